# Optimizing an MI355X kernel written in HIP

```python
import math
import jax
import jax.numpy as jnp
from jax import lax
import numpy as np

D_MODEL = 1024
BATCH = 4
SEQ = 4096
DEPTH = 4

N_META = 16
NORM_EPS = 1e-6
CHUNK = 128
CONV_K = 4
N_BRANCH = 4

RWKV_WIDTH = D_MODEL
RWKV_HEAD = 64
RWKV_HEADS = RWKV_WIDTH // RWKV_HEAD
RWKV_W_RANK = 64
RWKV_A_RANK = 64
RWKV_G_RANK = 128
RWKV_V_RANK = 32
RWKV_LN_EPS = 64e-5

SSM_WIDTH = D_MODEL
SSM_HEAD = 64
SSM_HEADS = SSM_WIDTH // SSM_HEAD
SSM_GROUPS = 4
SSM_STATE = 128

RET_HEADS = 8
RET_QK_WIDTH = D_MODEL // 2
RET_V_WIDTH = D_MODEL
RET_QK_HEAD = RET_QK_WIDTH // RET_HEADS
RET_V_HEAD = RET_V_WIDTH // RET_HEADS
ROPE_BASE = 10000.0

LRU_WIDTH = D_MODEL
LRU_BLOCKS = 8
LRU_BLOCK = LRU_WIDTH // LRU_BLOCKS
LRU_C = 8.0

FFN_HIDDEN = -(-8 * D_MODEL // (3 * 256)) * 256

RWKV_SIZES = (RWKV_WIDTH, RWKV_WIDTH, RWKV_WIDTH, RWKV_W_RANK, RWKV_A_RANK, RWKV_G_RANK)
SSM_XBC = SSM_WIDTH + 2 * SSM_GROUPS * SSM_STATE
SSM_SIZES = (SSM_WIDTH, SSM_XBC, SSM_HEADS)
RET_SIZES = (RET_QK_WIDTH, RET_QK_WIDTH, RET_V_WIDTH, RET_V_WIDTH)
LRU_SIZES = (LRU_WIDTH, LRU_WIDTH)
GROUP_SIZES = (sum(RWKV_SIZES), sum(SSM_SIZES), sum(RET_SIZES), sum(LRU_SIZES), N_BRANCH * D_MODEL)
IN_WIDTH = sum(GROUP_SIZES)

kernel_name = "hybrid_rwkv7_ssd_retention_rglru_trunk"


def _split(p, sizes):
    return jnp.split(p, np.cumsum(sizes)[:-1].tolist(), axis=-1)


def rms_norm(x, w, eps=NORM_EPS):
    x32 = x.astype(jnp.float32)
    y = x32 * lax.rsqrt(jnp.mean(x32 * x32, axis=-1, keepdims=True) + eps)
    return (y * w.astype(jnp.float32)).astype(x.dtype)


def causal_conv(x, w, b):
    y = lax.conv_general_dilated(x, w[:, None, :].astype(x.dtype), window_strides=(1,),
                                 padding=[(CONV_K - 1, 0)], dimension_numbers=('NWC', 'WIO', 'NWC'),
                                 feature_group_count=x.shape[-1])
    return y + b


def token_shift(p):
    return jnp.pad(p, ((0, 0), (1, 0), (0, 0)))[:, :-1]


def pad_front(t, n):
    return jnp.pad(t, ((0, 0), (n, 0)) + ((0, 0),) * (t.ndim - 2))


def segsum(a):
    n = a.shape[-1]
    cs = jnp.cumsum(a, axis=-1)
    diff = cs[..., :, None] - cs[..., None, :]
    return jnp.where(jnp.tril(jnp.ones((n, n), bool)), diff, -jnp.inf)


def rope(x, pos):
    half = x.shape[-1] // 2
    freq = jnp.power(ROPE_BASE, -jnp.arange(half, dtype=jnp.float32) / half)
    ang = pos[:, None] * freq[None, :]
    cos, sin = jnp.cos(ang)[None, :, None, :], jnp.sin(ang)[None, :, None, :]
    x1, x2 = x[..., :half], x[..., half:]
    return jnp.concatenate([x1 * cos - x2 * sin, x2 * cos + x1 * sin], axis=-1)


def rwkv7_mix(p, mu, w2, a2, g2, vec, r_k, v_first, vres):
    p = p.astype(jnp.float32)
    bsz, t_len, _ = p.shape
    p = p + (token_shift(p) - p) * mu
    r, k, v, wd, ad, gd = _split(p, RWKV_SIZES)
    w0, a0, k_k, k_a, ln_w, ln_b = vec
    w_log = -jax.nn.softplus(-(w0 + jnp.tanh(wd) @ w2)) - 0.5
    decay = jnp.exp(-jnp.exp(w_log))
    a = jax.nn.sigmoid(a0 + ad @ a2)
    g = jax.nn.sigmoid(gd) @ g2
    v_own = v
    if vres is not None:
        v0, v1, v2 = vres
        v = v + (v_first - v) * jax.nn.sigmoid(v0 + (v @ v1) @ v2)

    def hd(t):
        return t.reshape(bsz, t_len, RWKV_HEADS, RWKV_HEAD)

    kk = hd(k * k_k)
    kk = kk / jnp.maximum(jnp.sqrt(jnp.sum(kk * kk, axis=-1, keepdims=True)), 1e-12)
    k = k * (1.0 + (a - 1.0) * k_a)
    r4, w4, k4, v4, a4 = hd(r), hd(decay), hd(k), hd(v), hd(a)

    def step(s, inp):
        r_t, w_t, k_t, v_t, a_t, b_t = inp
        sa = jnp.einsum('bhvk,bhk->bhv', s, a_t)
        s = s * w_t[:, :, None, :] + sa[..., None] * b_t[:, :, None, :] + v_t[..., None] * k_t[:, :, None, :]
        return s, jnp.einsum('bhvk,bhk->bhv', s, r_t)

    s0 = jnp.zeros((bsz, RWKV_HEADS, RWKV_HEAD, RWKV_HEAD), jnp.float32)
    xs = tuple(jnp.moveaxis(t, 1, 0) for t in (r4, w4, k4, v4, -kk, kk * a4))
    _, y = lax.scan(step, s0, xs)
    y = jnp.moveaxis(y, 0, 1)
    mean = jnp.mean(y, axis=-1, keepdims=True)
    var = jnp.mean(jnp.square(y - mean), axis=-1, keepdims=True)
    y = ((y - mean) * lax.rsqrt(var + RWKV_LN_EPS)).reshape(bsz, t_len, RWKV_WIDTH) * ln_w + ln_b
    bonus = jnp.sum(r4 * k4 * r_k, axis=-1, keepdims=True) * v4
    return (y + bonus.reshape(bsz, t_len, RWKV_WIDTH)) * g, v_own


def ssd_mix(p, conv_w, conv_b, dt_bias, a_log, d_skip, norm_w):
    p = p.astype(jnp.float32)
    bsz, t_len, _ = p.shape
    G, E, P, N, L = SSM_GROUPS, SSM_HEADS // SSM_GROUPS, SSM_HEAD, SSM_STATE, CHUNK
    z, xbc, dt = _split(p, SSM_SIZES)
    xbc = jax.nn.silu(causal_conv(xbc, conv_w, conv_b))
    xs, bm, cm = _split(xbc, (SSM_WIDTH, G * N, G * N))
    dt = jax.nn.softplus(dt + dt_bias)
    A = -jnp.exp(a_log.astype(jnp.float32))
    pad = (-t_len) % L
    nc = (t_len + pad) // L

    def chunk(t, *tail):
        return pad_front(t, pad).reshape(bsz, nc, L, *tail)

    x6 = chunk(xs, G, E, P)
    dt5 = chunk(dt, G, E)
    bc = chunk(bm, G, N)
    cc = chunk(cm, G, N)
    dA = jnp.transpose(dt5 * A.reshape(G, E), (0, 3, 4, 1, 2))
    a_cum = jnp.cumsum(dA, axis=-1)
    lmat = jnp.exp(segsum(dA))
    xdt = x6 * dt5[..., None]
    cb = jnp.einsum('bclgn,bcsgn->bcgls', cc, bc)
    y_diag = jnp.einsum('bcgls,bgecls,bcsgep->bclgep', cb, lmat, xdt)
    decay_states = jnp.exp(a_cum[..., -1:] - a_cum)
    states = jnp.einsum('bclgn,bgecl,bclgep->bcgepn', bc, decay_states, xdt)
    states = jnp.concatenate([jnp.zeros_like(states[:, :1]), states], axis=1)
    chunk_decay = jnp.exp(segsum(jnp.pad(a_cum[..., -1], ((0, 0), (0, 0), (0, 0), (1, 0)))))
    states = jnp.einsum('bgezc,bcgepn->bzgepn', chunk_decay, states)[:, :-1]
    y_off = jnp.einsum('bclgn,bcgepn,bgecl->bclgep', cc, states, jnp.exp(a_cum))
    y = y_diag + y_off + x6 * d_skip.reshape(G, E)[..., None]
    y = y.reshape(bsz, nc * L, SSM_WIDTH)[:, pad:] * jax.nn.silu(z)
    yg = y.reshape(bsz, t_len, G, SSM_WIDTH // G)
    yg = yg * lax.rsqrt(jnp.mean(yg * yg, axis=-1, keepdims=True) + 1e-5)
    return yg.reshape(bsz, t_len, SSM_WIDTH) * norm_w


def retention_mix(p):
    p = p.astype(jnp.float32)
    bsz, t_len, _ = p.shape
    H, DK, DV, L = RET_HEADS, RET_QK_HEAD, RET_V_HEAD, CHUNK
    q, k, v, g = _split(p, RET_SIZES)
    pos = jnp.arange(t_len, dtype=jnp.float32)
    q = rope(q.reshape(bsz, t_len, H, DK), pos)
    k = rope(k.reshape(bsz, t_len, H, DK), pos) * (DK ** -0.5)
    v = v.reshape(bsz, t_len, H, DV)
    pad = (-t_len) % L
    nc = (t_len + pad) // L
    qc = pad_front(q, pad).reshape(bsz, nc, L, H, DK)
    kc = pad_front(k, pad).reshape(bsz, nc, L, H, DK)
    vc = pad_front(v, pad).reshape(bsz, nc, L, H, DV)
    log_g = jnp.log1p(-jnp.exp2(-5.0 - jnp.arange(H, dtype=jnp.float32)))
    idx = jnp.arange(L, dtype=jnp.float32)
    rel = idx[:, None] - idx[None, :]
    causal = rel >= 0
    intra = jnp.where(causal, jnp.exp(jnp.where(causal, rel, 0.0)[None] * log_g[:, None, None]), 0.0)
    scores = jnp.einsum('bclhd,bcshd->bchls', qc, kc) * intra
    y_in = jnp.einsum('bchls,bcshe->bclhe', scores, vc)
    k_dec = jnp.exp((L - 1.0 - idx)[None, :] * log_g[:, None])
    q_dec = jnp.exp((idx + 1.0)[None, :] * log_g[:, None])
    chunk_dec = jnp.exp(L * log_g)[None, :, None, None]
    kv = jnp.einsum('bclhd,hl,bclhe->bchde', kc, k_dec, vc)

    def step(r_state, kv_c):
        return chunk_dec * r_state + kv_c, r_state

    _, r_prev = lax.scan(step, jnp.zeros((bsz, H, DK, DV), jnp.float32), jnp.moveaxis(kv, 1, 0))
    y_x = jnp.einsum('bclhd,hl,cbhde->bclhe', qc, q_dec, r_prev)
    y = (y_in + y_x).reshape(bsz, nc * L, H, DV)[:, pad:]
    y = y * lax.rsqrt(jnp.mean(y * y, axis=-1, keepdims=True) + NORM_EPS)
    return jax.nn.silu(g) * y.reshape(bsz, t_len, RET_V_WIDTH)


def rglru_mix(p, conv_w, conv_b, w_gate, b_gate, lam):
    p = p.astype(jnp.float32)
    bsz, t_len, _ = p.shape
    y_in, x_in = _split(p, LRU_SIZES)
    gate = jax.nn.gelu(y_in)
    xc = causal_conv(x_in, conv_w, conv_b)
    xb = xc.reshape(bsz, t_len, LRU_BLOCKS, LRU_BLOCK)
    gates = jnp.einsum('btnc,knce->kbtne', xb, w_gate).reshape(2, bsz, t_len, LRU_WIDTH) + b_gate[:, None, None, :]
    r_gate = jax.nn.sigmoid(gates[0])
    i_gate = jax.nn.sigmoid(gates[1])
    log_a = -LRU_C * r_gate * jax.nn.softplus(-lam)
    a = jnp.exp(log_a)
    u = jnp.sqrt(-jnp.expm1(2.0 * log_a)) * (i_gate * xc)

    def combine(left, right):
        a1, b1 = left
        a2, b2 = right
        return a1 * a2, a2 * b1 + b2

    _, h = lax.associative_scan(combine, (a, u), axis=1)
    return h * gate


def setup_inputs(seed: int = 0) -> dict:
    key = jax.random.key(seed)
    keys = iter(jax.random.split(key, 64))
    f32 = jnp.float32

    def nrm(shape, scale):
        return jax.random.normal(next(keys), shape, f32) * scale

    def uni(shape, lo, hi):
        return jax.random.uniform(next(keys), shape, f32, lo, hi)

    L = DEPTH
    W = RWKV_WIDTH
    dt0 = jnp.exp(uni((L, SSM_HEADS), math.log(1e-3), math.log(1e-1)))
    a_pow = uni((L, LRU_WIDTH), 0.9, 0.999) ** (1.0 / LRU_C)
    rwkv_vec = jnp.stack([uni((L, W), -6.0, -1.0), nrm((L, W), 0.1), 0.85 + nrm((L, W), 0.02),
                          1.0 + nrm((L, W), 0.02), 1.0 + nrm((L, W), 0.02), nrm((L, W), 0.02)], axis=1)
    return {
        "x": nrm((BATCH, SEQ, D_MODEL), 1.0),
        "meta": nrm((N_META, D_MODEL), 1.0),
        "norm_mix": 1.0 + nrm((L, D_MODEL), 0.02),
        "norm_ffn": 1.0 + nrm((L, D_MODEL), 0.02),
        "w_in": nrm((L, D_MODEL, IN_WIDTH), D_MODEL ** -0.5),
        "rwkv_mu": uni((L, sum(RWKV_SIZES)), 0.0, 1.0),
        "rwkv_w2": nrm((L, RWKV_W_RANK, W), 0.1),
        "rwkv_a2": nrm((L, RWKV_A_RANK, W), RWKV_A_RANK ** -0.5),
        "rwkv_g2": nrm((L, RWKV_G_RANK, W), RWKV_G_RANK ** -0.5),
        "rwkv_vec": rwkv_vec,
        "rwkv_rk": nrm((L, RWKV_HEADS, RWKV_HEAD), 0.1),
        "rwkv_v0": nrm((L - 1, W), 0.1),
        "rwkv_v1": nrm((L - 1, W, RWKV_V_RANK), W ** -0.5),
        "rwkv_v2": nrm((L - 1, RWKV_V_RANK, W), RWKV_V_RANK ** -0.5),
        "ssm_conv_w": nrm((L, CONV_K, SSM_XBC), CONV_K ** -0.5),
        "ssm_conv_b": nrm((L, SSM_XBC), 0.02),
        "ssm_dt_bias": dt0 + jnp.log(-jnp.expm1(-dt0)),
        "ssm_a_log": jnp.log(uni((L, SSM_HEADS), 1.0, 16.0)),
        "ssm_d": 1.0 + nrm((L, SSM_HEADS), 0.02),
        "ssm_norm": 1.0 + nrm((L, SSM_WIDTH), 0.02),
        "lru_conv_w": nrm((L, CONV_K, LRU_WIDTH), CONV_K ** -0.5),
        "lru_conv_b": nrm((L, LRU_WIDTH), 0.02),
        "lru_w_gate": nrm((L, 2, LRU_BLOCKS, LRU_BLOCK, LRU_BLOCK), LRU_BLOCK ** -0.5),
        "lru_b_gate": nrm((L, 2, LRU_WIDTH), 0.02),
        "lru_lambda": jnp.log(a_pow) - jnp.log1p(-a_pow),
        "w_branch": nrm((L, N_BRANCH, D_MODEL, D_MODEL), D_MODEL ** -0.5),
        "w_out": nrm((L, D_MODEL, D_MODEL), D_MODEL ** -0.5),
        "w_ffn_in": nrm((L, D_MODEL, 2 * FFN_HIDDEN), D_MODEL ** -0.5),
        "w_ffn_out": nrm((L, FFN_HIDDEN, D_MODEL), FFN_HIDDEN ** -0.5),
        "final_norm": 1.0 + nrm((D_MODEL,), 0.02),
    }


def reference(x, meta, norm_mix, norm_ffn, w_in, rwkv_mu, rwkv_w2, rwkv_a2, rwkv_g2, rwkv_vec, rwkv_rk,
              rwkv_v0, rwkv_v1, rwkv_v2, ssm_conv_w, ssm_conv_b, ssm_dt_bias, ssm_a_log, ssm_d, ssm_norm,
              lru_conv_w, lru_conv_b, lru_w_gate, lru_b_gate, lru_lambda, w_branch, w_out, w_ffn_in,
              w_ffn_out, final_norm):
    bsz = x.shape[0]
    s = jnp.concatenate([jnp.broadcast_to(meta[None].astype(x.dtype), (bsz, N_META, D_MODEL)), x], axis=1)
    t_len = s.shape[1]
    v_first = None
    for l in range(DEPTH):
        hn = rms_norm(s, norm_mix[l])
        p_a, p_b, p_c, p_d, p_g = _split(hn @ w_in[l], GROUP_SIZES)
        vres = None if l == 0 else (rwkv_v0[l - 1], rwkv_v1[l - 1], rwkv_v2[l - 1])
        y_a, v_a = rwkv7_mix(p_a, rwkv_mu[l], rwkv_w2[l], rwkv_a2[l], rwkv_g2[l], rwkv_vec[l], rwkv_rk[l],
                             v_first, vres)
        if l == 0:
            v_first = v_a
        y_b = ssd_mix(p_b, ssm_conv_w[l], ssm_conv_b[l], ssm_dt_bias[l], ssm_a_log[l], ssm_d[l], ssm_norm[l])
        y_c = retention_mix(p_c)
        y_d = rglru_mix(p_d, lru_conv_w[l], lru_conv_b[l], lru_w_gate[l], lru_b_gate[l], lru_lambda[l])
        ys = jnp.stack([y_a, y_b, y_c, y_d], axis=2).astype(s.dtype)
        zb = jnp.einsum('btnc,ncd->btnd', ys, w_branch[l])
        gate = jax.nn.sigmoid(p_g.reshape(bsz, t_len, N_BRANCH, D_MODEL))
        s = s + jnp.sum(gate * zb, axis=2) @ w_out[l]
        hn = rms_norm(s, norm_ffn[l])
        g_in, u_in = jnp.split(hn @ w_ffn_in[l], 2, axis=-1)
        s = s + (jax.nn.silu(g_in) * u_in) @ w_ffn_out[l]
    return rms_norm(s, final_norm)[:, N_META:]
```

```cpp
#include <hip/hip_runtime.h>
#include <hip/hip_cooperative_groups.h>
#include <cstdio>
#include <cstdint>
namespace cg = cooperative_groups;

#define LAS __attribute__((address_space(3)))
typedef unsigned short bf16_t;
typedef short bf16x8 __attribute__((ext_vector_type(8)));
typedef short bf16x4 __attribute__((ext_vector_type(4)));
typedef float f32x4 __attribute__((ext_vector_type(4)));
typedef unsigned u32x4 __attribute__((ext_vector_type(4)));
typedef unsigned u32x2 __attribute__((ext_vector_type(2)));

constexpr int DM = 1024, NB = 4, SEQ = 4096, NMETA = 16, TT = SEQ + NMETA;
constexpr int MMAIN = NB * SEQ;
constexpr int MP = 16640, NTM = MP / 256;
constexpr int INW = 15632, NP = 15872;
constexpr int OFF_SSM = 3328, OFF_RET = 6416, OFF_LRU = 9488, OFF_GATE = 11536, OFF_VLO = 15632;
constexpr int FF = 2816;
constexpr int NLAYER = 4;

constexpr size_t WS_SSQ = 0;
constexpr size_t WS_XBAR = 12u << 20;
constexpr size_t WS_S = 16u << 20;
constexpr size_t WS_HN = WS_S + (size_t)MP * DM * 4;
constexpr size_t WS_P = WS_HN + (size_t)MP * DM * 2;
constexpr size_t WS_YS = WS_P + (size_t)MP * NP * 2;
constexpr size_t WS_VF = WS_YS + (size_t)4 * MP * DM * 2;
constexpr size_t WS_Z = WS_VF + (size_t)MP * DM * 2;
constexpr size_t WS_ZB = WS_Z + (size_t)MP * DM * 4;
constexpr size_t WS_WIN = WS_ZB + (size_t)MP * DM * 2;
constexpr size_t WSM_BR = 0, WSM_OUT = (size_t)4096 * 1024 * 2, WSM_FI = WSM_OUT + (size_t)1024 * 1024 * 2,
                 WSM_FO = WSM_FI + (size_t)2 * FF * 1024 * 2, WSM_SIZE = WSM_FO + (size_t)1024 * FF * 2;
constexpr size_t WS_WSM = WS_WIN + (size_t)NP * DM * 2;
constexpr int PT_A = 26;
constexpr int GT0 = 46, GTN = 15;
constexpr size_t WS_WING = WS_WSM + 2 * WSM_SIZE, WING_SIZE = (size_t)GTN * 256 * DM * 2;
constexpr size_t WS_END = WS_WING + 2 * WING_SIZE;
static_assert(WS_END <= 1024458752ull, "workspace map exceeds 4 x w_in bytes");

typedef float f32x2_t __attribute__((ext_vector_type(2))); typedef __bf16 bf16x2_t __attribute__((ext_vector_type(2)));
__device__ __forceinline__ unsigned pk2(float lo, float hi) { f32x2_t v = {lo, hi}; bf16x2_t b = __builtin_convertvector(v, bf16x2_t); return __builtin_bit_cast(unsigned, b); }
__device__ __forceinline__ unsigned f2bf(float f) { return pk2(f, f); }
__device__ __forceinline__ float bf2f(unsigned h) { return __builtin_bit_cast(float, h << 16); }
__device__ __forceinline__ float sigmoidf_(float x) { return __builtin_amdgcn_rcpf(1.f + __expf(-x)); }
__device__ __forceinline__ float softplusf_(float x) { return x > 20.f ? x : log1pf(__expf(x)); }
__device__ __forceinline__ float siluf_(float x) { return x * __builtin_amdgcn_rcpf(1.f + __expf(-x)); }
__device__ __forceinline__ int row_of(int b, int t) { return t < NMETA ? MMAIN + t : b * SEQ + (t - NMETA); }
__device__ __forceinline__ void unpack8(u32x4 w, float* f) {
    f[0] = bf2f(w.x & 0xffffu); f[1] = bf2f(w.x >> 16); f[2] = bf2f(w.y & 0xffffu); f[3] = bf2f(w.y >> 16);
    f[4] = bf2f(w.z & 0xffffu); f[5] = bf2f(w.z >> 16); f[6] = bf2f(w.w & 0xffffu); f[7] = bf2f(w.w >> 16);
}
__device__ __forceinline__ float dpp_f(float x, const int ctrl_is_const_only) { return x; }
#define DPP_ADD(x, ctrl) ((x) + __builtin_bit_cast(float, __builtin_amdgcn_update_dpp(0, __builtin_bit_cast(int, (x)), (ctrl), 0xf, 0xf, true)))
__device__ __forceinline__ float half_sum32(float x) { x = DPP_ADD(x, 0xB1); x = DPP_ADD(x, 0x4E); x = DPP_ADD(x, 0x141); x = DPP_ADD(x, 0x140); x += __shfl_xor(x, 16); return x; }
#define TIDX ((void)WAVE_U, (int)threadIdx.x)
#define LDS_WAIT() asm volatile("s_waitcnt lgkmcnt(0)" ::: "memory")
#ifndef REP_A
#define REP_A 1
#endif
#ifndef REP_B
#define REP_B 1
#endif
#define BAR_LDS() asm volatile("s_waitcnt lgkmcnt(0)\n\ts_barrier" ::: "memory")
__device__ __forceinline__ float ssq_total(const float* ssq, int row) {
    const f32x4 a = *(const f32x4*)(ssq + (size_t)row * 16), b = *(const f32x4*)(ssq + (size_t)row * 16 + 4), c = *(const f32x4*)(ssq + (size_t)row * 16 + 8), d = *(const f32x4*)(ssq + (size_t)row * 16 + 12);
    return (((a[0] + a[1]) + (a[2] + a[3])) + ((b[0] + b[1]) + (b[2] + b[3]))) + (((c[0] + c[1]) + (c[2] + c[3])) + ((d[0] + d[1]) + (d[2] + d[3])));
}

namespace pg8 {
constexpr int BM = 256, BK = 64, HALF = 128, HTB = HALF * BK * 2, STAGE_BYTES = 8 * HTB, NXCD = 8, WGM = 8;
__host__ __device__ __forceinline__ int lds_byte(int r, int c) { const int st = (r >> 4) * 2 + (c >> 5), rr = r & 15, cc = c & 31, ob = rr * 64 + cc * 2; return st * 1024 + (ob ^ (((ob >> 9) & 1) << 5)); }
__host__ __device__ __forceinline__ void stage_rc(int b, int& R, int& C) { const int st = b / 1024, sb = b % 1024, swz = sb ^ (((sb >> 9) & 1) << 5); R = (st >> 1) * 16 + swz / 64; C = (st & 1) * 32 + (swz % 64) / 2; }
__host__ __device__ __forceinline__ int perm32(int rho) { const int n = rho >> 4, i = rho & 15; return 8 * (i >> 2) + 4 * n + (i & 3); }
struct Unit { int pm, pn; };
struct Gemm { const bf16_t* A; const bf16_t* Bt; int K; };
struct StaticOrder {
    int nM, nN, nwg, G, c;
    __device__ void init(int nM_, int nN_, int G_, int c_) { nM = nM_; nN = nN_; nwg = nM * nN; G = G_; c = c_; }
    __device__ bool next(int i, Unit& u) const {
        const long L = (long)i * G + c; if (L >= nwg) return false;
        int wgid = (int)L; { const int q = nwg / NXCD, r = nwg % NXCD, xcd = wgid % NXCD, off = wgid / NXCD; wgid = (xcd < r ? xcd * (q + 1) : r * (q + 1) + (xcd - r) * q) + off; }
        const int nig = WGM * nN, gid = wgid / nig, fm = gid * WGM, gsz = (nM - fm) < WGM ? (nM - fm) : WGM;
        u.pm = fm + ((wgid % nig) % gsz); u.pn = (wgid % nig) / gsz; return true;
    }
};
struct RemapOrder { StaticOrder b; int from, to;
    __device__ bool next(int i, Unit& u) const { if (!b.next(i, u)) return false; if (u.pn == from) u.pn = to; return true; } };
struct BranchOrder {
    int G, c;
    __device__ bool next(int i, Unit& u) const {
        const int su = (i >> 2) * G + c, n = i & 3; if (su >= (NTM - 1) * 4) return false;
        u.pm = n * NTM + (su >> 2); u.pn = n * 4 + (su & 3); return true;
    }
};

template <class Epi, class Sched>
__device__ __forceinline__ void gemm_phase(LAS unsigned char* lds, const Gemm g, const Sched& S, const Epi& E, const int WAVE_U) {
    int tid_ = TIDX; asm volatile("" : "+v"(tid_)); const int tid = tid_, wid = __builtin_amdgcn_readfirstlane(tid >> 6), lane = tid & 63, wr = wid >> 2, wc = wid & 3, fr = lane & 15, fq = lane >> 4;
    const int K = g.K, nt = K / BK;
    unsigned voffA[2], voffB[2];
#pragma unroll
    for (int i = 0; i < 2; ++i) { int R, C; stage_rc(tid * 16 + i * 8192, R, C); const int Rb = (R & ~31) + perm32(R & 31);
        voffA[i] = (unsigned)(R * K + C) * 2u; voffB[i] = (unsigned)(Rb * K + C) * 2u; }
    const size_t kstep = (size_t)(BK * 2);
    const size_t hstep = (size_t)HALF * K * 2;
    const size_t tstep = 2 * hstep;
    const unsigned ldsw = (unsigned)wid * 1024u;
    const int aoff = lds_byte(wr * 64 + fr, fq * 8), boff = lds_byte(wc * 32 + fr, fq * 8);
#define PG8_SA(b, h) (((b) * 2 + (h)) * HTB)
#define PG8_SB(b, h) ((4 + (b) * 2 + (h)) * HTB)
#define PG8_STAGE(bufoff, gbase, voff) do { _Pragma("unroll") for (int _i = 0; _i < 2; ++_i) \
        __builtin_amdgcn_global_load_lds((const unsigned*)((const char*)(gbase) + (voff)[_i]), (LAS unsigned*)(lds + (bufoff) + ldsw + _i * 8192), 16, 0, 0); } while (0)
#define PG8_LDA(dst, b, h) do { _Pragma("unroll") for (int m = 0; m < 4; ++m) _Pragma("unroll") for (int k = 0; k < 2; ++k) dst[m][k] = *(const LAS bf16x8*)(lds + PG8_SA(b, h) + aoff + m * 2048 + k * 1024); } while (0)
#define PG8_LDB(dst, b, h) do { _Pragma("unroll") for (int n = 0; n < 2; ++n) _Pragma("unroll") for (int k = 0; k < 2; ++k) dst[n][k] = *(const LAS bf16x8*)(lds + PG8_SB(b, h) + boff + n * 2048 + k * 1024); } while (0)
#define PG8_MMA(ai, bj, At, Bt) do { __builtin_amdgcn_s_setprio(1); _Pragma("unroll") for (int m = 0; m < 4; ++m) _Pragma("unroll") for (int n = 0; n < 2; ++n) _Pragma("unroll") for (int k = 0; k < 2; ++k) \
        acc[ai][bj][m][n] = __builtin_amdgcn_mfma_f32_16x16x32_bf16(Bt[n][k], At[m][k], acc[ai][bj][m][n], 0, 0, 0); __builtin_amdgcn_s_setprio(0); } while (0)
#define PG8_WAIT_V(n) asm volatile("s_waitcnt vmcnt(" #n ")" ::: "memory")
#define PG8_WAIT_L(n) asm volatile("s_waitcnt lgkmcnt(" #n ")" ::: "memory")
#define PG8_BAR __builtin_amdgcn_s_barrier()
#define PG8_SCHED __builtin_amdgcn_sched_barrier(0)
    Unit cur, nxt; int ui = 0;
    if (!S.next(0, cur)) return;
    f32x4 acc[2][2][4][2];
#pragma unroll
    for (int a = 0; a < 2; ++a)
#pragma unroll
        for (int b = 0; b < 2; ++b)
#pragma unroll
            for (int m = 0; m < 4; ++m)
#pragma unroll
                for (int n = 0; n < 2; ++n) acc[a][b][m][n] = (f32x4){0.f, 0.f, 0.f, 0.f};
    bf16x8 At[4][2], B0[2][2], B1[2][2];
    const char* cA = (const char*)g.A + (size_t)cur.pm * tstep; const char* cB = (const char*)g.Bt + (size_t)cur.pn * tstep;
    PG8_STAGE(PG8_SB(0, 0), cB, voffB); PG8_STAGE(PG8_SB(0, 1), cB + hstep, voffB); PG8_STAGE(PG8_SA(0, 0), cA, voffA); PG8_STAGE(PG8_SA(0, 1), cA + hstep, voffA);
    if (wr == 1) PG8_BAR;
    PG8_WAIT_V(2); PG8_BAR;
    PG8_STAGE(PG8_SB(1, 0), cB + kstep, voffB); PG8_STAGE(PG8_SA(1, 0), cA + kstep, voffA); PG8_STAGE(PG8_SB(1, 1), cB + hstep + kstep, voffB);
    PG8_WAIT_V(6); PG8_BAR;
    for (;;) {
        const bool has_next = S.next(ui + 1, nxt);
        const char* nA = has_next ? (const char*)g.A + (size_t)nxt.pm * tstep : cA; const char* nB = has_next ? (const char*)g.Bt + (size_t)nxt.pn * tstep : cB;
        for (int t = 0; t < nt; t += 2) {
            const bool last = (t == nt - 2);
            const char* a1 = cA + (size_t)(t + 1) * kstep;
            const char* a2 = last ? nA : cA + (size_t)(t + 2) * kstep; const char* b2 = last ? nB : cB + (size_t)(t + 2) * kstep;
            const char* a3 = a2 + kstep; const char* b3 = b2 + kstep;
            PG8_LDB(B0, 0, 0); PG8_LDB(B1, 0, 1); PG8_SCHED; PG8_LDA(At, 0, 0); PG8_STAGE(PG8_SA(1, 1), a1 + hstep, voffA);
            PG8_WAIT_V(8); PG8_WAIT_L(0); PG8_BAR; PG8_MMA(0, 0, At, B0); PG8_MMA(0, 1, At, B1); PG8_BAR; PG8_SCHED;
            PG8_LDA(At, 0, 1); PG8_STAGE(PG8_SB(0, 0), b2, voffB); PG8_STAGE(PG8_SB(0, 1), b2 + hstep, voffB); PG8_STAGE(PG8_SA(0, 0), a2, voffA);
            PG8_WAIT_V(8); PG8_WAIT_L(0); PG8_BAR; PG8_MMA(1, 0, At, B0); PG8_MMA(1, 1, At, B1); PG8_BAR; PG8_SCHED;
            PG8_LDB(B0, 1, 0); PG8_LDB(B1, 1, 1); PG8_SCHED; PG8_LDA(At, 1, 0); PG8_STAGE(PG8_SA(0, 1), a2 + hstep, voffA);
            PG8_WAIT_V(8); PG8_WAIT_L(0); PG8_BAR; PG8_MMA(0, 0, At, B0); PG8_MMA(0, 1, At, B1); PG8_BAR; PG8_SCHED;
            PG8_LDA(At, 1, 1); PG8_STAGE(PG8_SB(1, 0), b3, voffB); PG8_STAGE(PG8_SB(1, 1), b3 + hstep, voffB); PG8_STAGE(PG8_SA(1, 0), a3, voffA);
            PG8_WAIT_V(8); PG8_WAIT_L(0); PG8_BAR; PG8_MMA(1, 0, At, B0); PG8_MMA(1, 1, At, B1); PG8_BAR; PG8_SCHED;
        }
        if (wr == 0) PG8_BAR;
        E(acc, cur, wr, wc, fr, fq);
        if (!has_next) break;
#pragma unroll
        for (int a = 0; a < 2; ++a)
#pragma unroll
            for (int b = 0; b < 2; ++b)
#pragma unroll
                for (int m = 0; m < 4; ++m)
#pragma unroll
                    for (int n = 0; n < 2; ++n) acc[a][b][m][n] = (f32x4){0.f, 0.f, 0.f, 0.f};
        cur = nxt; cA = nA; cB = nB; ++ui;
        if (wr == 1) PG8_BAR;
    }
    PG8_WAIT_V(0);
    PG8_BAR;
#undef PG8_SA
#undef PG8_SB
#undef PG8_STAGE
#undef PG8_LDA
#undef PG8_LDB
#undef PG8_MMA
#undef PG8_WAIT_V
#undef PG8_WAIT_L
#undef PG8_BAR
#undef PG8_SCHED
}

struct EpiInProj {
    bf16_t* P; const float* ssq; int pn_off;
    __device__ __forceinline__ void operator()(const f32x4 (&acc)[2][2][4][2], const Unit& u, int wr, int wc, int fr, int fq) const {
#pragma unroll
        for (int ai = 0; ai < 2; ++ai)
#pragma unroll
            for (int m = 0; m < 4; ++m) {
                const int row = u.pm * 256 + ai * 128 + wr * 64 + m * 16 + fr;
                const float rs = rsqrtf(ssq_total(ssq, row) * (1.f / 1024.f) + 1e-6f);
#pragma unroll
                for (int bj = 0; bj < 2; ++bj) {
                    const int col = (u.pn + pn_off) * 256 + bj * 128 + wc * 32 + 8 * fq;
                    const f32x4 v0 = acc[ai][bj][m][0] * rs, v1 = acc[ai][bj][m][1] * rs;
                    u32x4 w; w.x = pk2(v0[0], v0[1]); w.y = pk2(v0[2], v0[3]); w.z = pk2(v1[0], v1[1]); w.w = pk2(v1[2], v1[3]);
                    *(u32x4*)(P + (size_t)row * NP + col) = w;
                }
            }
    }
};
struct EpiBranch {
    const bf16_t* P; float* Z; bf16_t* ZB;
    __device__ __forceinline__ void operator()(const f32x4 (&acc)[2][2][4][2], const Unit& u, int wr, int wc, int fr, int fq) const {
        const int n = u.pn >> 2, pn = u.pn & 3, pm = u.pm - n * NTM;
#pragma unroll
        for (int ai = 0; ai < 2; ++ai)
#pragma unroll
            for (int m = 0; m < 4; ++m) {
                const int row = pm * 256 + ai * 128 + wr * 64 + m * 16 + fr;
#pragma unroll
                for (int bj = 0; bj < 2; ++bj) {
                    const int col = pn * 256 + bj * 128 + wc * 32 + 8 * fq;
                    const u32x4 gw = *(const u32x4*)(P + (size_t)row * NP + OFF_GATE + n * 1024 + col);
                    float gt[8]; unpack8(gw, gt);
                    float v[8];
#pragma unroll
                    for (int j = 0; j < 4; ++j) { v[j] = sigmoidf_(gt[j]) * acc[ai][bj][m][0][j]; v[4 + j] = sigmoidf_(gt[4 + j]) * acc[ai][bj][m][1][j]; }
                    float* zp = Z + (size_t)row * DM + col;
                    if (n != 0) { const f32x4 z0 = *(const f32x4*)zp, z1 = *(const f32x4*)(zp + 4);
#pragma unroll
                        for (int j = 0; j < 4; ++j) { v[j] += z0[j]; v[4 + j] += z1[j]; } }
                    if (n != 3) { *(f32x4*)zp = (f32x4){v[0], v[1], v[2], v[3]}; *(f32x4*)(zp + 4) = (f32x4){v[4], v[5], v[6], v[7]}; }
                    else { u32x4 w; w.x = pk2(v[0], v[1]); w.y = pk2(v[2], v[3]); w.z = pk2(v[4], v[5]); w.w = pk2(v[6], v[7]); *(u32x4*)(ZB + (size_t)row * DM + col) = w; }
                }
            }
    }
};
struct EpiResid {
    float* S; bf16_t* HN; const float* nw; float* ssq;
    __device__ __forceinline__ void operator()(const f32x4 (&acc)[2][2][4][2], const Unit& u, int wr, int wc, int fr, int fq) const {
#pragma unroll
        for (int ai = 0; ai < 2; ++ai)
#pragma unroll
            for (int m = 0; m < 4; ++m) {
                const int row = u.pm * 256 + ai * 128 + wr * 64 + m * 16 + fr;
                float ss = 0.f;
#pragma unroll
                for (int bj = 0; bj < 2; ++bj) {
                    const int col = u.pn * 256 + bj * 128 + wc * 32 + 8 * fq;
                    float* sp = S + (size_t)row * DM + col;
                    f32x4 s0 = *(const f32x4*)sp, s1 = *(const f32x4*)(sp + 4);
                    s0 += acc[ai][bj][m][0]; s1 += acc[ai][bj][m][1];
                    *(f32x4*)sp = s0; *(f32x4*)(sp + 4) = s1;
                    const f32x4 w0 = *(const f32x4*)(nw + col), w1 = *(const f32x4*)(nw + col + 4);
                    u32x4 w; w.x = pk2(s0[0] * w0[0], s0[1] * w0[1]); w.y = pk2(s0[2] * w0[2], s0[3] * w0[3]); w.z = pk2(s1[0] * w1[0], s1[1] * w1[1]); w.w = pk2(s1[2] * w1[2], s1[3] * w1[3]);
                    *(u32x4*)(HN + (size_t)row * DM + col) = w;
                    ss += (s0[0] * s0[0] + s0[1] * s0[1]) + (s0[2] * s0[2] + s0[3] * s0[3]) + (s1[0] * s1[0] + s1[1] * s1[1]) + (s1[2] * s1[2] + s1[3] * s1[3]);
                }
                ss += __shfl_xor(ss, 16); ss += __shfl_xor(ss, 32);
                if (fq == 0) ssq[(size_t)row * 16 + u.pn * 4 + wc] = ss;
            }
    }
};
struct EpiSwiglu {
    bf16_t* H; const float* ssq;
    __device__ __forceinline__ void operator()(const f32x4 (&acc)[2][2][4][2], const Unit& u, int wr, int wc, int fr, int fq) const {
#pragma unroll
        for (int ai = 0; ai < 2; ++ai)
#pragma unroll
            for (int m = 0; m < 4; ++m) {
                const int row = u.pm * 256 + ai * 128 + wr * 64 + m * 16 + fr;
                const float rs = rsqrtf(ssq_total(ssq, row) * (1.f / 1024.f) + 1e-6f);
                float v[8];
#pragma unroll
                for (int n = 0; n < 2; ++n)
#pragma unroll
                    for (int j = 0; j < 4; ++j) { const float gg = acc[ai][0][m][n][j] * rs, uu = acc[ai][1][m][n][j] * rs; v[4 * n + j] = siluf_(gg) * uu; }
                u32x4 w; w.x = pk2(v[0], v[1]); w.y = pk2(v[2], v[3]); w.z = pk2(v[4], v[5]); w.w = pk2(v[6], v[7]);
                *(u32x4*)(H + (size_t)row * FF + u.pn * 128 + wc * 32 + 8 * fq) = w;
            }
    }
};
}

__device__ __forceinline__ bf16x8 ldfrag(const LAS bf16_t* p, int ld, int r, int q) { return *(const LAS bf16x8*)(p + r * ld + q * 8); }
__device__ __forceinline__ bf16x4 ldfrag4(const LAS bf16_t* p, int ld, int r, int q) { return *(const LAS bf16x4*)(p + r * ld + q * 4); }
__device__ __forceinline__ f32x4 mma32(bf16x8 a, bf16x8 b, f32x4 c) { return __builtin_amdgcn_mfma_f32_16x16x32_bf16(a, b, c, 0, 0, 0); }
__device__ __forceinline__ f32x4 mma16(bf16x4 a, bf16x4 b, f32x4 c) { return __builtin_amdgcn_mfma_f32_16x16x16bf16_1k(a, b, c, 0, 0, 0); }
__device__ __forceinline__ bf16x4 cvt4(f32x4 v) { u32x2 w; w.x = pk2(v[0], v[1]); w.y = pk2(v[2], v[3]); return __builtin_bit_cast(bf16x4, w); }
__device__ __forceinline__ bf16x8 scale8(bf16x8 x, const float* f) { const u32x4 w = __builtin_bit_cast(u32x4, x); float v[8]; unpack8(w, v); u32x4 o;
    o.x = pk2(v[0] * f[0], v[1] * f[1]); o.y = pk2(v[2] * f[2], v[3] * f[3]); o.z = pk2(v[4] * f[4], v[5] * f[5]); o.w = pk2(v[6] * f[6], v[7] * f[7]); return __builtin_bit_cast(bf16x8, o); }

struct KP { const float* in[30]; float* out; unsigned char* ws; };

__device__ __forceinline__ void tr_item(const float* W, int N, bf16_t* WT, int ldk, int k0, int n0, int dst_row0, LAS float* scr, int lane) {
#pragma unroll 8
    for (int i = 0; i < 32; ++i) { const int kk = 2 * i + (lane >> 5); const int n = n0 + (lane & 31); scr[kk * 33 + (lane & 31)] = (n < N) ? W[(size_t)(k0 + kk) * N + n] : 0.f; }
    LDS_WAIT(); asm volatile("" ::: "memory");
    const int c = lane & 7;
#pragma unroll
    for (int j = 0; j < 4; ++j) { const int n = (lane >> 3) + 8 * j; const LAS float* s = scr + (8 * c) * 33 + n;
        u32x4 o; o.x = pk2(s[0 * 33], s[1 * 33]); o.y = pk2(s[2 * 33], s[3 * 33]); o.z = pk2(s[4 * 33], s[5 * 33]); o.w = pk2(s[6 * 33], s[7 * 33]);
        if (n0 + n < N) *(u32x4*)(WT + (size_t)(dst_row0 + n) * ldk + k0 + 8 * c) = o; }
    LDS_WAIT(); asm volatile("" ::: "memory");
}
__device__ __forceinline__ void convert_layer(const KP& p, int l, LAS unsigned char* lds, int gw, int NGW, int wave, int lane) {
    asm volatile("" : "+v"(lane)); asm volatile("" : "+v"(wave)); wave = __builtin_amdgcn_readfirstlane(wave);
    LAS float* scr = (LAS float*)(lds + wave * 8448);
    bf16_t* win_t = (bf16_t*)(p.ws + WS_WIN); bf16_t* wing_t = (bf16_t*)(p.ws + WS_WING + (size_t)(l & 1) * WING_SIZE);
    unsigned char* sm = p.ws + WS_WSM + (size_t)(l & 1) * WSM_SIZE;
    bf16_t* br_t = (bf16_t*)(sm + WSM_BR); bf16_t* out_t = (bf16_t*)(sm + WSM_OUT); bf16_t* fi_t = (bf16_t*)(sm + WSM_FI); bf16_t* fo_t = (bf16_t*)(sm + WSM_FO);
    constexpr int NB_IN = (INW + 31) / 32;
    constexpr int I_IN = 16 * NB_IN, I_BR = 4 * 16 * 32, I_OUT = 16 * 32, I_FI = 16 * (2 * FF / 32), I_FO = (FF / 64) * 32;
    constexpr int NITEMS = I_IN + I_BR + I_OUT + I_FI + I_FO;
    for (int it = gw; it < NITEMS; it += NGW) {
        int r = it;
        if (r < I_IN) { const int kb = r / NB_IN, nb = r % NB_IN; const bool gt = nb >= GT0 * 8 && nb < (GT0 + GTN) * 8;
            tr_item(p.in[4] + (size_t)l * DM * INW, INW, gt ? wing_t : win_t, DM, kb * 64, nb * 32, gt ? nb * 32 - GT0 * 256 : nb * 32, scr, lane); continue; } r -= I_IN;
        if (r < I_BR) { const int n = r / 512, rr = r % 512, kb = rr / 32, nb = rr % 32; tr_item(p.in[25] + (size_t)(l * 4 + n) * DM * DM, DM, br_t, DM, kb * 64, nb * 32, n * 1024 + nb * 32, scr, lane); continue; } r -= I_BR;
        if (r < I_OUT) { const int kb = r / 32, nb = r % 32; tr_item(p.in[26] + (size_t)l * DM * DM, DM, out_t, DM, kb * 64, nb * 32, nb * 32, scr, lane); continue; } r -= I_OUT;
        if (r < I_FI) { const int nbn = 2 * FF / 32, kb = r / nbn, nb = r % nbn; const int c0 = nb * 32, bj = c0 / FF, j = c0 % FF, pn = j / 128, rr = j % 128;
            tr_item(p.in[27] + (size_t)l * DM * 2 * FF, 2 * FF, fi_t, DM, kb * 64, c0, 256 * pn + 128 * bj + rr, scr, lane); continue; } r -= I_FI;
        { const int kb = r / 32, nb = r % 32; tr_item(p.in[28] + (size_t)l * FF * DM, DM, fo_t, FF, kb * 64, nb * 32, nb * 32, scr, lane); }
    }
    if (l >= 1) {
        const float* Wv = p.in[4] + (size_t)l * DM * INW + 2048; const float* mu = p.in[5] + (size_t)l * 3328 + 2048; const float* v1 = p.in[12] + (size_t)(l - 1) * DM * 32;
        for (int k = gw; k < DM; k += NGW) {
            float wv[16], m1[16];
#pragma unroll
            for (int m = 0; m < 16; ++m) { const int c = lane + 64 * m; wv[m] = Wv[(size_t)k * INW + c]; m1[m] = mu[c]; }
            for (int j = 0; j < 32; ++j) {
                float e1 = 0.f, e2 = 0.f;
#pragma unroll
                for (int m = 0; m < 16; ++m) { const int c = lane + 64 * m; const float vv = v1[c * 32 + j] * wv[m]; e1 += vv * (1.f - m1[m]); e2 += vv * m1[m]; }
#pragma unroll
                for (int o = 1; o < 64; o <<= 1) { e1 += __shfl_xor(e1, o); e2 += __shfl_xor(e2, o); }
                if (lane == 0) { win_t[(size_t)(OFF_VLO + j) * DM + k] = (bf16_t)f2bf(e1); win_t[(size_t)(OFF_VLO + 32 + j) * DM + k] = (bf16_t)f2bf(e2); }
            }
        }
    }
}


constexpr int XLW = 320;
__device__ __forceinline__ void rwkv_lora_inputs(const KP& p, int l, int gw, int NGW, int lane) {
    const bf16_t* P = (const bf16_t*)(p.ws + WS_P); bf16_t* XLO = (bf16_t*)(p.ws + WS_Z);
    const float* mu = p.in[5] + (size_t)l * 3328 + 3072;
    float muv[4];
#pragma unroll
    for (int j = 0; j < 4; ++j) muv[j] = mu[lane + 64 * j];
    for (int m = gw; m < MMAIN + NMETA; m += NGW) {
        int prev; if (m < MMAIN) prev = ((m & (SEQ - 1)) == 0) ? MMAIN + NMETA - 1 : m - 1; else prev = (m == MMAIN) ? -1 : m - 1;
        const bf16_t* cr = P + (size_t)m * NP; const bf16_t* pr = P + (size_t)(prev < 0 ? m : prev) * NP; const float pz = prev < 0 ? 0.f : 1.f;
        float cur[4], prv[4];
#pragma unroll
        for (int j = 0; j < 4; ++j) { cur[j] = bf2f(cr[3072 + lane + 64 * j]); prv[j] = pz * bf2f(pr[3072 + lane + 64 * j]); }
        float vl = 0.f; if (lane < 32) vl = bf2f(cr[OFF_VLO + lane]) + pz * bf2f(pr[OFF_VLO + 32 + lane]);
        bf16_t* o = XLO + (size_t)m * XLW;
#pragma unroll
        for (int j = 0; j < 4; ++j) { const float val = cur[j] + (prv[j] - cur[j]) * muv[j]; float r_;
            if (j == 0) { const float e2 = __expf(2.f * val); r_ = 1.f - 2.f * __builtin_amdgcn_rcpf(e2 + 1.f); } else if (j == 1) r_ = val; else r_ = __builtin_amdgcn_rcpf(1.f + __expf(-val));
            o[lane + 64 * j] = (bf16_t)f2bf(r_); }
        if (lane < 32) o[256 + lane] = (bf16_t)f2bf(vl);
    }
}

__device__ __forceinline__ void rwkv_unit(const KP& p, int l, int b, int h, LAS unsigned char* lds, const int WAVE_U) {
    int tid = TIDX; asm volatile("" : "+v"(tid)); const int wave = __builtin_amdgcn_readfirstlane(tid >> 6); int lane = tid & 63, r = lane & 15, q = lane >> 4;
#define RELAUNDER() do { asm volatile("" : "+v"(tid)); lane = tid & 63; r = lane & 15; q = lane >> 4; l32 = lane & 31; thalf = lane >> 5; } while (0)
    const bf16_t* P = (const bf16_t*)(p.ws + WS_P);
    bf16_t* YS = (bf16_t*)(p.ws + WS_YS);
    bf16_t* VFG = (bf16_t*)(p.ws + WS_VF); const bf16_t* XLO = (const bf16_t*)(p.ws + WS_Z);
    const float* mu = p.in[5] + (size_t)l * 3328;
    const float* vec = p.in[9] + (size_t)l * 6 * DM;
    const float* rk = p.in[10] + (size_t)l * DM;
    const float* v0 = (l >= 1) ? p.in[11] + (size_t)(l - 1) * DM : nullptr;
    LAS bf16_t* W2T = (LAS bf16_t*)(lds + 0); LAS bf16_t* A2T = (LAS bf16_t*)(lds + 9216); LAS bf16_t* G2T = (LAS bf16_t*)(lds + 18432); LAS bf16_t* V2T = (LAS bf16_t*)(lds + 35840);
    LAS float* MU = (LAS float*)(lds + 40960); LAS float* W0L = (LAS float*)(lds + 42752); LAS float* A0L = W0L + 64; LAS float* V0L = A0L + 64;
    LAS float* BON = (LAS float*)(lds + 43520); LAS float* PC = (LAS float*)(lds + 43648);
    LAS float* RM = (LAS float*)(lds + 44160); LAS float* KM = RM + 2048; LAS float* VM = KM + 2048; LAS float* WD = VM + 2048; LAS float* AG = WD + 2048; LAS float* VG = AG + 2048; LAS float* GL = VG + 2048;
    LAS float* YY = RM; LAS float* KPp = KM; LAS float* VPp = VM; LAS float* APp = AG; LAS float* BPp = VG;
    constexpr int REG = 101504; constexpr int TS = 20;
    LAS bf16_t* RAW = (LAS bf16_t*)(lds + REG);
    LAS bf16_t* XW = (LAS bf16_t*)(lds + 140048); LAS bf16_t* XA = (LAS bf16_t*)(lds + 144656); LAS bf16_t* XG = (LAS bf16_t*)(lds + 149264); LAS bf16_t* XV = (LAS bf16_t*)(lds + 157968);
    constexpr int O_AT = 0, O_RT = 2304, O_BT = 4608, O_KT = 6912, O_BH = 9216, O_KH = 12288, O_VT = 15360, O_MAB = 18432, O_TT = 19712, OPB = 20480;
    { const float* w2g = p.in[6] + (size_t)l * 64 * DM + 64 * h; const float* a2g = p.in[7] + (size_t)l * 64 * DM + 64 * h; const float* g2g = p.in[8] + (size_t)l * 128 * DM + 64 * h;
      for (int idx = tid; idx < 64 * 64; idx += 512) { const int k = idx >> 6, n = idx & 63; W2T[n * 72 + k] = (bf16_t)f2bf(w2g[k * DM + n]); A2T[n * 72 + k] = (bf16_t)f2bf(a2g[k * DM + n]); }
      for (int idx = tid; idx < 128 * 64; idx += 512) { const int k = idx >> 6, n = idx & 63; G2T[n * 136 + k] = (bf16_t)f2bf(g2g[k * DM + n]); }
      if (l >= 1) { const float* v2g = p.in[13] + (size_t)(l - 1) * 32 * DM + 64 * h; for (int idx = tid; idx < 32 * 64; idx += 512) { const int k = idx >> 6, n = idx & 63; V2T[n * 40 + k] = (bf16_t)f2bf(v2g[k * DM + n]); } } }
    if (tid < 192) MU[tid] = mu[(tid >> 6) * 1024 + 64 * h + (tid & 63)];
    if (tid < 64) { W0L[tid] = vec[64 * h + tid]; A0L[tid] = vec[DM + 64 * h + tid]; V0L[tid] = l >= 1 ? v0[64 * h + tid] : 0.f; }
    f32x4 sT[4];
#pragma unroll
    for (int i = 0; i < 4; ++i) sT[i] = (f32x4){0.f, 0.f, 0.f, 0.f};
    int l32 = lane & 31, thalf = lane >> 5; const int hc0 = 64 * h + l32, hc1 = hc0 + 32;
    const float kk_c0 = vec[2 * DM + hc0], ka_c0 = vec[3 * DM + hc0], lnw_c0 = vec[4 * DM + hc0], lnb_c0 = vec[5 * DM + hc0], rk_c0 = rk[hc0];
    const float kk_c1 = vec[2 * DM + hc1], ka_c1 = vec[3 * DM + hc1], lnw_c1 = vec[4 * DM + hc1], lnb_c1 = vec[5 * DM + hc1], rk_c1 = rk[hc1];
    auto trow = [&](int t) -> size_t { return (size_t)row_of(b, t < 0 ? 0 : (t >= TT ? TT - 1 : t)); };
    constexpr int RS = 264;
    const int ra0 = tid, ra1 = tid + 512; const int rr0 = ra0 / 24, pc0 = ra0 % 24, rr1 = ra1 / 24, pc1 = ra1 % 24;
    const int gc0 = (pc0 >> 3) * 1024 + 64 * h + 8 * (pc0 & 7), gc1 = (pc1 >> 3) * 1024 + 64 * h + 8 * (pc1 & 7);
    int xtok[3], xpc[3], xdst[3];
#pragma unroll
    for (int j = 0; j < 3; ++j) { const int xa = tid + 512 * j; xtok[j] = xa / 36; xpc[j] = xa % 36; const int pc = xpc[j], tk = xtok[j];
        xdst[j] = pc < 8 ? 140048 + (tk * 72 + 8 * pc) * 2 : (pc < 16 ? 144656 + (tk * 72 + 8 * (pc - 8)) * 2 : (pc < 32 ? 149264 + (tk * 136 + 8 * (pc - 16)) * 2 : 157968 + (tk * 40 + 8 * (pc - 32)) * 2)); }
    u32x4 pfa0, pfa1, pfv, pfx0, pfx1, pfx2;
#define RWKV_PREFETCH(pn) do { const int t0_ = 32 * (pn) - 1; \
        pfa0 = *(const u32x4*)(P + trow(t0_ + rr0) * NP + gc0); if (t0_ + rr0 < 0) pfa0 = (u32x4){0u, 0u, 0u, 0u}; \
        if (ra1 < 792) pfa1 = *(const u32x4*)(P + trow(t0_ + rr1) * NP + gc1); \
        if (tid < 256) pfv = *(const u32x4*)(VFG + trow(t0_ + 1 + (tid >> 3)) * DM + 64 * h + 8 * (tid & 7)); \
        pfx0 = *(const u32x4*)(XLO + trow(t0_ + 1 + xtok[0]) * XLW + 8 * xpc[0]); pfx1 = *(const u32x4*)(XLO + trow(t0_ + 1 + xtok[1]) * XLW + 8 * xpc[1]); \
        if (tid < 128) pfx2 = *(const u32x4*)(XLO + trow(t0_ + 1 + xtok[2]) * XLW + 8 * xpc[2]); } while (0)
    pfa1 = (u32x4){0u, 0u, 0u, 0u}; pfv = pfa1; pfx2 = pfa1;
    RWKV_PREFETCH(0);
    __syncthreads();
    for (int pp = 0; pp < 129; ++pp) {
        *(LAS u32x4*)(RAW + rr0 * RS + 8 * pc0) = pfa0;
        if (ra1 < 792) *(LAS u32x4*)(RAW + rr1 * RS + 8 * pc1) = pfa1;
        if (tid < 256) *(LAS u32x4*)(RAW + (1 + (tid >> 3)) * RS + 192 + 8 * (tid & 7)) = pfv;
        *(LAS u32x4*)(lds + xdst[0]) = pfx0; *(LAS u32x4*)(lds + xdst[1]) = pfx1; if (tid < 128) *(LAS u32x4*)(lds + xdst[2]) = pfx2;
        if (pp + 1 < 129) RWKV_PREFETCH(pp + 1);
        BAR_LDS();
        RELAUNDER();
        typedef float f32x2 __attribute__((ext_vector_type(2)));
        { unsigned cwv[6], pwv[6]; f32x2 m2v[3];
#pragma unroll
          for (int pj = 0; pj < 6; ++pj) { const int grp = pj % 3, i = 4 * wave + 2 * (pj / 3) + thalf, col = 64 * grp + 2 * l32;
              cwv[pj] = *(const LAS unsigned*)(RAW + (i + 1) * RS + col); pwv[pj] = *(const LAS unsigned*)(RAW + i * RS + col); if (pj < 3) m2v[pj] = *(const LAS f32x2*)(MU + col); }
#pragma unroll
          for (int pj = 0; pj < 6; ++pj) { const int grp = pj % 3, i = 4 * wave + 2 * (pj / 3) + thalf;
              const unsigned cw = cwv[pj], pw = pwv[pj]; const f32x2 m2 = m2v[grp];
              const float c0 = __builtin_bit_cast(float, cw << 16), c1 = __builtin_bit_cast(float, cw & 0xffff0000u), p0 = __builtin_bit_cast(float, pw << 16), p1 = __builtin_bit_cast(float, pw & 0xffff0000u);
              LAS float* dst = grp == 0 ? RM : (grp == 1 ? KM : VM); *(LAS f32x2*)(dst + i * 64 + 2 * l32) = (f32x2){c0 + (p0 - c0) * m2.x, c1 + (p1 - c1) * m2.y}; } }
        RELAUNDER();
        { auto s2_tile = [&](int which, int mt, int nt) { f32x4 acc = (f32x4){0.f, 0.f, 0.f, 0.f};
            if (which == 0) { acc = mma32(ldfrag(XW + 16 * mt * 72, 72, r, q), ldfrag(W2T + nt * 16 * 72, 72, r, q), acc); acc = mma32(ldfrag(XW + 16 * mt * 72 + 32, 72, r, q), ldfrag(W2T + nt * 16 * 72 + 32, 72, r, q), acc); }
            else if (which == 1) { acc = mma32(ldfrag(XA + 16 * mt * 72, 72, r, q), ldfrag(A2T + nt * 16 * 72, 72, r, q), acc); acc = mma32(ldfrag(XA + 16 * mt * 72 + 32, 72, r, q), ldfrag(A2T + nt * 16 * 72 + 32, 72, r, q), acc); }
            else if (which == 2) {
#pragma unroll
                for (int ks = 0; ks < 4; ++ks) acc = mma32(ldfrag(XG + 16 * mt * 136 + 32 * ks, 136, r, q), ldfrag(G2T + nt * 16 * 136 + 32 * ks, 136, r, q), acc); }
            else { acc = mma32(ldfrag(XV + 16 * mt * 40, 40, r, q), ldfrag(V2T + nt * 16 * 40, 40, r, q), acc); }
            const int cc = 16 * nt + r;
#pragma unroll
            for (int j = 0; j < 4; ++j) { const int tok = 16 * mt + 4 * q + j; const float x = acc[j];
                if (which == 0) { const float ex = __expf(-(W0L[cc] + x)); WD[tok * 64 + cc] = __expf(-0.6065306597f * __builtin_amdgcn_rcpf(1.f + ex)); }
                else if (which == 1) AG[tok * 64 + cc] = __builtin_amdgcn_rcpf(1.f + __expf(-(A0L[cc] + x)));
                else if (which == 2) GL[tok * 64 + cc] = x;
                else VG[tok * 64 + cc] = __builtin_amdgcn_rcpf(1.f + __expf(-(V0L[cc] + x))); } };
          if (wave < 4) { const int which = wave >> 1;
#pragma unroll
              for (int mt = 0; mt < 2; ++mt)
#pragma unroll
                  for (int tnt = 0; tnt < 2; ++tnt) s2_tile(which, mt, 2 * (wave & 1) + tnt); }
          else { const int mtg = (wave - 4) >> 1;
#pragma unroll
              for (int tnt = 0; tnt < 2; ++tnt) s2_tile(2, mtg, 2 * (wave & 1) + tnt);
              if (l >= 1) {
#pragma unroll
                  for (int tnt = 0; tnt < 2; ++tnt) s2_tile(3, mtg, 2 * (wave & 1) + tnt); } } }
        BAR_LDS();
        RELAUNDER();
#pragma unroll
        for (int rep = 0; rep < 2; ++rep) { const int tok = 4 * wave + 2 * rep + thalf, e0 = tok * 64 + l32, e1 = e0 + 32;
          const float k0 = KM[e0], k1 = KM[e1], a0 = AG[e0], a1 = AG[e1], vv0 = VM[e0], vv1 = VM[e1], r0 = RM[e0], r1 = RM[e1];
          float kka = k0 * kk_c0, kkb = k1 * kk_c1; float n2 = kka * kka + kkb * kkb;
          const float kp0 = k0 * (1.f + (a0 - 1.f) * ka_c0), kp1 = k1 * (1.f + (a1 - 1.f) * ka_c1);
          float bo = r0 * kp0 * rk_c0 + r1 * kp1 * rk_c1;
          n2 = half_sum32(n2); bo = half_sum32(bo);
          const float inv = rsqrtf(fmaxf(n2, 1e-24f)); kka *= inv; kkb *= inv;
          float vp0 = vv0, vp1 = vv1;
          if (l >= 1) { vp0 = vv0 + (bf2f(RAW[(tok + 1) * RS + 192 + l32]) - vv0) * VG[e0]; vp1 = vv1 + (bf2f(RAW[(tok + 1) * RS + 224 + l32]) - vv1) * VG[e1]; }
          KPp[e0] = kp0; KPp[e1] = kp1; VPp[e0] = vp0; VPp[e1] = vp1; APp[e0] = -kka; APp[e1] = -kkb; BPp[e0] = kka * a0; BPp[e1] = kkb * a1; if (l32 == 0) BON[tok] = bo;
          const int t = 32 * pp + tok;
          if (l == 0 && t < TT) { bf16_t* vf = VFG + (size_t)row_of(b, t) * DM; vf[hc0] = (bf16_t)f2bf(vv0); vf[hc1] = (bf16_t)f2bf(vv1); } }
        BAR_LDS();
        RELAUNDER();
        { const int ch = wave >> 2, i0 = 4 * (wave & 3); LAS unsigned char* ob = lds + REG + ch * OPB;
          LAS bf16_t* AT_ = (LAS bf16_t*)(ob + O_AT); LAS bf16_t* RT_ = (LAS bf16_t*)(ob + O_RT); LAS bf16_t* BTl = (LAS bf16_t*)(ob + O_BT); LAS bf16_t* KTl = (LAS bf16_t*)(ob + O_KT);
          LAS bf16_t* BHt = (LAS bf16_t*)(ob + O_BH); LAS bf16_t* KHt = (LAS bf16_t*)(ob + O_KH); LAS bf16_t* VTt = (LAS bf16_t*)(ob + O_VT);
          float Pv[5]; float run = 1.f;
          const LAS float* wdp = WD + 16 * ch * 64 + lane; float wdv[16], pp[17];
#pragma unroll
          for (int j = 0; j < 16; ++j) wdv[j] = wdp[j * 64];
          pp[0] = 1.f;
#pragma unroll
          for (int j = 0; j < 16; ++j) pp[j + 1] = pp[j] * wdv[j];
          const int sel = wave & 3;
          if (sel == 0) { Pv[0] = pp[0]; Pv[1] = pp[1]; Pv[2] = pp[2]; Pv[3] = pp[3]; Pv[4] = pp[4]; }
          else if (sel == 1) { Pv[0] = pp[4]; Pv[1] = pp[5]; Pv[2] = pp[6]; Pv[3] = pp[7]; Pv[4] = pp[8]; }
          else if (sel == 2) { Pv[0] = pp[8]; Pv[1] = pp[9]; Pv[2] = pp[10]; Pv[3] = pp[11]; Pv[4] = pp[12]; }
          else { Pv[0] = pp[12]; Pv[1] = pp[13]; Pv[2] = pp[14]; Pv[3] = pp[15]; Pv[4] = pp[16]; }
          const float Pall = pp[16]; (void)run;
          float av[4], bv[4], kv[4], rv[4], vv[4];
#pragma unroll
          for (int tt = 0; tt < 4; ++tt) { const int e = (16 * ch + i0 + tt) * 64 + lane; av[tt] = APp[e]; bv[tt] = BPp[e]; kv[tt] = KPp[e]; rv[tt] = RM[e]; vv[tt] = VPp[e]; }
#pragma unroll
          for (int tt = 0; tt < 4; ++tt) { const int i = i0 + tt; const float Pi = Pv[1 + tt], Pp = Pv[tt]; const float ip = __builtin_amdgcn_rcpf(Pi), hp = Pall * ip;
              AT_[i * 72 + lane] = (bf16_t)f2bf(av[tt] * Pp); RT_[i * 72 + lane] = (bf16_t)f2bf(rv[tt] * Pi); BTl[i * 72 + lane] = (bf16_t)f2bf(bv[tt] * ip); KTl[i * 72 + lane] = (bf16_t)f2bf(kv[tt] * ip);
              BHt[lane * TS + i] = (bf16_t)f2bf(bv[tt] * hp); KHt[lane * TS + i] = (bf16_t)f2bf(kv[tt] * hp); VTt[lane * TS + i] = (bf16_t)f2bf(vv[tt]); }
          if ((wave & 3) == 0) PC[ch * 64 + lane] = Pall; }
        BAR_LDS();
        RELAUNDER();
        bf16x4 nrb4, rhs4, v4; f32x4 Y;
#define RWKV_PRE(ch) do { LAS unsigned char* ob = lds + REG + (ch) * OPB; \
            const LAS bf16_t* AT_ = (const LAS bf16_t*)(ob + O_AT); const LAS bf16_t* RT_ = (const LAS bf16_t*)(ob + O_RT); const LAS bf16_t* BTl = (const LAS bf16_t*)(ob + O_BT); const LAS bf16_t* KTl = (const LAS bf16_t*)(ob + O_KT); \
            const LAS bf16_t* VTt = (const LAS bf16_t*)(ob + O_VT); \
            f32x4 mk = (f32x4){0.f, 0.f, 0.f, 0.f}, nb = mk, nk = mk; \
            _Pragma("unroll") for (int ks = 0; ks < 2; ++ks) { const bf16x8 fa = ldfrag(AT_ + 32 * ks, 72, r, q), fr_ = ldfrag(RT_ + 32 * ks, 72, r, q), fb = ldfrag(BTl + 32 * ks, 72, r, q), fk = ldfrag(KTl + 32 * ks, 72, r, q); \
                mk = mma32(fk, fa, mk); nb = mma32(fb, fr_, nb); nk = mma32(fk, fr_, nk); } \
            _Pragma("unroll") for (int j = 0; j < 4; ++j) { const int s_ = 4 * q + j; if (!(s_ < r)) mk[j] = 0.f; if (!(s_ <= r)) { nb[j] = 0.f; nk[j] = 0.f; } } \
            const bf16x4 mak4 = cvt4(mk), nrk4 = cvt4(nk); nrb4 = cvt4(nb); \
            v4 = ldfrag4(VTt + 16 * wave * TS, TS, r, q); \
            bf16x4 sb[4]; \
            _Pragma("unroll") for (int kt = 0; kt < 4; ++kt) sb[kt] = cvt4(sT[kt]); \
            f32x4 RHS = (f32x4){0.f, 0.f, 0.f, 0.f}; Y = RHS; \
            RHS = mma16(mak4, v4, RHS); Y = mma16(nrk4, v4, Y); \
            _Pragma("unroll") for (int kt = 0; kt < 4; ++kt) { RHS = mma16(ldfrag4(AT_ + 16 * kt, 72, r, q), sb[kt], RHS); Y = mma16(ldfrag4(RT_ + 16 * kt, 72, r, q), sb[kt], Y); } \
            rhs4 = cvt4(RHS); } while (0)
#define RWKV_FIN(ch) do { LAS unsigned char* ob = lds + REG + (ch) * OPB; \
            const LAS bf16_t* BHt = (const LAS bf16_t*)(ob + O_BH); const LAS bf16_t* KHt = (const LAS bf16_t*)(ob + O_KH); const LAS bf16_t* TTm = (const LAS bf16_t*)(ob + O_TT); \
            f32x4 U = (f32x4){0.f, 0.f, 0.f, 0.f}; U = mma16(ldfrag4(TTm, 24, r, q), rhs4, U); \
            const bf16x4 ub = cvt4(U); \
            Y = mma16(nrb4, ub, Y); \
            _Pragma("unroll") for (int j = 0; j < 4; ++j) YY[(16 * (ch) + 4 * q + j) * 64 + 16 * wave + r] = Y[j]; \
            _Pragma("unroll") for (int kt = 0; kt < 4; ++kt) { const f32x4 pc4 = *(const LAS f32x4*)(PC + (ch) * 64 + 16 * kt + 4 * q); f32x4 s_ = sT[kt] * pc4; \
                s_ = mma16(ldfrag4(BHt + 16 * kt * TS, TS, r, q), ub, s_); s_ = mma16(ldfrag4(KHt + 16 * kt * TS, TS, r, q), v4, s_); sT[kt] = s_; } } while (0)
        if (wave == 4 || wave == 5) { LAS unsigned char* ob = lds + REG + (wave - 4) * OPB;
            const LAS bf16_t* AT_ = (const LAS bf16_t*)(ob + O_AT); const LAS bf16_t* BTl = (const LAS bf16_t*)(ob + O_BT); LAS bf16_t* TTm = (LAS bf16_t*)(ob + O_TT);
            const f32x4 z4 = (f32x4){0.f, 0.f, 0.f, 0.f}; f32x4 n = z4, nt = z4, eye;
#pragma unroll
            for (int ks = 0; ks < 2; ++ks) { const bf16x8 fa = ldfrag(AT_ + 32 * ks, 72, r, q), fb = ldfrag(BTl + 32 * ks, 72, r, q); n = mma32(fa, fb, n); nt = mma32(fb, fa, nt); }
#pragma unroll
            for (int j = 0; j < 4; ++j) { const int i_ = 4 * q + j; if (!(r < i_)) n[j] = 0.f; if (!(i_ < r)) nt[j] = 0.f; eye[j] = (i_ == r) ? 1.f : 0.f; }
            const bf16x4 nB = cvt4(n), nA = cvt4(nt);
            const f32x4 n2 = mma16(nA, nB, z4), n2t = mma16(nB, nA, z4); const bf16x4 n2B = cvt4(n2), n2A = cvt4(n2t);
            const f32x4 n4 = mma16(n2A, n2B, z4), n4t = mma16(n2B, n2A, z4); const bf16x4 n4B = cvt4(n4), n4A = cvt4(n4t);
            const f32x4 n3 = mma16(nA, n2B, z4), n3t = mma16(n2B, nA, z4);
            const f32x4 n8 = mma16(n4A, n4B, z4); const f32x4 n12 = mma16(n4A, cvt4(n8), z4);
            const f32x4 p1 = ((eye + n) + (n2 + n3)), p1t = ((eye + nt) + (n2t + n3t)), rr = (n4 + n8) + n12;
            const f32x4 tt = mma16(cvt4(p1t), cvt4(rr), p1);
#pragma unroll
            for (int j = 0; j < 4; ++j) TTm[(4 * q + j) * 24 + r] = (bf16_t)f2bf(tt[j]); }
        else if (wave < 4) RWKV_PRE(0);
        BAR_LDS();
        RELAUNDER();
        if (wave < 4) { RWKV_FIN(0); RWKV_PRE(1); RWKV_FIN(1); }
        BAR_LDS();
#undef RWKV_PRE
#undef RWKV_FIN
        RELAUNDER();
#pragma unroll
        for (int rep = 0; rep < 2; ++rep) { const int tok = 4 * wave + 2 * rep + thalf, e0 = tok * 64 + l32, e1 = e0 + 32; const float y0 = YY[e0], y1 = YY[e1];
          float s1 = y0 + y1, s2 = y0 * y0 + y1 * y1;
          s1 = half_sum32(s1); s2 = half_sum32(s2);
          const float mean = s1 * (1.f / 64.f), var = fmaxf(s2 * (1.f / 64.f) - mean * mean, 0.f), rs = rsqrtf(var + 64e-5f), bon = BON[tok];
          const float o0 = ((y0 - mean) * rs * lnw_c0 + lnb_c0 + bon * VPp[e0]) * GL[e0], o1 = ((y1 - mean) * rs * lnw_c1 + lnb_c1 + bon * VPp[e1]) * GL[e1];
          const int t = 32 * pp + tok;
          if (t < TT) { bf16_t* yo = YS + (size_t)row_of(b, t) * DM; yo[hc0] = (bf16_t)f2bf(o0); yo[hc1] = (bf16_t)f2bf(o1); } }
    }
#undef RWKV_PREFETCH
#undef RELAUNDER
    __syncthreads();
}

__device__ __forceinline__ int swz72(int row, int chunk) { return row * 72 + (((chunk ^ (row >> 3)) & 7) << 3); }
__device__ __forceinline__ void ssd_unit(const KP& p, int l, int b, int g, LAS unsigned char* lds, const int WAVE_U) {
    int tid = TIDX; asm volatile("" : "+v"(tid)); const int wave = __builtin_amdgcn_readfirstlane(tid >> 6); int lane = tid & 63, r = lane & 15, q = lane >> 4;
#define RELAUNDER() do { asm volatile("" : "+v"(tid)); lane = tid & 63; r = lane & 15; q = lane >> 4; } while (0)
    const bf16_t* P = (const bf16_t*)(p.ws + WS_P);
    bf16_t* YS1 = (bf16_t*)(p.ws + WS_YS) + (size_t)1 * MP * DM;
    const float* conv_w = p.in[14] + (size_t)l * 4 * 2048; const float* conv_b = p.in[15] + (size_t)l * 2048;
    const float* dt_bias = p.in[16] + l * 16; const float* a_log = p.in[17] + l * 16; const float* dsk = p.in[18] + l * 16; const float* normw = p.in[19] + (size_t)l * DM;
    LAS bf16_t* Cm = (LAS bf16_t*)(lds + 0); LAS bf16_t* Bm = (LAS bf16_t*)(lds + 17408); LAS bf16_t* BT = (LAS bf16_t*)(lds + 34816); LAS bf16_t* CB = (LAS bf16_t*)(lds + 53248);
    LAS bf16_t* XT = (LAS bf16_t*)(lds + 62464); LAS float* ACU = (LAS float*)(lds + 99328); LAS float* DTV = (LAS float*)(lds + 100352); LAS float* RED = (LAS float*)(lds + 101376); LAS bf16_t* YL = (LAS bf16_t*)(lds + 103424); (void)RED;
    const int e = wave >> 1, ptb = 2 * (wave & 1);
    f32x4 st[8][2];
#pragma unroll
    for (int i = 0; i < 8; ++i) { st[i][0] = (f32x4){0.f, 0.f, 0.f, 0.f}; st[i][1] = (f32x4){0.f, 0.f, 0.f, 0.f}; }
    const float De = dsk[4 * g + e];
    unsigned short dtraw = 0;
#define SSD_DT_PREFETCH(cn) do { if (tid < 256) { const int t = 64 * (cn) - 48 + (tid & 63); dtraw = P[(size_t)row_of(b, t >= 0 ? t : 0) * NP + OFF_SSM + 3072 + 4 * g + (tid >> 6)]; } } while (0)
    SSD_DT_PREFETCH(0);
    for (int c = 0; c < 65; ++c) {
        RELAUNDER();
        if (tid < 256) { const int ee = wave, t = 64 * c - 48 + lane; float dtv = 0.f;
            if (t >= 0) dtv = softplusf_(bf2f(dtraw) + dt_bias[4 * g + ee]);
            float a = -dtv * __expf(a_log[4 * g + ee]);
#pragma unroll
            for (int off = 1; off < 64; off <<= 1) { const float v = __shfl_up(a, off); if (lane >= off) a += v; }
            ACU[ee * 64 + lane] = a; DTV[ee * 64 + lane] = dtv; }
        { const int cgp = tid & 63, tg = tid >> 6;
          const int xbc_idx = cgp < 32 ? 256 * g + 8 * cgp : (cgp < 48 ? 1024 + 128 * g + 8 * (cgp - 32) : 1536 + 128 * g + 8 * (cgp - 48));
          const int pcol = OFF_SSM + 1024 + xbc_idx;
          typedef float f32x2 __attribute__((ext_vector_type(2)));
          f32x2 cw0[4], cw1[4], cw2[4], cw3[4], cb[4]; u32x4 raw[11]; unsigned pk[8][4];
          const int i0 = 8 * tg, t0 = 64 * c - 48 + i0;
#pragma unroll
          for (int j = 0; j < 11; ++j) { const int t = t0 - 3 + j; raw[j] = *(const u32x4*)(P + (size_t)row_of(b, t >= 0 ? t : 0) * NP + pcol); if (t < 0) raw[j] = (u32x4){0u, 0u, 0u, 0u}; }
#pragma unroll
          for (int m = 0; m < 4; ++m) { cw0[m] = *(const f32x2*)(conv_w + xbc_idx + 2 * m); cw1[m] = *(const f32x2*)(conv_w + 2048 + xbc_idx + 2 * m); cw2[m] = *(const f32x2*)(conv_w + 4096 + xbc_idx + 2 * m);
              cw3[m] = *(const f32x2*)(conv_w + 6144 + xbc_idx + 2 * m); cb[m] = *(const f32x2*)(conv_b + xbc_idx + 2 * m); }
#define UNPK2(RW, VV) do { const u32x4 rw_ = (RW); VV[0] = (f32x2){__builtin_bit_cast(float, rw_[0] << 16), __builtin_bit_cast(float, rw_[0] & 0xffff0000u)}; VV[1] = (f32x2){__builtin_bit_cast(float, rw_[1] << 16), __builtin_bit_cast(float, rw_[1] & 0xffff0000u)}; \
                           VV[2] = (f32x2){__builtin_bit_cast(float, rw_[2] << 16), __builtin_bit_cast(float, rw_[2] & 0xffff0000u)}; VV[3] = (f32x2){__builtin_bit_cast(float, rw_[3] << 16), __builtin_bit_cast(float, rw_[3] & 0xffff0000u)}; } while (0)
          f32x2 x0[4], x1[4], x2[4];
          UNPK2(raw[0], x0); UNPK2(raw[1], x1); UNPK2(raw[2], x2);
#pragma unroll
          for (int i2 = 0; i2 < 4; ++i2) { f32x2 oa[4], ob[4];
#pragma unroll
              for (int hh = 0; hh < 2; ++hh) { const int ii = 2 * i2 + hh, t = t0 + ii; f32x2 x3[4];
                  UNPK2(raw[ii + 3], x3);
#pragma unroll
                  for (int m = 0; m < 4; ++m) { const f32x2 z = cb[m] + cw0[m] * x0[m] + cw1[m] * x1[m] + cw2[m] * x2[m] + cw3[m] * x3[m]; f32x2 o;
                      o.x = z.x * __builtin_amdgcn_rcpf(1.f + __expf(-z.x)); o.y = z.y * __builtin_amdgcn_rcpf(1.f + __expf(-z.y)); if (t < 0) o = (f32x2){0.f, 0.f};
                      if (hh == 0) oa[m] = o; else ob[m] = o;
                      x0[m] = x1[m]; x1[m] = x2[m]; x2[m] = x3[m]; }
                  if (cgp >= 32) { const f32x2* o = hh == 0 ? oa : ob; u32x4 w; w.x = pk2(o[0].x, o[0].y); w.y = pk2(o[1].x, o[1].y); w.z = pk2(o[2].x, o[2].y); w.w = pk2(o[3].x, o[3].y);
                      if (cgp < 48) *(LAS u32x4*)(Bm + (i0 + ii) * 136 + 8 * (cgp - 32)) = w; else *(LAS u32x4*)(Cm + (i0 + ii) * 136 + 8 * (cgp - 48)) = w; } }
#pragma unroll
              for (int m = 0; m < 4; ++m) { pk[2 * m][i2] = pk2(oa[m].x, ob[m].x); pk[2 * m + 1][i2] = pk2(oa[m].y, ob[m].y); } }
#undef UNPK2
          if (cgp < 48) { LAS bf16_t* dstT = cgp < 32 ? XT : BT; const int rb = cgp < 32 ? 8 * cgp : 8 * (cgp - 32);
#pragma unroll
              for (int k = 0; k < 8; ++k) *(LAS u32x4*)(dstT + swz72(rb + k, tg)) = (u32x4){pk[k][0], pk[k][1], pk[k][2], pk[k][3]}; } }
        BAR_LDS();
        RELAUNDER();
        { const int mt = wave & 3;
#pragma unroll
          for (int tn = 0; tn < 2; ++tn) { const int nt = 2 * (wave >> 2) + tn; f32x4 acc = (f32x4){0.f, 0.f, 0.f, 0.f};
#pragma unroll
              for (int ks = 0; ks < 4; ++ks) acc = mma32(ldfrag(Cm + 16 * mt * 136 + 32 * ks, 136, r, q), ldfrag(Bm + 16 * nt * 136 + 32 * ks, 136, r, q), acc);
#pragma unroll
              for (int j = 0; j < 4; ++j) CB[(16 * mt + 4 * q + j) * 72 + 16 * nt + r] = (bf16_t)f2bf(acc[j]); } }
        BAR_LDS();
        RELAUNDER();
        SSD_DT_PREFETCH(c + 1 < 65 ? c + 1 : 64);
        f32x4 acc1[4][2];
#pragma unroll
        for (int lt = 0; lt < 4; ++lt) { acc1[lt][0] = (f32x4){0.f, 0.f, 0.f, 0.f}; acc1[lt][1] = acc1[lt][0]; }
        const LAS float* acu = ACU + e * 64; const LAS float* dtv = DTV + e * 64;
#pragma unroll
        for (int nt = 0; nt < 8; ++nt) { const bf16x4 sb0 = cvt4(st[nt][0]), sb1 = cvt4(st[nt][1]);
#pragma unroll
            for (int lt = 0; lt < 4; ++lt) { const bf16x4 a4 = ldfrag4(Cm + 16 * lt * 136 + 16 * nt, 136, r, q); acc1[lt][0] = mma16(a4, sb0, acc1[lt][0]); acc1[lt][1] = mma16(a4, sb1, acc1[lt][1]); }
            __builtin_amdgcn_sched_barrier(0); }
#pragma unroll
        for (int lt = 0; lt < 4; ++lt)
#pragma unroll
            for (int j = 0; j < 4; ++j) { const float ea = __expf(acu[16 * lt + 4 * q + j]); acc1[lt][0][j] *= ea; acc1[lt][1][j] *= ea; }
#pragma unroll
        for (int lt = 0; lt < 4; ++lt)
#pragma unroll
            for (int ks = 0; ks < 2; ++ks) { if (ks == 1 && lt < 2) continue;
                const bf16x8 fr0 = ldfrag(CB + 16 * lt * 72 + 32 * ks, 72, r, q); const int ll = 16 * lt + r; const float al = acu[ll]; float f[8];
                const f32x4 ac0 = *(const LAS f32x4*)(acu + 32 * ks + 8 * q), ac1 = *(const LAS f32x4*)(acu + 32 * ks + 8 * q + 4), dt0 = *(const LAS f32x4*)(dtv + 32 * ks + 8 * q), dt1 = *(const LAS f32x4*)(dtv + 32 * ks + 8 * q + 4);
#pragma unroll
                for (int i = 0; i < 8; ++i) { const int s = 32 * ks + 8 * q + i; const float as_ = i < 4 ? ac0[i & 3] : ac1[i & 3], ds_ = i < 4 ? dt0[i & 3] : dt1[i & 3]; f[i] = (s <= ll) ? __expf(al - as_) * ds_ : 0.f; }
                const bf16x8 fm = scale8(fr0, f);
#pragma unroll
                for (int pt = 0; pt < 2; ++pt) acc1[lt][pt] = mma32(fm, *(const LAS bf16x8*)(XT + swz72(64 * e + 16 * (ptb + pt) + r, 4 * ks + q)), acc1[lt][pt]);
                __builtin_amdgcn_sched_barrier(0); }
#pragma unroll
        for (int lt = 0; lt < 4; ++lt)
#pragma unroll
            for (int j = 0; j < 4; ++j) { const int ll = 16 * lt + 4 * q + j;
#pragma unroll
                for (int pt = 0; pt < 2; ++pt) { const int pp = 16 * (ptb + pt) + r; YL[ll * 264 + 64 * e + pp] = (bf16_t)f2bf(acc1[lt][pt][j] + De * bf2f(XT[swz72(64 * e + pp, ll >> 3) + (ll & 7)])); } }
        u32x4 zreg[4];
#pragma unroll
        for (int rep = 0; rep < 4; ++rep) { const int idx = tid + 512 * rep, ll = idx >> 5, grp = idx & 31, t = 64 * c - 48 + ll;
            zreg[rep] = *(const u32x4*)(P + (size_t)row_of(b, t >= 0 ? t : 0) * NP + OFF_SSM + 256 * g + 8 * grp); }
        { const float a63 = acu[63], sc = __expf(a63); bf16x8 fx[2][2];
#pragma unroll
          for (int pt = 0; pt < 2; ++pt)
#pragma unroll
              for (int ks = 0; ks < 2; ++ks) { float f[8];
                  const f32x4 ac0 = *(const LAS f32x4*)(acu + 32 * ks + 8 * q), ac1 = *(const LAS f32x4*)(acu + 32 * ks + 8 * q + 4), dt0 = *(const LAS f32x4*)(dtv + 32 * ks + 8 * q), dt1 = *(const LAS f32x4*)(dtv + 32 * ks + 8 * q + 4);
#pragma unroll
                  for (int i = 0; i < 8; ++i) { const float as_ = i < 4 ? ac0[i & 3] : ac1[i & 3], ds_ = i < 4 ? dt0[i & 3] : dt1[i & 3]; f[i] = __expf(a63 - as_) * ds_; }
                  fx[pt][ks] = scale8(*(const LAS bf16x8*)(XT + swz72(64 * e + 16 * (ptb + pt) + r, 4 * ks + q)), f); }
#pragma unroll
          for (int nt = 0; nt < 8; ++nt) { const bf16x8 b0 = *(const LAS bf16x8*)(BT + swz72(16 * nt + r, q)), b1 = *(const LAS bf16x8*)(BT + swz72(16 * nt + r, 4 + q));
#pragma unroll
              for (int pt = 0; pt < 2; ++pt) { f32x4 s_ = st[nt][pt] * sc; s_ = mma32(b0, fx[pt][0], s_); s_ = mma32(b1, fx[pt][1], s_); st[nt][pt] = s_; }
              __builtin_amdgcn_sched_barrier(0); } }
        BAR_LDS();
        RELAUNDER();
#pragma unroll
        for (int rep = 0; rep < 4; ++rep) { const int idx = tid + 512 * rep, ll = idx >> 5, grp = idx & 31, t = 64 * c - 48 + ll; float y[8], zz[8];
            unpack8(*(const LAS u32x4*)(YL + ll * 264 + 8 * grp), y);
            const size_t row = (size_t)row_of(b, t >= 0 ? t : 0);
            unpack8(zreg[rep], zz);
            float ss = 0.f;
#pragma unroll
            for (int k = 0; k < 8; ++k) { y[k] *= siluf_(zz[k]); ss += y[k] * y[k]; }
            ss += __shfl_xor(ss, 1); ss += __shfl_xor(ss, 2); ss += __shfl_xor(ss, 4); ss += __shfl_xor(ss, 8); ss += __shfl_xor(ss, 16);
            const float rs = rsqrtf(ss * (1.f / 256.f) + 1e-5f); const float* nwp = normw + 256 * g + 8 * grp;
            u32x4 w; w.x = pk2(y[0] * rs * nwp[0], y[1] * rs * nwp[1]); w.y = pk2(y[2] * rs * nwp[2], y[3] * rs * nwp[3]); w.z = pk2(y[4] * rs * nwp[4], y[5] * rs * nwp[5]); w.w = pk2(y[6] * rs * nwp[6], y[7] * rs * nwp[7]);
            if (t >= 0) *(u32x4*)(YS1 + row * DM + 256 * g + 8 * grp) = w; }
        BAR_LDS();
    }
}
#undef RELAUNDER
#undef SSD_DT_PREFETCH

__device__ __forceinline__ void ret_unit(const KP& p, int b, int h, LAS unsigned char* lds, const int WAVE_U) {
    int tid_ = TIDX; asm volatile("" : "+v"(tid_)); const int tid = tid_, wave = __builtin_amdgcn_readfirstlane(tid >> 6), lane = tid & 63, r = lane & 15, q = lane >> 4;
    const bf16_t* P = (const bf16_t*)(p.ws + WS_P);
    bf16_t* YS2 = (bf16_t*)(p.ws + WS_YS) + (size_t)2 * MP * DM;
    LAS bf16_t* Q = (LAS bf16_t*)(lds + 0); LAS bf16_t* K = (LAS bf16_t*)(lds + 9216); LAS bf16_t* KT = (LAS bf16_t*)(lds + 18432); LAS bf16_t* VT = (LAS bf16_t*)(lds + 27648);
    LAS bf16_t* CB = (LAS bf16_t*)(lds + 46080); LAS bf16_t* YL = (LAS bf16_t*)(lds + 57344);
    const float lg0 = log2f(1.f - exp2f(-5.f - (float)h));
    f32x4 st[4];
#pragma unroll
    for (int i = 0; i < 4; ++i) st[i] = (f32x4){0.f, 0.f, 0.f, 0.f};
    const int f_ = tid & 31, it = tid >> 5; const float freq = powf(10000.f, -(float)f_ / 32.f);
    float lg = lg0;
    for (int c = 0; c < 65; ++c) {
        asm volatile("" : "+v"(lg));
        u32x4 greg[2];
#pragma unroll
        for (int rep = 0; rep < 2; ++rep) { const int idx = tid + 512 * rep, ll = idx >> 4, grp = idx & 15, t = 64 * c - 48 + ll;
            greg[rep] = *(const u32x4*)(P + (size_t)row_of(b, t >= 0 ? t : 0) * NP + OFF_RET + 2048 + 128 * h + 8 * grp); }
#pragma unroll
        for (int rep = 0; rep < 4; ++rep) { const int i = it + 16 * rep, t = 64 * c - 48 + i; float qa = 0.f, qb = 0.f, ka = 0.f, kb = 0.f;
            { const bf16_t* pr = P + (size_t)row_of(b, t >= 0 ? t : 0) * NP + OFF_RET + 64 * h + f_; const float vz = t >= 0 ? 1.f : 0.f; const float q1 = vz * bf2f(pr[0]), q2 = vz * bf2f(pr[32]), k1 = vz * bf2f(pr[512]), k2 = vz * bf2f(pr[544]);
                double rv = (double)((float)t * freq) * 0.15915494309189535; rv -= __builtin_rint(rv); const float rf = (float)rv; const float sn = __builtin_amdgcn_sinf(rf), cs = __builtin_amdgcn_cosf(rf); qa = q1 * cs - q2 * sn; qb = q2 * cs + q1 * sn; ka = (k1 * cs - k2 * sn) * 0.125f; kb = (k2 * cs + k1 * sn) * 0.125f; }
            Q[i * 72 + f_] = (bf16_t)f2bf(qa); Q[i * 72 + 32 + f_] = (bf16_t)f2bf(qb); const bf16_t kab = (bf16_t)f2bf(ka), kbb = (bf16_t)f2bf(kb);
            K[i * 72 + f_] = kab; K[i * 72 + 32 + f_] = kbb; KT[f_ * 72 + i] = kab; KT[(f_ + 32) * 72 + i] = kbb; }
#pragma unroll
        for (int rep = 0; rep < 2; ++rep) { const int idx = tid + 512 * rep, i = idx >> 4, grp = idx & 15, t = 64 * c - 48 + i; u32x4 w = (u32x4){0u, 0u, 0u, 0u};
            w = *(const u32x4*)(P + (size_t)row_of(b, t >= 0 ? t : 0) * NP + OFF_RET + 1024 + 128 * h + 8 * grp); if (t < 0) w = (u32x4){0u, 0u, 0u, 0u};
            LAS bf16_t* d = VT + (8 * grp) * 72 + i;
            d[0] = (bf16_t)(w.x & 0xffffu); d[72] = (bf16_t)(w.x >> 16); d[144] = (bf16_t)(w.y & 0xffffu); d[216] = (bf16_t)(w.y >> 16);
            d[288] = (bf16_t)(w.z & 0xffffu); d[360] = (bf16_t)(w.z >> 16); d[432] = (bf16_t)(w.w & 0xffffu); d[504] = (bf16_t)(w.w >> 16); }
        BAR_LDS();
        { const int mt = wave & 3;
#pragma unroll
          for (int tn = 0; tn < 2; ++tn) { const int nt = 2 * (wave >> 2) + tn; f32x4 acc = (f32x4){0.f, 0.f, 0.f, 0.f};
#pragma unroll
              for (int ks = 0; ks < 2; ++ks) acc = mma32(ldfrag(Q + 16 * mt * 72 + 32 * ks, 72, r, q), ldfrag(K + 16 * nt * 72 + 32 * ks, 72, r, q), acc);
#pragma unroll
              for (int j = 0; j < 4; ++j) CB[(16 * mt + 4 * q + j) * 72 + 16 * nt + r] = (bf16_t)f2bf(acc[j]); } }
        BAR_LDS();
        f32x4 acc1[4];
#pragma unroll
        for (int lt = 0; lt < 4; ++lt) acc1[lt] = (f32x4){0.f, 0.f, 0.f, 0.f};
#pragma unroll
        for (int dt = 0; dt < 4; ++dt) { const bf16x4 sb = cvt4(st[dt]);
#pragma unroll
            for (int lt = 0; lt < 4; ++lt) acc1[lt] = mma16(ldfrag4(Q + 16 * lt * 72 + 16 * dt, 72, r, q), sb, acc1[lt]); }
#pragma unroll
        for (int lt = 0; lt < 4; ++lt)
#pragma unroll
            for (int j = 0; j < 4; ++j) acc1[lt][j] *= __builtin_amdgcn_exp2f((float)(16 * lt + 4 * q + j + 1) * lg);
#pragma unroll
        for (int lt = 0; lt < 4; ++lt)
#pragma unroll
            for (int ks = 0; ks < 2; ++ks) { if (ks == 1 && lt < 2) continue;
                const int ll = 16 * lt + r; float f[8];
#pragma unroll
                for (int i = 0; i < 8; ++i) { const int s = 32 * ks + 8 * q + i; f[i] = (s <= ll) ? __builtin_amdgcn_exp2f((float)(ll - s) * lg) : 0.f; }
                acc1[lt] = mma32(scale8(ldfrag(CB + 16 * lt * 72 + 32 * ks, 72, r, q), f), ldfrag(VT + 16 * wave * 72 + 32 * ks, 72, r, q), acc1[lt]); }
#pragma unroll
        for (int lt = 0; lt < 4; ++lt)
#pragma unroll
            for (int j = 0; j < 4; ++j) YL[(16 * lt + 4 * q + j) * 136 + 16 * wave + r] = (bf16_t)f2bf(acc1[lt][j]);
        { const float sc = __builtin_amdgcn_exp2f(64.f * lg); bf16x8 fv[2];
#pragma unroll
          for (int ks = 0; ks < 2; ++ks) { float f[8];
#pragma unroll
              for (int i = 0; i < 8; ++i) f[i] = __builtin_amdgcn_exp2f((float)(63 - (32 * ks + 8 * q + i)) * lg);
              fv[ks] = scale8(ldfrag(VT + 16 * wave * 72 + 32 * ks, 72, r, q), f); }
#pragma unroll
          for (int dt = 0; dt < 4; ++dt) { f32x4 s_ = st[dt] * sc; s_ = mma32(ldfrag(KT + 16 * dt * 72, 72, r, q), fv[0], s_); s_ = mma32(ldfrag(KT + 16 * dt * 72 + 32, 72, r, q), fv[1], s_); st[dt] = s_; } }
        BAR_LDS();
#pragma unroll
        for (int rep = 0; rep < 2; ++rep) { const int idx = tid + 512 * rep, ll = idx >> 4, grp = idx & 15, t = 64 * c - 48 + ll; float y[8], gg[8];
            unpack8(*(const LAS u32x4*)(YL + ll * 136 + 8 * grp), y);
            const size_t row = (size_t)row_of(b, t >= 0 ? t : 0);
            unpack8(greg[rep], gg);
            float ss = 0.f;
#pragma unroll
            for (int k = 0; k < 8; ++k) ss += y[k] * y[k];
            ss += __shfl_xor(ss, 1); ss += __shfl_xor(ss, 2); ss += __shfl_xor(ss, 4); ss += __shfl_xor(ss, 8);
            const float rs = rsqrtf(ss * (1.f / 128.f) + 1e-6f);
            u32x4 w; w.x = pk2(siluf_(gg[0]) * y[0] * rs, siluf_(gg[1]) * y[1] * rs); w.y = pk2(siluf_(gg[2]) * y[2] * rs, siluf_(gg[3]) * y[3] * rs);
            w.z = pk2(siluf_(gg[4]) * y[4] * rs, siluf_(gg[5]) * y[5] * rs); w.w = pk2(siluf_(gg[6]) * y[6] * rs, siluf_(gg[7]) * y[7] * rs);
            if (t >= 0) *(u32x4*)(YS2 + row * DM + 128 * h + 8 * grp) = w; }
        BAR_LDS();
    }
}

__device__ __forceinline__ void lru_unit(const KP& p, int l, int b, int n, int hf, LAS unsigned char* lds, const int WAVE_U) {
    int tid_ = TIDX; asm volatile("" : "+v"(tid_)); const int tid = tid_, wave = __builtin_amdgcn_readfirstlane(tid >> 6), lane = tid & 63, r = lane & 15, q = lane >> 4;
    const bf16_t* P = (const bf16_t*)(p.ws + WS_P);
    bf16_t* YS3 = (bf16_t*)(p.ws + WS_YS) + (size_t)3 * MP * DM;
    const float* conv_w = p.in[20] + (size_t)l * 4 * DM; const float* conv_b = p.in[21] + (size_t)l * DM;
    const float* wg = p.in[22] + (size_t)l * 2 * 8 * 128 * 128; const float* bg = p.in[23] + (size_t)l * 2 * DM; const float* lam = p.in[24] + (size_t)l * DM;
    LAS bf16_t* WGT = (LAS bf16_t*)(lds + 0); LAS bf16_t* XC = (LAS bf16_t*)(lds + 34816); LAS float* AA = (LAS float*)(lds + 52224); LAS float* UU = (LAS float*)(lds + 68608);
    LAS float* SEG = (LAS float*)(lds + 84992); LAS float* CAR = (LAS float*)(lds + 89088);
    for (int idx = tid; idx < 2 * 64 * 128; idx += 512) { const int k = idx >> 13, rem = idx & 8191, cc = rem >> 6, e = rem & 63;
        WGT[(k * 64 + e) * 136 + cc] = (bf16_t)f2bf(wg[((size_t)(k * 8 + n) * 128 + cc) * 128 + 64 * hf + e]); }
    if (tid < 64) CAR[tid] = 0.f;
    const int cgp = tid & 15, tg = tid >> 4, cb8 = 128 * n + 8 * cgp, pcol = OFF_LRU + 1024 + cb8;
    const int chs = 128 * n + 64 * hf + (tid & 63), seg = tid >> 6;
    __syncthreads();
    for (int c = 0; c < 65; ++c) {
        unsigned short yin[8];
#pragma unroll
        for (int i = 0; i < 8; ++i) { const int t = 64 * c - 48 + 8 * seg + i; yin[i] = P[(size_t)row_of(b, t >= 0 ? t : 0) * NP + OFF_LRU + chs]; }
        { float cw0[8], cw1[8], cw2[8], cw3[8], cb[8]; u32x4 raw[5];
          const int i0 = 2 * tg, t0 = 64 * c - 48 + i0;
#pragma unroll
          for (int j = 0; j < 5; ++j) { const int t = t0 - 3 + j; raw[j] = *(const u32x4*)(P + (size_t)row_of(b, t >= 0 ? t : 0) * NP + pcol); if (t < 0) raw[j] = (u32x4){0u, 0u, 0u, 0u}; }
#pragma unroll
          for (int k = 0; k < 8; ++k) { cw0[k] = conv_w[cb8 + k]; cw1[k] = conv_w[DM + cb8 + k]; cw2[k] = conv_w[2 * DM + cb8 + k]; cw3[k] = conv_w[3 * DM + cb8 + k]; cb[k] = conv_b[cb8 + k]; }
#pragma unroll
          for (int ii = 0; ii < 2; ++ii) { const int t = t0 + ii, i = i0 + ii; float x0[8], x1[8], x2[8], x3[8], o[8];
              unpack8(raw[ii], x0); unpack8(raw[ii + 1], x1); unpack8(raw[ii + 2], x2); unpack8(raw[ii + 3], x3);
#pragma unroll
              for (int k = 0; k < 8; ++k) { const float z = cb[k] + cw0[k] * x0[k] + cw1[k] * x1[k] + cw2[k] * x2[k] + cw3[k] * x3[k]; o[k] = t >= 0 ? z : 0.f; }
              u32x4 w; w.x = pk2(o[0], o[1]); w.y = pk2(o[2], o[3]); w.z = pk2(o[4], o[5]); w.w = pk2(o[6], o[7]);
              *(LAS u32x4*)(XC + i * 136 + 8 * cgp) = w; } }
        BAR_LDS();
        { const int lt = wave & 3;
#pragma unroll
          for (int te = 0; te < 2; ++te) { const int et = 2 * (wave >> 2) + te; f32x4 a0 = (f32x4){0.f, 0.f, 0.f, 0.f}, a1 = a0;
#pragma unroll
              for (int ks = 0; ks < 4; ++ks) { const bf16x8 xa = ldfrag(XC + 16 * lt * 136 + 32 * ks, 136, r, q);
                  a0 = mma32(xa, ldfrag(WGT + (16 * et) * 136 + 32 * ks, 136, r, q), a0); a1 = mma32(xa, ldfrag(WGT + (64 + 16 * et) * 136 + 32 * ks, 136, r, q), a1); }
              const int e = 16 * et + r, chn = 128 * n + 64 * hf + e; const float b0 = bg[chn], b1 = bg[DM + chn], spl = softplusf_(-lam[chn]);
#pragma unroll
              for (int j = 0; j < 4; ++j) { const int tok = 16 * lt + 4 * q + j, t = 64 * c - 48 + tok;
                  const float rg = sigmoidf_(a0[j] + b0), ig = sigmoidf_(a1[j] + b1), la = -8.f * rg * spl; float a = __expf(la), u = __builtin_amdgcn_sqrtf(fmaxf(1.f - __expf(2.f * la), 0.f)) * ig * bf2f(XC[tok * 136 + 64 * hf + e]);
                  if (t < 0) { a = 1.f; u = 0.f; }
                  AA[tok * 64 + e] = a; UU[tok * 64 + e] = u; } } }
        BAR_LDS();
        { const int ch = tid & 63; float A = 1.f, H = 0.f;
#pragma unroll
          for (int i = 0; i < 8; ++i) { const float a = AA[(8 * seg + i) * 64 + ch], u = UU[(8 * seg + i) * 64 + ch]; H = a * H + u; A *= a; }
          SEG[(seg * 64 + ch) * 2] = A; SEG[(seg * 64 + ch) * 2 + 1] = H;
          BAR_LDS();
          float hcar = CAR[ch];
          { float sa[7], sh[7];
#pragma unroll
            for (int s2 = 0; s2 < 7; ++s2) { sa[s2] = SEG[(s2 * 64 + ch) * 2]; sh[s2] = SEG[(s2 * 64 + ch) * 2 + 1]; }
#pragma unroll
            for (int s2 = 0; s2 < 7; ++s2) if (s2 < seg) hcar = sa[s2] * hcar + sh[s2]; }
#pragma unroll
          for (int i = 0; i < 8; ++i) { const int tok = 8 * seg + i, t = 64 * c - 48 + tok; hcar = AA[tok * 64 + ch] * hcar + UU[tok * 64 + ch];
              if (t >= 0) { const size_t row = (size_t)row_of(b, t); const float x = bf2f(yin[i]);
                  const float tu = 0.7978845608f * (x + 0.044715f * x * x * x); const float ge = 0.5f * x * (2.f - 2.f * __builtin_amdgcn_rcpf(1.f + __expf(2.f * tu)));
                  YS3[row * DM + chs] = (bf16_t)f2bf(hcar * ge); } }
          BAR_LDS();
          if (seg == 7) CAR[ch] = hcar; }
        BAR_LDS();
    }
}


__device__ __forceinline__ f32x4 skinny_tile(const bf16_t* A, const bf16_t* Bt, int K, int j, LAS unsigned char* lds, int wave, int lane) {
    const int r = lane & 15, q = lane >> 4; f32x4 acc[4];
#pragma unroll
    for (int nt = 0; nt < 4; ++nt) acc[nt] = (f32x4){0.f, 0.f, 0.f, 0.f};
    const bf16_t* ap = A + (size_t)(MMAIN + r) * K + 8 * q; const bf16_t* bp = Bt + (size_t)(64 * j + r) * K + 8 * q;
    const int nks = K / 32;
    for (int ks = wave; ks < nks; ks += 8) { const bf16x8 a = *(const bf16x8*)(ap + 32 * ks);
#pragma unroll
        for (int nt = 0; nt < 4; ++nt) acc[nt] = mma32(a, *(const bf16x8*)(bp + (size_t)16 * nt * K + 32 * ks), acc[nt]); }
    LAS f32x4* red = (LAS f32x4*)lds;
#pragma unroll
    for (int nt = 0; nt < 4; ++nt) red[(wave * 4 + nt) * 64 + lane] = acc[nt];
    __syncthreads();
    f32x4 tot = (f32x4){0.f, 0.f, 0.f, 0.f};
    if (wave < 4) {
#pragma unroll
        for (int w = 0; w < 8; ++w) tot += red[(w * 4 + wave) * 64 + lane]; }
    __syncthreads();
    return tot;
}
__device__ __forceinline__ void skinny_branch(const bf16_t* YS, const bf16_t* br_t, const bf16_t* P, float* Z, bf16_t* ZB, int j, LAS unsigned char* lds, const int WAVE_U) {
    int tid = TIDX; asm volatile("" : "+v"(tid)); const int wave = __builtin_amdgcn_readfirstlane(tid >> 6), lane = tid & 63, r = lane & 15, q = lane >> 4;
    for (int n = 0; n < 4; ++n) {
        const f32x4 acc = skinny_tile(YS + (size_t)n * MP * DM, br_t + (size_t)n * 1024 * DM, DM, j, lds, wave, lane);
        if (wave < 4) { const int col = 64 * j + 16 * wave + r;
#pragma unroll
            for (int jj = 0; jj < 4; ++jj) { const size_t row = MMAIN + 4 * q + jj; float v = sigmoidf_(bf2f(P[row * NP + OFF_GATE + n * 1024 + col])) * acc[jj];
                if (n != 0) v += Z[row * DM + col];
                if (n != 3) Z[row * DM + col] = v; else ZB[row * DM + col] = (bf16_t)f2bf(v); } }
    }
}
__device__ __forceinline__ void skinny_resid(const bf16_t* A, const bf16_t* Bt, int K, float* S, bf16_t* HN, const float* nw, float* ssq, int j, LAS unsigned char* lds, const int WAVE_U) {
    int tid = TIDX; asm volatile("" : "+v"(tid)); const int wave = __builtin_amdgcn_readfirstlane(tid >> 6), lane = tid & 63, r = lane & 15, q = lane >> 4;
    const f32x4 acc = skinny_tile(A, Bt, K, j, lds, wave, lane);
    LAS float* part = (LAS float*)lds;
    if (wave < 4) { const int col = 64 * j + 16 * wave + r; const float w = nw[col];
#pragma unroll
        for (int jj = 0; jj < 4; ++jj) { const size_t row = MMAIN + 4 * q + jj; const float sn = S[row * DM + col] + acc[jj]; S[row * DM + col] = sn; HN[row * DM + col] = (bf16_t)f2bf(sn * w);
            float ss = sn * sn; ss = DPP_ADD(ss, 0xB1); ss = DPP_ADD(ss, 0x4E); ss = DPP_ADD(ss, 0x141); ss = DPP_ADD(ss, 0x140);
            if (r == 0) part[wave * 16 + 4 * q + jj] = ss; } }
    __syncthreads();
    if (tid < 16) ssq[(size_t)(MMAIN + tid) * 16 + j] = (part[tid] + part[16 + tid]) + (part[32 + tid] + part[48 + tid]);
    __syncthreads();
}


#define XB_TMO      128
#define XB_XCNT(j)  (256  + 64 * (j))
#define XB_XSUB(j)  (1280 + 64 * (j))
#define XB_XGEN(j)  (2304 + 64 * (j))
#define XB_TOP      3328
#define XB_TOPGEN   3392
#define XCD_BAR_WORDS 3456
#define XB_SPIN_CAP (1u << 20)
__device__ __forceinline__ unsigned xb_ld(unsigned* p)              { return __hip_atomic_load(p, __ATOMIC_RELAXED, __HIP_MEMORY_SCOPE_AGENT); }
__device__ __forceinline__ unsigned xb_add(unsigned* p, unsigned v) { return __hip_atomic_fetch_add(p, v, __ATOMIC_RELAXED, __HIP_MEMORY_SCOPE_AGENT); }
__device__ __forceinline__ unsigned xb_xcc_id() { return (unsigned)__builtin_amdgcn_s_getreg((3 << 11) | 20) & 0xFu; }
#define XB_SPIN(cond, bar) do { unsigned _sp = 0; while (cond) { __builtin_amdgcn_s_sleep(1); \
    if ((++_sp & 255u) == 0u) { if (xb_ld(&(bar)[XB_TMO])) break; if (_sp > XB_SPIN_CAP) { atomicAdd(&(bar)[XB_TMO], 1u); break; } } } } while (0)
struct XcdBarrier { unsigned* bar; unsigned x; volatile LAS unsigned* st; };
__device__ __forceinline__ XcdBarrier xcd_barrier_post(unsigned* bar, volatile LAS unsigned* st, const int WAVE_U) {
    XcdBarrier b; b.bar = bar; b.x = (unsigned)__builtin_amdgcn_readfirstlane((int)xb_xcc_id()); b.st = st;
    if (TIDX == 0) (void)xb_add(&bar[XB_XCNT(b.x)], 1u);
    return b;
}
__device__ __forceinline__ void xcd_barrier_complete(unsigned* bar, unsigned x, unsigned& nloc, unsigned& nx) {
    const unsigned G = gridDim.x * gridDim.y * gridDim.z;
    unsigned sum, cnt, mine, sp = 0u;
    for (;;) {
        sum = 0u; cnt = 0u; mine = 0u;
#pragma unroll
        for (unsigned j = 0; j < 16; ++j) { const unsigned c = xb_ld(&bar[XB_XCNT(j)]); sum += c; cnt += (c > 0u) ? 1u : 0u; mine = (j == x) ? c : mine; }
        if (sum == G) break;
        __builtin_amdgcn_s_sleep(1);
        if ((++sp & 255u) == 0u) { if (xb_ld(&bar[XB_TMO])) break; if (sp > XB_SPIN_CAP) { atomicAdd(&bar[XB_TMO], 1u); break; } }
    }
    nloc = mine > 0u ? mine : 1u; nx = cnt > 0u ? cnt : 1u;
}
__device__ __forceinline__ void xcd_barrier(const XcdBarrier& b, const int WAVE_U) {
    asm volatile("s_waitcnt vmcnt(0)" ::: "memory");
    __syncthreads();
    if (TIDX == 0) {
        unsigned* bar = b.bar;
        __builtin_amdgcn_s_waitcnt(0);
        unsigned nloc = b.st[0], nx = b.st[1];
        if (nloc == 0u) { xcd_barrier_complete(bar, b.x, nloc, nx); b.st[0] = nloc; b.st[1] = nx; }
        const unsigned old = xb_add(&bar[XB_XSUB(b.x)], 1u);
        const unsigned gen = old / nloc;
        if (old + 1u == (gen + 1u) * nloc) {
            __builtin_amdgcn_fence(__ATOMIC_RELEASE, "agent");
            asm volatile("s_waitcnt vmcnt(0)" ::: "memory");
            const unsigned og = xb_add(&bar[XB_TOP], 1u);
            const unsigned tg = og / nx;
            if (og + 1u == (tg + 1u) * nx) xb_add(&bar[XB_TOPGEN], 1u);
            else XB_SPIN(xb_ld(&bar[XB_TOPGEN]) == tg, bar);
            __builtin_amdgcn_fence(__ATOMIC_ACQUIRE, "agent");
            xb_add(&bar[XB_XGEN(b.x)], 1u);
            asm volatile("s_waitcnt vmcnt(0)" ::: "memory");
        } else {
            XB_SPIN(xb_ld(&bar[XB_XGEN(b.x)]) == gen, bar);
            __builtin_amdgcn_fence(__ATOMIC_ACQUIRE, "agent");
            asm volatile("s_waitcnt vmcnt(0)" ::: "memory");
        }
    }
    __syncthreads();
}


__device__ __forceinline__ void subgrid_arrive(unsigned* word, const int WAVE_U) {
    asm volatile("s_waitcnt vmcnt(0)" ::: "memory");
    __syncthreads();
    if (TIDX == 0) { __builtin_amdgcn_fence(__ATOMIC_RELEASE, "agent"); asm volatile("s_waitcnt vmcnt(0)" ::: "memory"); (void)xb_add(word, 1u); }
}
__device__ __forceinline__ void subgrid_wait(unsigned* word, unsigned nblocks, const int WAVE_U) {
    if (TIDX == 0) { unsigned sp = 0u; while (xb_ld(word) < nblocks) { __builtin_amdgcn_s_sleep(1); if (++sp > (1u << 22)) break; }
        __builtin_amdgcn_fence(__ATOMIC_ACQUIRE, "agent"); asm volatile("s_waitcnt vmcnt(0)" ::: "memory"); }
    __syncthreads();
}
__device__ __forceinline__ void subgrid_barrier(unsigned* word, unsigned nblocks, const int WAVE_U) {
    asm volatile("s_waitcnt vmcnt(0)" ::: "memory");
    __syncthreads();
    if (TIDX == 0) {
        __builtin_amdgcn_fence(__ATOMIC_RELEASE, "agent");
        asm volatile("s_waitcnt vmcnt(0)" ::: "memory");
        (void)xb_add(word, 1u);
        unsigned sp = 0u;
        while (xb_ld(word) < nblocks) { __builtin_amdgcn_s_sleep(1); if (++sp > (1u << 22)) break; }
        __builtin_amdgcn_fence(__ATOMIC_ACQUIRE, "agent");
        asm volatile("s_waitcnt vmcnt(0)" ::: "memory");
    }
    __syncthreads();
}

#ifndef REP_P1
#define REP_P1 1
#endif
#ifndef REP_RWKV
#define REP_RWKV 1
#endif
#ifndef REP_SSD
#define REP_SSD 1
#endif
#ifndef REP_RET
#define REP_RET 1
#endif
#ifndef REP_LRU
#define REP_LRU 1
#endif
#ifndef PH_MASK
#define PH_MASK 1023
#endif
constexpr int LDS_BYTES = 160768;
constexpr int NUNITS = 176;

__global__ void __launch_bounds__(512, 2) fwd_megakernel(KP p) {
    extern __shared__ __attribute__((aligned(16))) unsigned char lds_raw[];
    LAS unsigned char* lds = (LAS unsigned char*)lds_raw;
    cg::grid_group grid = cg::this_grid();
    const int WAVE_U = __builtin_amdgcn_readfirstlane((int)(threadIdx.x >> 6));
    constexpr int G = 256; int bx = blockIdx.x; constexpr int NGW = G * 8;
#define FRESH_TID() int tid_ = TIDX; asm volatile("" : "+v"(tid_)); const int tid = tid_, wave = tid >> 6, lane = tid & 63, gw = bx * 8 + wave; (void)gw; (void)lane
    float* ssq = (float*)(p.ws + WS_SSQ); float* S = (float*)(p.ws + WS_S); bf16_t* HN = (bf16_t*)(p.ws + WS_HN); bf16_t* P = (bf16_t*)(p.ws + WS_P);
    bf16_t* YS = (bf16_t*)(p.ws + WS_YS); float* Z = (float*)(p.ws + WS_Z); bf16_t* ZB = (bf16_t*)(p.ws + WS_ZB); bf16_t* WIN = (bf16_t*)(p.ws + WS_WIN);
    bf16_t* H = (bf16_t*)(p.ws + WS_P);
    {
        FRESH_TID();
        const float* nw0 = p.in[2];
        for (int m = gw; m < MP; m += NGW) {
            const float* src = m < MMAIN ? p.in[0] + (size_t)m * DM : (m < MMAIN + NMETA ? p.in[1] + (size_t)(m - MMAIN) * DM : nullptr);
            float ss = 0.f;
#pragma unroll
            for (int j = 0; j < 4; ++j) { const int col = 4 * lane + 256 * j; f32x4 v = (f32x4){0.f, 0.f, 0.f, 0.f}; if (src) v = *(const f32x4*)(src + col);
                *(f32x4*)(S + (size_t)m * DM + col) = v; const f32x4 w = *(const f32x4*)(nw0 + col);
                u32x2 o; o.x = pk2(v[0] * w[0], v[1] * w[1]); o.y = pk2(v[2] * w[2], v[3] * w[3]); *(u32x2*)(HN + (size_t)m * DM + col) = o;
                ss += (v[0] * v[0] + v[1] * v[1]) + (v[2] * v[2] + v[3] * v[3]); }
#pragma unroll
            for (int o = 1; o < 64; o <<= 1) ss += __shfl_xor(ss, o);
            if (lane < 16) ssq[(size_t)m * 16 + lane] = lane == 0 ? ss : 0.f;
        }
        for (int i = bx * 512 + tid; i < (NP - INW) * DM / 8; i += G * 512) ((u32x4*)(WIN + (size_t)INW * DM))[i] = (u32x4){0u, 0u, 0u, 0u};
        convert_layer(p, 0, lds, gw, NGW, wave, lane);
        if (bx == 0) for (int i = tid; i < XCD_BAR_WORDS + 512; i += 512) ((unsigned*)(p.ws + WS_XBAR))[i] = 0u;
        if (tid == 0) { ((volatile LAS unsigned*)(lds + LDS_BYTES - 16))[0] = 0u; ((volatile LAS unsigned*)(lds + LDS_BYTES - 16))[1] = 0u; }
    }
    grid.sync();
    XcdBarrier xbar = xcd_barrier_post((unsigned*)(p.ws + WS_XBAR), (volatile LAS unsigned*)(lds + LDS_BYTES - 16), WAVE_U);
    for (int l_ = 0; l_ < NLAYER; ++l_) {
        int l = l_; asm volatile("" : "+s"(l)); asm volatile("" : "+s"(bx));
        unsigned char* sm = p.ws + WS_WSM + (size_t)(l & 1) * WSM_SIZE;
        const bf16_t* br_t = (const bf16_t*)(sm + WSM_BR); const bf16_t* out_t = (const bf16_t*)(sm + WSM_OUT); const bf16_t* fi_t = (const bf16_t*)(sm + WSM_FI); const bf16_t* fo_t = (const bf16_t*)(sm + WSM_FO);
        if (PH_MASK & 1) for (int rp = 0; rp < REP_P1; ++rp) { pg8::Gemm g{HN, WIN, DM}; pg8::RemapOrder So; So.b.init(NTM, PT_A + 1, G, bx); So.from = PT_A; So.to = NP / 256 - 1; pg8::EpiInProj E{P, ssq + (size_t)(2 * l) * MP * 16, 0}; pg8::gemm_phase(lds, g, So, E, WAVE_U); }
        xcd_barrier(xbar, WAVE_U);
        asm volatile("" : "+s"(bx));
        { FRESH_TID(); rwkv_lora_inputs(p, l, gw, NGW, lane); }
        xcd_barrier(xbar, WAVE_U);
        asm volatile("" : "+s"(bx));
        {
            int l = l_; asm volatile("" : "+s"(l));
            if (bx < 64) rwkv_unit(p, l, bx >> 4, bx & 15, lds, WAVE_U);
            else if (bx < 80) ssd_unit(p, l, (bx - 64) >> 2, (bx - 64) & 3, lds, WAVE_U);
            else {
                { pg8::Gemm g{HN, WIN + (size_t)PT_A * 256 * DM, DM}; pg8::StaticOrder So; So.init(NTM, GT0 - PT_A, G - 80, bx - 80);
                  pg8::EpiInProj E{P, ssq + (size_t)(2 * l) * MP * 16, PT_A}; pg8::gemm_phase(lds, g, So, E, WAVE_U); }
                unsigned* sbw = (unsigned*)(p.ws + WS_XBAR) + XCD_BAR_WORDS + 64 + 64 * l;
                subgrid_arrive(sbw, WAVE_U);
                if (bx < 176) subgrid_wait(sbw, (unsigned)(G - 80), WAVE_U);
                if (bx < 112) ret_unit(p, (bx - 80) >> 3, (bx - 80) & 7, lds, WAVE_U);
                else if (bx < 176) { const int v = bx - 112; lru_unit(p, l, v >> 4, (v >> 1) & 7, v & 1, lds, WAVE_U); }
                else { { pg8::Gemm g{HN, (const bf16_t*)(p.ws + WS_WING + (size_t)(l & 1) * WING_SIZE), DM}; pg8::StaticOrder So; So.init(NTM, GTN, G - 176, bx - 176);
                         pg8::EpiInProj E{P, ssq + (size_t)(2 * l) * MP * 16, GT0}; pg8::gemm_phase(lds, g, So, E, WAVE_U); }
                       subgrid_wait(sbw, (unsigned)(G - 80), WAVE_U);
                       if (l_ + 1 < NLAYER) { FRESH_TID(); convert_layer(p, l + 1, lds, (bx - 176) * 8 + wave, (G - 176) * 8, wave, lane); } }
            }
        }
        xcd_barrier(xbar, WAVE_U);
        asm volatile("" : "+s"(bx));
        if (PH_MASK & 32) { pg8::Gemm g{YS, br_t, DM}; pg8::BranchOrder So{G, bx}; pg8::EpiBranch E{P, Z, ZB}; pg8::gemm_phase(lds, g, So, E, WAVE_U);
          if (bx < 16) skinny_branch(YS, br_t, P, Z, ZB, bx, lds, WAVE_U); }
        xcd_barrier(xbar, WAVE_U);
        asm volatile("" : "+s"(bx));
        if (PH_MASK & 64) { pg8::Gemm g{ZB, out_t, DM}; pg8::StaticOrder So; So.init(NTM - 1, 4, G, bx); pg8::EpiResid E{S, HN, p.in[3] + (size_t)l * DM, ssq + (size_t)(2 * l + 1) * MP * 16}; pg8::gemm_phase(lds, g, So, E, WAVE_U);
          if (bx < 16) skinny_resid(ZB, out_t, DM, S, HN, p.in[3] + (size_t)l * DM, ssq + (size_t)(2 * l + 1) * MP * 16, bx, lds, WAVE_U); }
        xcd_barrier(xbar, WAVE_U);
        asm volatile("" : "+s"(bx));
        if (PH_MASK & 128) { pg8::Gemm g{HN, fi_t, DM}; pg8::StaticOrder So; So.init(NTM, 2 * FF / 256, G, bx); pg8::EpiSwiglu E{H, ssq + (size_t)(2 * l + 1) * MP * 16}; pg8::gemm_phase(lds, g, So, E, WAVE_U); }
        xcd_barrier(xbar, WAVE_U);
        asm volatile("" : "+s"(bx));
        if (PH_MASK & 256) { pg8::Gemm g{H, fo_t, FF}; pg8::StaticOrder So; So.init(NTM - 1, 4, G, bx); const float* nwn = (l + 1 < NLAYER) ? p.in[2] + (size_t)(l + 1) * DM : p.in[29];
          pg8::EpiResid E{S, HN, nwn, ssq + (size_t)(2 * l + 2) * MP * 16}; pg8::gemm_phase(lds, g, So, E, WAVE_U);
          if (bx < 16) skinny_resid(H, fo_t, FF, S, HN, nwn, ssq + (size_t)(2 * l + 2) * MP * 16, bx, lds, WAVE_U); }
        xcd_barrier(xbar, WAVE_U);
        asm volatile("" : "+s"(bx));
    }
    { FRESH_TID(); const float* fw = p.in[29]; const float* sq = ssq + (size_t)8 * MP * 16;
      for (int m = gw; m < MMAIN; m += NGW) { const float rs = rsqrtf(ssq_total(sq, m) * (1.f / 1024.f) + 1e-6f);
#pragma unroll
          for (int j = 0; j < 4; ++j) { const int col = 4 * lane + 256 * j; const f32x4 v = *(const f32x4*)(S + (size_t)m * DM + col), w = *(const f32x4*)(fw + col);
              *(f32x4*)(p.out + (size_t)m * DM + col) = v * rs * w; } } }
}

extern "C" void kernel_launch(void* const* d_in, const int* in_sizes, int n_in, void* d_out, int out_size, void* d_ws, size_t ws_size, hipStream_t stream) {
    static int grid = 0;
    if (grid == 0) {
        if (n_in != 30 || ws_size < WS_END) { fprintf(stderr, "kernel_launch: unexpected n_in %d / ws %zu (need %zu)\n", n_in, ws_size, (size_t)WS_END); grid = -1; return; }
        int dev = 0, cus = 0, per_cu = 0;
        hipGetDevice(&dev); hipDeviceGetAttribute(&cus, hipDeviceAttributeMultiprocessorCount, dev);
        hipFuncSetAttribute((const void*)fwd_megakernel, hipFuncAttributeMaxDynamicSharedMemorySize, LDS_BYTES);
        hipOccupancyMaxActiveBlocksPerMultiprocessor(&per_cu, (const void*)fwd_megakernel, 512, LDS_BYTES);
        if (per_cu < 1) { fprintf(stderr, "kernel_launch: occupancy query says %d blocks/CU\n", per_cu); per_cu = 1; }
        (void)hipGetLastError();
        grid = 256;
        if (cus < 256) { fprintf(stderr, "kernel_launch: this kernel needs 256 CUs (got %d)\n", cus); grid = -1; return; }
    }
    if (grid < 0) return;
    KP p{};
    for (int i = 0; i < 30; ++i) p.in[i] = (const float*)d_in[i];
    p.out = (float*)d_out; p.ws = (unsigned char*)d_ws;
    void* args[] = {&p};
    hipError_t e = hipLaunchCooperativeKernel((const void*)fwd_megakernel, dim3(grid), dim3(512), args, LDS_BYTES, stream);
    if (e != hipSuccess) fprintf(stderr, "cooperative launch failed: %s (grid %d)\n", hipGetErrorString(e), grid);
}
```

```cpp
#include <hip/hip_runtime.h>
#include <hip/hip_cooperative_groups.h>
#include <cstdio>
#include <cstdint>
namespace cg = cooperative_groups;

#define LAS __attribute__((address_space(3)))
typedef unsigned short bf16_t;
typedef short bf16x8 __attribute__((ext_vector_type(8)));
typedef short bf16x4 __attribute__((ext_vector_type(4)));
typedef float f32x4 __attribute__((ext_vector_type(4)));
typedef unsigned u32x4 __attribute__((ext_vector_type(4)));
typedef unsigned u32x2 __attribute__((ext_vector_type(2)));

constexpr int DM = 1024, NB = 4, SEQ = 4096, NMETA = 16, TT = SEQ + NMETA;
constexpr int MMAIN = NB * SEQ;
constexpr int MP = 16640, NTM = MP / 256;
constexpr int INW = 15632, NP = 15872;
constexpr int OFF_SSM = 3328, OFF_RET = 6416, OFF_LRU = 9488, OFF_GATE = 11536, OFF_VLO = 15632;
constexpr int FF = 2816;
constexpr int NLAYER = 4;

constexpr size_t WS_SSQ = 0;
constexpr size_t WS_XBAR = 12u << 20;
constexpr size_t WS_S = 16u << 20;
constexpr size_t WS_HN = WS_S + (size_t)MP * DM * 4;
constexpr size_t WS_P = WS_HN + (size_t)MP * DM * 2;
constexpr size_t WS_YS = WS_P + (size_t)MP * NP * 2;
constexpr size_t WS_VF = WS_YS + (size_t)4 * MP * DM * 2;
constexpr size_t WS_Z = WS_VF + (size_t)MP * DM * 2;
constexpr size_t WS_ZB = WS_Z + (size_t)MP * DM * 4;
constexpr size_t WS_WIN = WS_ZB + (size_t)MP * DM * 2;
constexpr size_t WSM_BR = 0, WSM_OUT = (size_t)4096 * 1024 * 2, WSM_FI = WSM_OUT + (size_t)1024 * 1024 * 2,
                 WSM_FO = WSM_FI + (size_t)2 * FF * 1024 * 2, WSM_SIZE = WSM_FO + (size_t)1024 * FF * 2;
constexpr size_t WS_WSM = WS_WIN + (size_t)NP * DM * 2;
constexpr int PT_A = 26;
constexpr int GT0 = 46, GTN = 15;
constexpr size_t WS_WING = WS_WSM + 2 * WSM_SIZE, WING_SIZE = (size_t)GTN * 256 * DM * 2;
constexpr size_t WS_END = WS_WING + 2 * WING_SIZE;
static_assert(WS_END <= 1024458752ull, "workspace map exceeds 4 x w_in bytes");

typedef float f32x2_t __attribute__((ext_vector_type(2))); typedef __bf16 bf16x2_t __attribute__((ext_vector_type(2)));
__device__ __forceinline__ unsigned pk2(float lo, float hi) { f32x2_t v = {lo, hi}; bf16x2_t b = __builtin_convertvector(v, bf16x2_t); return __builtin_bit_cast(unsigned, b); }
__device__ __forceinline__ unsigned f2bf(float f) { return pk2(f, f); }
__device__ __forceinline__ float bf2f(unsigned h) { return __builtin_bit_cast(float, h << 16); }
__device__ __forceinline__ float sigmoidf_(float x) { return __builtin_amdgcn_rcpf(1.f + __expf(-x)); }
__device__ __forceinline__ float softplusf_(float x) { return x > 20.f ? x : log1pf(__expf(x)); }
__device__ __forceinline__ float siluf_(float x) { return x * __builtin_amdgcn_rcpf(1.f + __expf(-x)); }
__device__ __forceinline__ int row_of(int b, int t) { return t < NMETA ? MMAIN + t : b * SEQ + (t - NMETA); }
__device__ __forceinline__ void unpack8(u32x4 w, float* f) {
    f[0] = bf2f(w.x & 0xffffu); f[1] = bf2f(w.x >> 16); f[2] = bf2f(w.y & 0xffffu); f[3] = bf2f(w.y >> 16);
    f[4] = bf2f(w.z & 0xffffu); f[5] = bf2f(w.z >> 16); f[6] = bf2f(w.w & 0xffffu); f[7] = bf2f(w.w >> 16);
}
__device__ __forceinline__ float dpp_f(float x, const int ctrl_is_const_only) { return x; }
#define DPP_ADD(x, ctrl) ((x) + __builtin_bit_cast(float, __builtin_amdgcn_update_dpp(0, __builtin_bit_cast(int, (x)), (ctrl), 0xf, 0xf, true)))
__device__ __forceinline__ float half_sum32(float x) { x = DPP_ADD(x, 0xB1); x = DPP_ADD(x, 0x4E); x = DPP_ADD(x, 0x141); x = DPP_ADD(x, 0x140); x += __shfl_xor(x, 16); return x; }
#define TIDX ((void)WAVE_U, (int)threadIdx.x)
#define LDS_WAIT() asm volatile("s_waitcnt lgkmcnt(0)" ::: "memory")
#ifndef REP_A
#define REP_A 1
#endif
#ifndef REP_B
#define REP_B 1
#endif
#define BAR_LDS() asm volatile("s_waitcnt lgkmcnt(0)\n\ts_barrier" ::: "memory")
__device__ __forceinline__ float ssq_total(const float* ssq, int row) {
    const f32x4 a = *(const f32x4*)(ssq + (size_t)row * 16), b = *(const f32x4*)(ssq + (size_t)row * 16 + 4), c = *(const f32x4*)(ssq + (size_t)row * 16 + 8), d = *(const f32x4*)(ssq + (size_t)row * 16 + 12);
    return (((a[0] + a[1]) + (a[2] + a[3])) + ((b[0] + b[1]) + (b[2] + b[3]))) + (((c[0] + c[1]) + (c[2] + c[3])) + ((d[0] + d[1]) + (d[2] + d[3])));
}

namespace pg8 {
constexpr int BM = 256, BK = 64, HALF = 128, HTB = HALF * BK * 2, STAGE_BYTES = 8 * HTB, NXCD = 8, WGM = 8;
__host__ __device__ __forceinline__ int lds_byte(int r, int c) { const int st = (r >> 4) * 2 + (c >> 5), rr = r & 15, cc = c & 31, ob = rr * 64 + cc * 2; return st * 1024 + (ob ^ (((ob >> 9) & 1) << 5)); }
__host__ __device__ __forceinline__ void stage_rc(int b, int& R, int& C) { const int st = b / 1024, sb = b % 1024, swz = sb ^ (((sb >> 9) & 1) << 5); R = (st >> 1) * 16 + swz / 64; C = (st & 1) * 32 + (swz % 64) / 2; }
__host__ __device__ __forceinline__ int perm32(int rho) { const int n = rho >> 4, i = rho & 15; return 8 * (i >> 2) + 4 * n + (i & 3); }
struct Unit { int pm, pn; };
struct Gemm { const bf16_t* A; const bf16_t* Bt; int K; };
struct StaticOrder {
    int nM, nN, nwg, G, c;
    __device__ void init(int nM_, int nN_, int G_, int c_) { nM = nM_; nN = nN_; nwg = nM * nN; G = G_; c = c_; }
    __device__ bool next(int i, Unit& u) const {
        const long L = (long)i * G + c; if (L >= nwg) return false;
        int wgid = (int)L; { const int q = nwg / NXCD, r = nwg % NXCD, xcd = wgid % NXCD, off = wgid / NXCD; wgid = (xcd < r ? xcd * (q + 1) : r * (q + 1) + (xcd - r) * q) + off; }
        const int nig = WGM * nN, gid = wgid / nig, fm = gid * WGM, gsz = (nM - fm) < WGM ? (nM - fm) : WGM;
        u.pm = fm + ((wgid % nig) % gsz); u.pn = (wgid % nig) / gsz; return true;
    }
};
struct RemapOrder { StaticOrder b; int from, to;
    __device__ bool next(int i, Unit& u) const { if (!b.next(i, u)) return false; if (u.pn == from) u.pn = to; return true; } };
struct BranchOrder {
    int G, c;
    __device__ bool next(int i, Unit& u) const {
        const int su = (i >> 2) * G + c, n = i & 3; if (su >= (NTM - 1) * 4) return false;
        u.pm = n * NTM + (su >> 2); u.pn = n * 4 + (su & 3); return true;
    }
};

template <class Epi, class Sched>
__device__ __forceinline__ void gemm_phase(LAS unsigned char* lds, const Gemm g, const Sched& S, const Epi& E, const int WAVE_U) {
    int tid_ = TIDX; asm volatile("" : "+v"(tid_)); const int tid = tid_, wid = __builtin_amdgcn_readfirstlane(tid >> 6), lane = tid & 63, wr = wid >> 2, wc = wid & 3, fr = lane & 15, fq = lane >> 4;
    const int K = g.K, nt = K / BK;
    unsigned voffA[2], voffB[2];
#pragma unroll
    for (int i = 0; i < 2; ++i) { int R, C; stage_rc(tid * 16 + i * 8192, R, C); const int Rb = (R & ~31) + perm32(R & 31);
        voffA[i] = (unsigned)(R * K + C) * 2u; voffB[i] = (unsigned)(Rb * K + C) * 2u; }
    const size_t kstep = (size_t)(BK * 2);
    const size_t hstep = (size_t)HALF * K * 2;
    const size_t tstep = 2 * hstep;
    const unsigned ldsw = (unsigned)wid * 1024u;
    const int aoff = lds_byte(wr * 64 + fr, fq * 8), boff = lds_byte(wc * 32 + fr, fq * 8);
#define PG8_SA(b, h) (((b) * 2 + (h)) * HTB)
#define PG8_SB(b, h) ((4 + (b) * 2 + (h)) * HTB)
#define PG8_STAGE(bufoff, gbase, voff) do { _Pragma("unroll") for (int _i = 0; _i < 2; ++_i) \
        __builtin_amdgcn_global_load_lds((const unsigned*)((const char*)(gbase) + (voff)[_i]), (LAS unsigned*)(lds + (bufoff) + ldsw + _i * 8192), 16, 0, 0); } while (0)
#define PG8_LDA(dst, b, h) do { _Pragma("unroll") for (int m = 0; m < 4; ++m) _Pragma("unroll") for (int k = 0; k < 2; ++k) dst[m][k] = *(const LAS bf16x8*)(lds + PG8_SA(b, h) + aoff + m * 2048 + k * 1024); } while (0)
#define PG8_LDB(dst, b, h) do { _Pragma("unroll") for (int n = 0; n < 2; ++n) _Pragma("unroll") for (int k = 0; k < 2; ++k) dst[n][k] = *(const LAS bf16x8*)(lds + PG8_SB(b, h) + boff + n * 2048 + k * 1024); } while (0)
#define PG8_MMA(ai, bj, At, Bt) do { __builtin_amdgcn_s_setprio(1); _Pragma("unroll") for (int m = 0; m < 4; ++m) _Pragma("unroll") for (int n = 0; n < 2; ++n) _Pragma("unroll") for (int k = 0; k < 2; ++k) \
        acc[ai][bj][m][n] = __builtin_amdgcn_mfma_f32_16x16x32_bf16(Bt[n][k], At[m][k], acc[ai][bj][m][n], 0, 0, 0); __builtin_amdgcn_s_setprio(0); } while (0)
#define PG8_WAIT_V(n) asm volatile("s_waitcnt vmcnt(" #n ")" ::: "memory")
#define PG8_WAIT_L(n) asm volatile("s_waitcnt lgkmcnt(" #n ")" ::: "memory")
#define PG8_BAR __builtin_amdgcn_s_barrier()
#define PG8_SCHED __builtin_amdgcn_sched_barrier(0)
    Unit cur, nxt; int ui = 0;
    if (!S.next(0, cur)) return;
    f32x4 acc[2][2][4][2];
#pragma unroll
    for (int a = 0; a < 2; ++a)
#pragma unroll
        for (int b = 0; b < 2; ++b)
#pragma unroll
            for (int m = 0; m < 4; ++m)
#pragma unroll
                for (int n = 0; n < 2; ++n) acc[a][b][m][n] = (f32x4){0.f, 0.f, 0.f, 0.f};
    bf16x8 At[4][2], B0[2][2], B1[2][2];
    const char* cA = (const char*)g.A + (size_t)cur.pm * tstep; const char* cB = (const char*)g.Bt + (size_t)cur.pn * tstep;
    PG8_STAGE(PG8_SB(0, 0), cB, voffB); PG8_STAGE(PG8_SB(0, 1), cB + hstep, voffB); PG8_STAGE(PG8_SA(0, 0), cA, voffA); PG8_STAGE(PG8_SA(0, 1), cA + hstep, voffA);
    if (wr == 1) PG8_BAR;
    PG8_WAIT_V(2); PG8_BAR;
    PG8_STAGE(PG8_SB(1, 0), cB + kstep, voffB); PG8_STAGE(PG8_SA(1, 0), cA + kstep, voffA); PG8_STAGE(PG8_SB(1, 1), cB + hstep + kstep, voffB);
    PG8_WAIT_V(6); PG8_BAR;
    for (;;) {
        const bool has_next = S.next(ui + 1, nxt);
        const char* nA = has_next ? (const char*)g.A + (size_t)nxt.pm * tstep : cA; const char* nB = has_next ? (const char*)g.Bt + (size_t)nxt.pn * tstep : cB;
        for (int t = 0; t < nt; t += 2) {
            const bool last = (t == nt - 2);
            const char* a1 = cA + (size_t)(t + 1) * kstep;
            const char* a2 = last ? nA : cA + (size_t)(t + 2) * kstep; const char* b2 = last ? nB : cB + (size_t)(t + 2) * kstep;
            const char* a3 = a2 + kstep; const char* b3 = b2 + kstep;
            PG8_LDB(B0, 0, 0); PG8_LDB(B1, 0, 1); PG8_SCHED; PG8_LDA(At, 0, 0); PG8_STAGE(PG8_SA(1, 1), a1 + hstep, voffA);
            PG8_WAIT_V(8); PG8_WAIT_L(0); PG8_BAR; PG8_MMA(0, 0, At, B0); PG8_MMA(0, 1, At, B1); PG8_BAR; PG8_SCHED;
            PG8_LDA(At, 0, 1); PG8_STAGE(PG8_SB(0, 0), b2, voffB); PG8_STAGE(PG8_SB(0, 1), b2 + hstep, voffB); PG8_STAGE(PG8_SA(0, 0), a2, voffA);
            PG8_WAIT_V(8); PG8_WAIT_L(0); PG8_BAR; PG8_MMA(1, 0, At, B0); PG8_MMA(1, 1, At, B1); PG8_BAR; PG8_SCHED;
            PG8_LDB(B0, 1, 0); PG8_LDB(B1, 1, 1); PG8_SCHED; PG8_LDA(At, 1, 0); PG8_STAGE(PG8_SA(0, 1), a2 + hstep, voffA);
            PG8_WAIT_V(8); PG8_WAIT_L(0); PG8_BAR; PG8_MMA(0, 0, At, B0); PG8_MMA(0, 1, At, B1); PG8_BAR; PG8_SCHED;
            PG8_LDA(At, 1, 1); PG8_STAGE(PG8_SB(1, 0), b3, voffB); PG8_STAGE(PG8_SB(1, 1), b3 + hstep, voffB); PG8_STAGE(PG8_SA(1, 0), a3, voffA);
            PG8_WAIT_V(8); PG8_WAIT_L(0); PG8_BAR; PG8_MMA(1, 0, At, B0); PG8_MMA(1, 1, At, B1); PG8_BAR; PG8_SCHED;
        }
        if (wr == 0) PG8_BAR;
        E(acc, cur, wr, wc, fr, fq);
        if (!has_next) break;
#pragma unroll
        for (int a = 0; a < 2; ++a)
#pragma unroll
            for (int b = 0; b < 2; ++b)
#pragma unroll
                for (int m = 0; m < 4; ++m)
#pragma unroll
                    for (int n = 0; n < 2; ++n) acc[a][b][m][n] = (f32x4){0.f, 0.f, 0.f, 0.f};
        cur = nxt; cA = nA; cB = nB; ++ui;
        if (wr == 1) PG8_BAR;
    }
    PG8_WAIT_V(0);
    PG8_BAR;
#undef PG8_SA
#undef PG8_SB
#undef PG8_STAGE
#undef PG8_LDA
#undef PG8_LDB
#undef PG8_MMA
#undef PG8_WAIT_V
#undef PG8_WAIT_L
#undef PG8_BAR
#undef PG8_SCHED
}

struct EpiInProj {
    bf16_t* P; const float* ssq; int pn_off;
    __device__ __forceinline__ void operator()(const f32x4 (&acc)[2][2][4][2], const Unit& u, int wr, int wc, int fr, int fq) const {
#pragma unroll
        for (int ai = 0; ai < 2; ++ai)
#pragma unroll
            for (int m = 0; m < 4; ++m) {
                const int row = u.pm * 256 + ai * 128 + wr * 64 + m * 16 + fr;
                const float rs = rsqrtf(ssq_total(ssq, row) * (1.f / 1024.f) + 1e-6f);
#pragma unroll
                for (int bj = 0; bj < 2; ++bj) {
                    const int col = (u.pn + pn_off) * 256 + bj * 128 + wc * 32 + 8 * fq;
                    const f32x4 v0 = acc[ai][bj][m][0] * rs, v1 = acc[ai][bj][m][1] * rs;
                    u32x4 w; w.x = pk2(v0[0], v0[1]); w.y = pk2(v0[2], v0[3]); w.z = pk2(v1[0], v1[1]); w.w = pk2(v1[2], v1[3]);
                    *(u32x4*)(P + (size_t)row * NP + col) = w;
                }
            }
    }
};
struct EpiBranch {
    const bf16_t* P; float* Z; bf16_t* ZB;
    __device__ __forceinline__ void operator()(const f32x4 (&acc)[2][2][4][2], const Unit& u, int wr, int wc, int fr, int fq) const {
        const int n = u.pn >> 2, pn = u.pn & 3, pm = u.pm - n * NTM;
#pragma unroll
        for (int ai = 0; ai < 2; ++ai)
#pragma unroll
            for (int m = 0; m < 4; ++m) {
                const int row = pm * 256 + ai * 128 + wr * 64 + m * 16 + fr;
#pragma unroll
                for (int bj = 0; bj < 2; ++bj) {
                    const int col = pn * 256 + bj * 128 + wc * 32 + 8 * fq;
                    const u32x4 gw = *(const u32x4*)(P + (size_t)row * NP + OFF_GATE + n * 1024 + col);
                    float gt[8]; unpack8(gw, gt);
                    float v[8];
#pragma unroll
                    for (int j = 0; j < 4; ++j) { v[j] = sigmoidf_(gt[j]) * acc[ai][bj][m][0][j]; v[4 + j] = sigmoidf_(gt[4 + j]) * acc[ai][bj][m][1][j]; }
                    float* zp = Z + (size_t)row * DM + col;
                    if (n != 0) { const f32x4 z0 = *(const f32x4*)zp, z1 = *(const f32x4*)(zp + 4);
#pragma unroll
                        for (int j = 0; j < 4; ++j) { v[j] += z0[j]; v[4 + j] += z1[j]; } }
                    if (n != 3) { *(f32x4*)zp = (f32x4){v[0], v[1], v[2], v[3]}; *(f32x4*)(zp + 4) = (f32x4){v[4], v[5], v[6], v[7]}; }
                    else { u32x4 w; w.x = pk2(v[0], v[1]); w.y = pk2(v[2], v[3]); w.z = pk2(v[4], v[5]); w.w = pk2(v[6], v[7]); *(u32x4*)(ZB + (size_t)row * DM + col) = w; }
                }
            }
    }
};
struct EpiResid {
    float* S; bf16_t* HN; const float* nw; float* ssq;
    __device__ __forceinline__ void operator()(const f32x4 (&acc)[2][2][4][2], const Unit& u, int wr, int wc, int fr, int fq) const {
#pragma unroll
        for (int ai = 0; ai < 2; ++ai)
#pragma unroll
            for (int m = 0; m < 4; ++m) {
                const int row = u.pm * 256 + ai * 128 + wr * 64 + m * 16 + fr;
                float ss = 0.f;
#pragma unroll
                for (int bj = 0; bj < 2; ++bj) {
                    const int col = u.pn * 256 + bj * 128 + wc * 32 + 8 * fq;
                    float* sp = S + (size_t)row * DM + col;
                    f32x4 s0 = *(const f32x4*)sp, s1 = *(const f32x4*)(sp + 4);
                    s0 += acc[ai][bj][m][0]; s1 += acc[ai][bj][m][1];
                    *(f32x4*)sp = s0; *(f32x4*)(sp + 4) = s1;
                    const f32x4 w0 = *(const f32x4*)(nw + col), w1 = *(const f32x4*)(nw + col + 4);
                    u32x4 w; w.x = pk2(s0[0] * w0[0], s0[1] * w0[1]); w.y = pk2(s0[2] * w0[2], s0[3] * w0[3]); w.z = pk2(s1[0] * w1[0], s1[1] * w1[1]); w.w = pk2(s1[2] * w1[2], s1[3] * w1[3]);
                    *(u32x4*)(HN + (size_t)row * DM + col) = w;
                    ss += (s0[0] * s0[0] + s0[1] * s0[1]) + (s0[2] * s0[2] + s0[3] * s0[3]) + (s1[0] * s1[0] + s1[1] * s1[1]) + (s1[2] * s1[2] + s1[3] * s1[3]);
                }
                ss += __shfl_xor(ss, 16); ss += __shfl_xor(ss, 32);
                if (fq == 0) ssq[(size_t)row * 16 + u.pn * 4 + wc] = ss;
            }
    }
};
struct EpiSwiglu {
    bf16_t* H; const float* ssq;
    __device__ __forceinline__ void operator()(const f32x4 (&acc)[2][2][4][2], const Unit& u, int wr, int wc, int fr, int fq) const {
#pragma unroll
        for (int ai = 0; ai < 2; ++ai)
#pragma unroll
            for (int m = 0; m < 4; ++m) {
                const int row = u.pm * 256 + ai * 128 + wr * 64 + m * 16 + fr;
                const float rs = rsqrtf(ssq_total(ssq, row) * (1.f / 1024.f) + 1e-6f);
                float v[8];
#pragma unroll
                for (int n = 0; n < 2; ++n)
#pragma unroll
                    for (int j = 0; j < 4; ++j) { const float gg = acc[ai][0][m][n][j] * rs, uu = acc[ai][1][m][n][j] * rs; v[4 * n + j] = siluf_(gg) * uu; }
                u32x4 w; w.x = pk2(v[0], v[1]); w.y = pk2(v[2], v[3]); w.z = pk2(v[4], v[5]); w.w = pk2(v[6], v[7]);
                *(u32x4*)(H + (size_t)row * FF + u.pn * 128 + wc * 32 + 8 * fq) = w;
            }
    }
};
}

__device__ __forceinline__ bf16x8 ldfrag(const LAS bf16_t* p, int ld, int r, int q) { return *(const LAS bf16x8*)(p + r * ld + q * 8); }
__device__ __forceinline__ bf16x4 ldfrag4(const LAS bf16_t* p, int ld, int r, int q) { return *(const LAS bf16x4*)(p + r * ld + q * 4); }
__device__ __forceinline__ f32x4 mma32(bf16x8 a, bf16x8 b, f32x4 c) { return __builtin_amdgcn_mfma_f32_16x16x32_bf16(a, b, c, 0, 0, 0); }
__device__ __forceinline__ f32x4 mma16(bf16x4 a, bf16x4 b, f32x4 c) { return __builtin_amdgcn_mfma_f32_16x16x16bf16_1k(a, b, c, 0, 0, 0); }
__device__ __forceinline__ bf16x4 cvt4(f32x4 v) { u32x2 w; w.x = pk2(v[0], v[1]); w.y = pk2(v[2], v[3]); return __builtin_bit_cast(bf16x4, w); }
__device__ __forceinline__ bf16x8 scale8(bf16x8 x, const float* f) { const u32x4 w = __builtin_bit_cast(u32x4, x); float v[8]; unpack8(w, v); u32x4 o;
    o.x = pk2(v[0] * f[0], v[1] * f[1]); o.y = pk2(v[2] * f[2], v[3] * f[3]); o.z = pk2(v[4] * f[4], v[5] * f[5]); o.w = pk2(v[6] * f[6], v[7] * f[7]); return __builtin_bit_cast(bf16x8, o); }

struct KP { const float* in[30]; float* out; unsigned char* ws; };

__device__ __forceinline__ void tr_item(const float* W, int N, bf16_t* WT, int ldk, int k0, int n0, int dst_row0, LAS float* scr, int lane) {
#pragma unroll 8
    for (int i = 0; i < 32; ++i) { const int kk = 2 * i + (lane >> 5); const int n = n0 + (lane & 31); scr[kk * 33 + (lane & 31)] = (n < N) ? W[(size_t)(k0 + kk) * N + n] : 0.f; }
    LDS_WAIT(); asm volatile("" ::: "memory");
    const int c = lane & 7;
#pragma unroll
    for (int j = 0; j < 4; ++j) { const int n = (lane >> 3) + 8 * j; const LAS float* s = scr + (8 * c) * 33 + n;
        u32x4 o; o.x = pk2(s[0 * 33], s[1 * 33]); o.y = pk2(s[2 * 33], s[3 * 33]); o.z = pk2(s[4 * 33], s[5 * 33]); o.w = pk2(s[6 * 33], s[7 * 33]);
        if (n0 + n < N) *(u32x4*)(WT + (size_t)(dst_row0 + n) * ldk + k0 + 8 * c) = o; }
    LDS_WAIT(); asm volatile("" ::: "memory");
}
__device__ __forceinline__ void convert_layer(const KP& p, int l, LAS unsigned char* lds, int gw, int NGW, int wave, int lane) {
    asm volatile("" : "+v"(lane)); asm volatile("" : "+v"(wave)); wave = __builtin_amdgcn_readfirstlane(wave);
    LAS float* scr = (LAS float*)(lds + wave * 8448);
    bf16_t* win_t = (bf16_t*)(p.ws + WS_WIN); bf16_t* wing_t = (bf16_t*)(p.ws + WS_WING + (size_t)(l & 1) * WING_SIZE);
    unsigned char* sm = p.ws + WS_WSM + (size_t)(l & 1) * WSM_SIZE;
    bf16_t* br_t = (bf16_t*)(sm + WSM_BR); bf16_t* out_t = (bf16_t*)(sm + WSM_OUT); bf16_t* fi_t = (bf16_t*)(sm + WSM_FI); bf16_t* fo_t = (bf16_t*)(sm + WSM_FO);
    constexpr int NB_IN = (INW + 31) / 32;
    constexpr int I_IN = 16 * NB_IN, I_BR = 4 * 16 * 32, I_OUT = 16 * 32, I_FI = 16 * (2 * FF / 32), I_FO = (FF / 64) * 32;
    constexpr int NITEMS = I_IN + I_BR + I_OUT + I_FI + I_FO;
    for (int it = gw; it < NITEMS; it += NGW) {
        int r = it;
        if (r < I_IN) { const int kb = r / NB_IN, nb = r % NB_IN; const bool gt = nb >= GT0 * 8 && nb < (GT0 + GTN) * 8;
            tr_item(p.in[4] + (size_t)l * DM * INW, INW, gt ? wing_t : win_t, DM, kb * 64, nb * 32, gt ? nb * 32 - GT0 * 256 : nb * 32, scr, lane); continue; } r -= I_IN;
        if (r < I_BR) { const int n = r / 512, rr = r % 512, kb = rr / 32, nb = rr % 32; tr_item(p.in[25] + (size_t)(l * 4 + n) * DM * DM, DM, br_t, DM, kb * 64, nb * 32, n * 1024 + nb * 32, scr, lane); continue; } r -= I_BR;
        if (r < I_OUT) { const int kb = r / 32, nb = r % 32; tr_item(p.in[26] + (size_t)l * DM * DM, DM, out_t, DM, kb * 64, nb * 32, nb * 32, scr, lane); continue; } r -= I_OUT;
        if (r < I_FI) { const int nbn = 2 * FF / 32, kb = r / nbn, nb = r % nbn; const int c0 = nb * 32, bj = c0 / FF, j = c0 % FF, pn = j / 128, rr = j % 128;
            tr_item(p.in[27] + (size_t)l * DM * 2 * FF, 2 * FF, fi_t, DM, kb * 64, c0, 256 * pn + 128 * bj + rr, scr, lane); continue; } r -= I_FI;
        { const int kb = r / 32, nb = r % 32; tr_item(p.in[28] + (size_t)l * FF * DM, DM, fo_t, FF, kb * 64, nb * 32, nb * 32, scr, lane); }
    }
    if (l >= 1) {
        const float* Wv = p.in[4] + (size_t)l * DM * INW + 2048; const float* mu = p.in[5] + (size_t)l * 3328 + 2048; const float* v1 = p.in[12] + (size_t)(l - 1) * DM * 32;
        for (int k = gw; k < DM; k += NGW) {
            float wv[16], m1[16];
#pragma unroll
            for (int m = 0; m < 16; ++m) { const int c = lane + 64 * m; wv[m] = Wv[(size_t)k * INW + c]; m1[m] = mu[c]; }
            for (int j = 0; j < 32; ++j) {
                float e1 = 0.f, e2 = 0.f;
#pragma unroll
                for (int m = 0; m < 16; ++m) { const int c = lane + 64 * m; const float vv = v1[c * 32 + j] * wv[m]; e1 += vv * (1.f - m1[m]); e2 += vv * m1[m]; }
#pragma unroll
                for (int o = 1; o < 64; o <<= 1) { e1 += __shfl_xor(e1, o); e2 += __shfl_xor(e2, o); }
                if (lane == 0) { win_t[(size_t)(OFF_VLO + j) * DM + k] = (bf16_t)f2bf(e1); win_t[(size_t)(OFF_VLO + 32 + j) * DM + k] = (bf16_t)f2bf(e2); }
            }
        }
    }
}


constexpr int XLW = 320;
__device__ __forceinline__ void rwkv_lora_inputs(const KP& p, int l, int gw, int NGW, int lane) {
    const bf16_t* P = (const bf16_t*)(p.ws + WS_P); bf16_t* XLO = (bf16_t*)(p.ws + WS_Z);
    const float* mu = p.in[5] + (size_t)l * 3328 + 3072;
    float muv[4];
#pragma unroll
    for (int j = 0; j < 4; ++j) muv[j] = mu[lane + 64 * j];
    for (int m = gw; m < MMAIN + NMETA; m += NGW) {
        int prev; if (m < MMAIN) prev = ((m & (SEQ - 1)) == 0) ? MMAIN + NMETA - 1 : m - 1; else prev = (m == MMAIN) ? -1 : m - 1;
        const bf16_t* cr = P + (size_t)m * NP; const bf16_t* pr = P + (size_t)(prev < 0 ? m : prev) * NP; const float pz = prev < 0 ? 0.f : 1.f;
        float cur[4], prv[4];
#pragma unroll
        for (int j = 0; j < 4; ++j) { cur[j] = bf2f(cr[3072 + lane + 64 * j]); prv[j] = pz * bf2f(pr[3072 + lane + 64 * j]); }
        float vl = 0.f; if (lane < 32) vl = bf2f(cr[OFF_VLO + lane]) + pz * bf2f(pr[OFF_VLO + 32 + lane]);
        bf16_t* o = XLO + (size_t)m * XLW;
#pragma unroll
        for (int j = 0; j < 4; ++j) { const float val = cur[j] + (prv[j] - cur[j]) * muv[j]; float r_;
            if (j == 0) { const float e2 = __expf(2.f * val); r_ = 1.f - 2.f * __builtin_amdgcn_rcpf(e2 + 1.f); } else if (j == 1) r_ = val; else r_ = __builtin_amdgcn_rcpf(1.f + __expf(-val));
            o[lane + 64 * j] = (bf16_t)f2bf(r_); }
        if (lane < 32) o[256 + lane] = (bf16_t)f2bf(vl);
    }
}

__device__ __forceinline__ void rwkv_unit(const KP& p, int l, int b, int h, LAS unsigned char* lds, const int WAVE_U) {
    int tid = TIDX; asm volatile("" : "+v"(tid)); const int wave = __builtin_amdgcn_readfirstlane(tid >> 6); int lane = tid & 63, r = lane & 15, q = lane >> 4;
#define RELAUNDER() do { asm volatile("" : "+v"(tid)); lane = tid & 63; r = lane & 15; q = lane >> 4; l32 = lane & 31; thalf = lane >> 5; } while (0)
    const bf16_t* P = (const bf16_t*)(p.ws + WS_P);
    bf16_t* YS = (bf16_t*)(p.ws + WS_YS);
    bf16_t* VFG = (bf16_t*)(p.ws + WS_VF); const bf16_t* XLO = (const bf16_t*)(p.ws + WS_Z);
    const float* mu = p.in[5] + (size_t)l * 3328;
    const float* vec = p.in[9] + (size_t)l * 6 * DM;
    const float* rk = p.in[10] + (size_t)l * DM;
    const float* v0 = (l >= 1) ? p.in[11] + (size_t)(l - 1) * DM : nullptr;
    LAS bf16_t* W2T = (LAS bf16_t*)(lds + 0); LAS bf16_t* A2T = (LAS bf16_t*)(lds + 9216); LAS bf16_t* G2T = (LAS bf16_t*)(lds + 18432); LAS bf16_t* V2T = (LAS bf16_t*)(lds + 35840);
    LAS float* MU = (LAS float*)(lds + 40960); LAS float* W0L = (LAS float*)(lds + 42752); LAS float* A0L = W0L + 64; LAS float* V0L = A0L + 64;
    LAS float* BON = (LAS float*)(lds + 43520); LAS float* PC = (LAS float*)(lds + 43648);
    LAS float* RM = (LAS float*)(lds + 44160); LAS float* KM = RM + 2048; LAS float* VM = KM + 2048; LAS float* WD = VM + 2048; LAS float* AG = WD + 2048; LAS float* VG = AG + 2048; LAS float* GL = VG + 2048;
    LAS float* YY = RM; LAS float* KPp = KM; LAS float* VPp = VM; LAS float* APp = AG; LAS float* BPp = VG;
    constexpr int REG = 101504; constexpr int TS = 20;
    LAS bf16_t* RAW = (LAS bf16_t*)(lds + REG);
    LAS bf16_t* XW = (LAS bf16_t*)(lds + 140048); LAS bf16_t* XA = (LAS bf16_t*)(lds + 144656); LAS bf16_t* XG = (LAS bf16_t*)(lds + 149264); LAS bf16_t* XV = (LAS bf16_t*)(lds + 157968);
    constexpr int O_AT = 0, O_RT = 2304, O_BT = 4608, O_KT = 6912, O_BH = 9216, O_KH = 12288, O_VT = 15360, O_MAB = 18432, O_TT = 19712, OPB = 20480;
    { const float* w2g = p.in[6] + (size_t)l * 64 * DM + 64 * h; const float* a2g = p.in[7] + (size_t)l * 64 * DM + 64 * h; const float* g2g = p.in[8] + (size_t)l * 128 * DM + 64 * h;
      for (int idx = tid; idx < 64 * 64; idx += 512) { const int k = idx >> 6, n = idx & 63; W2T[n * 72 + k] = (bf16_t)f2bf(w2g[k * DM + n]); A2T[n * 72 + k] = (bf16_t)f2bf(a2g[k * DM + n]); }
      for (int idx = tid; idx < 128 * 64; idx += 512) { const int k = idx >> 6, n = idx & 63; G2T[n * 136 + k] = (bf16_t)f2bf(g2g[k * DM + n]); }
      if (l >= 1) { const float* v2g = p.in[13] + (size_t)(l - 1) * 32 * DM + 64 * h; for (int idx = tid; idx < 32 * 64; idx += 512) { const int k = idx >> 6, n = idx & 63; V2T[n * 40 + k] = (bf16_t)f2bf(v2g[k * DM + n]); } } }
    if (tid < 192) MU[tid] = mu[(tid >> 6) * 1024 + 64 * h + (tid & 63)];
    if (tid < 64) { W0L[tid] = vec[64 * h + tid]; A0L[tid] = vec[DM + 64 * h + tid]; V0L[tid] = l >= 1 ? v0[64 * h + tid] : 0.f; }
    f32x4 sT[4];
#pragma unroll
    for (int i = 0; i < 4; ++i) sT[i] = (f32x4){0.f, 0.f, 0.f, 0.f};
    int l32 = lane & 31, thalf = lane >> 5; const int hc0 = 64 * h + l32, hc1 = hc0 + 32;
    const float kk_c0 = vec[2 * DM + hc0], ka_c0 = vec[3 * DM + hc0], lnw_c0 = vec[4 * DM + hc0], lnb_c0 = vec[5 * DM + hc0], rk_c0 = rk[hc0];
    const float kk_c1 = vec[2 * DM + hc1], ka_c1 = vec[3 * DM + hc1], lnw_c1 = vec[4 * DM + hc1], lnb_c1 = vec[5 * DM + hc1], rk_c1 = rk[hc1];
    auto trow = [&](int t) -> size_t { return (size_t)row_of(b, t < 0 ? 0 : (t >= TT ? TT - 1 : t)); };
    constexpr int RS = 264;
    const int ra0 = tid, ra1 = tid + 512; const int rr0 = ra0 / 24, pc0 = ra0 % 24, rr1 = ra1 / 24, pc1 = ra1 % 24;
    const int gc0 = (pc0 >> 3) * 1024 + 64 * h + 8 * (pc0 & 7), gc1 = (pc1 >> 3) * 1024 + 64 * h + 8 * (pc1 & 7);
    int xtok[3], xpc[3], xdst[3];
#pragma unroll
    for (int j = 0; j < 3; ++j) { const int xa = tid + 512 * j; xtok[j] = xa / 36; xpc[j] = xa % 36; const int pc = xpc[j], tk = xtok[j];
        xdst[j] = pc < 8 ? 140048 + (tk * 72 + 8 * pc) * 2 : (pc < 16 ? 144656 + (tk * 72 + 8 * (pc - 8)) * 2 : (pc < 32 ? 149264 + (tk * 136 + 8 * (pc - 16)) * 2 : 157968 + (tk * 40 + 8 * (pc - 32)) * 2)); }
    u32x4 pfa0, pfa1, pfv, pfx0, pfx1, pfx2;
#define RWKV_PREFETCH(pn) do { const int t0_ = 32 * (pn) - 1; \
        pfa0 = *(const u32x4*)(P + trow(t0_ + rr0) * NP + gc0); if (t0_ + rr0 < 0) pfa0 = (u32x4){0u, 0u, 0u, 0u}; \
        if (ra1 < 792) pfa1 = *(const u32x4*)(P + trow(t0_ + rr1) * NP + gc1); \
        if (tid < 256) pfv = *(const u32x4*)(VFG + trow(t0_ + 1 + (tid >> 3)) * DM + 64 * h + 8 * (tid & 7)); \
        pfx0 = *(const u32x4*)(XLO + trow(t0_ + 1 + xtok[0]) * XLW + 8 * xpc[0]); pfx1 = *(const u32x4*)(XLO + trow(t0_ + 1 + xtok[1]) * XLW + 8 * xpc[1]); \
        if (tid < 128) pfx2 = *(const u32x4*)(XLO + trow(t0_ + 1 + xtok[2]) * XLW + 8 * xpc[2]); } while (0)
    pfa1 = (u32x4){0u, 0u, 0u, 0u}; pfv = pfa1; pfx2 = pfa1;
    RWKV_PREFETCH(0);
    __syncthreads();
    for (int pp = 0; pp < 129; ++pp) {
        *(LAS u32x4*)(RAW + rr0 * RS + 8 * pc0) = pfa0;
        if (ra1 < 792) *(LAS u32x4*)(RAW + rr1 * RS + 8 * pc1) = pfa1;
        if (tid < 256) { const int tk = tid >> 3; *(LAS u32x4*)(lds + (tk < 24 ? 160528 + tk * 128 : 41728 + (tk - 24) * 128) + 16 * (tid & 7)) = pfv; }
        *(LAS u32x4*)(lds + xdst[0]) = pfx0; *(LAS u32x4*)(lds + xdst[1]) = pfx1; if (tid < 128) *(LAS u32x4*)(lds + xdst[2]) = pfx2;
        if (pp + 1 < 129) RWKV_PREFETCH(pp + 1);
        BAR_LDS();
        RELAUNDER();
        typedef float f32x2 __attribute__((ext_vector_type(2)));
        { unsigned cwv[6], pwv[6]; f32x2 m2v[3];
#pragma unroll
          for (int pj = 0; pj < 6; ++pj) { const int grp = pj % 3, i = 4 * wave + 2 * (pj / 3) + thalf, col = 64 * grp + 2 * l32;
              cwv[pj] = *(const LAS unsigned*)(RAW + (i + 1) * RS + col); pwv[pj] = *(const LAS unsigned*)(RAW + i * RS + col); if (pj < 3) m2v[pj] = *(const LAS f32x2*)(MU + col); }
#pragma unroll
          for (int pj = 0; pj < 6; ++pj) { const int grp = pj % 3, i = 4 * wave + 2 * (pj / 3) + thalf;
              const unsigned cw = cwv[pj], pw = pwv[pj]; const f32x2 m2 = m2v[grp];
              const float c0 = __builtin_bit_cast(float, cw << 16), c1 = __builtin_bit_cast(float, cw & 0xffff0000u), p0 = __builtin_bit_cast(float, pw << 16), p1 = __builtin_bit_cast(float, pw & 0xffff0000u);
              LAS float* dst = grp == 0 ? RM : (grp == 1 ? KM : VM); *(LAS f32x2*)(dst + i * 64 + 2 * l32) = (f32x2){c0 + (p0 - c0) * m2.x, c1 + (p1 - c1) * m2.y}; } }
        RELAUNDER();
        { auto s2_tile = [&](int which, int mt, int nt) { f32x4 acc = (f32x4){0.f, 0.f, 0.f, 0.f};
            if (which == 0) { acc = mma32(ldfrag(XW + 16 * mt * 72, 72, r, q), ldfrag(W2T + nt * 16 * 72, 72, r, q), acc); acc = mma32(ldfrag(XW + 16 * mt * 72 + 32, 72, r, q), ldfrag(W2T + nt * 16 * 72 + 32, 72, r, q), acc); }
            else if (which == 1) { acc = mma32(ldfrag(XA + 16 * mt * 72, 72, r, q), ldfrag(A2T + nt * 16 * 72, 72, r, q), acc); acc = mma32(ldfrag(XA + 16 * mt * 72 + 32, 72, r, q), ldfrag(A2T + nt * 16 * 72 + 32, 72, r, q), acc); }
            else if (which == 2) {
#pragma unroll
                for (int ks = 0; ks < 4; ++ks) acc = mma32(ldfrag(XG + 16 * mt * 136 + 32 * ks, 136, r, q), ldfrag(G2T + nt * 16 * 136 + 32 * ks, 136, r, q), acc); }
            else { acc = mma32(ldfrag(XV + 16 * mt * 40, 40, r, q), ldfrag(V2T + nt * 16 * 40, 40, r, q), acc); }
            const int cc = 16 * nt + r;
#pragma unroll
            for (int j = 0; j < 4; ++j) { const int tok = 16 * mt + 4 * q + j; const float x = acc[j];
                if (which == 0) { const float ex = __expf(-(W0L[cc] + x)); WD[tok * 64 + cc] = __expf(-0.6065306597f * __builtin_amdgcn_rcpf(1.f + ex)); }
                else if (which == 1) AG[tok * 64 + cc] = __builtin_amdgcn_rcpf(1.f + __expf(-(A0L[cc] + x)));
                else if (which == 2) GL[tok * 64 + cc] = x;
                else VG[tok * 64 + cc] = __builtin_amdgcn_rcpf(1.f + __expf(-(V0L[cc] + x))); } };
          if (wave < 4) { const int which = wave >> 1;
#pragma unroll
              for (int mt = 0; mt < 2; ++mt)
#pragma unroll
                  for (int tnt = 0; tnt < 2; ++tnt) s2_tile(which, mt, 2 * (wave & 1) + tnt); }
          else { const int mtg = (wave - 4) >> 1;
#pragma unroll
              for (int tnt = 0; tnt < 2; ++tnt) s2_tile(2, mtg, 2 * (wave & 1) + tnt);
              if (l >= 1) {
#pragma unroll
                  for (int tnt = 0; tnt < 2; ++tnt) s2_tile(3, mtg, 2 * (wave & 1) + tnt); } } }
        BAR_LDS();
        RELAUNDER();
#pragma unroll
        for (int rep = 0; rep < 2; ++rep) { const int tok = 4 * wave + 2 * rep + thalf, e0 = tok * 64 + l32, e1 = e0 + 32;
          const float k0 = KM[e0], k1 = KM[e1], a0 = AG[e0], a1 = AG[e1], vv0 = VM[e0], vv1 = VM[e1], r0 = RM[e0], r1 = RM[e1];
          float kka = k0 * kk_c0, kkb = k1 * kk_c1; float n2 = kka * kka + kkb * kkb;
          const float kp0 = k0 * (1.f + (a0 - 1.f) * ka_c0), kp1 = k1 * (1.f + (a1 - 1.f) * ka_c1);
          float bo = r0 * kp0 * rk_c0 + r1 * kp1 * rk_c1;
          n2 = half_sum32(n2); bo = half_sum32(bo);
          const float inv = rsqrtf(fmaxf(n2, 1e-24f)); kka *= inv; kkb *= inv;
          float vp0 = vv0, vp1 = vv1;
          if (l >= 1) { const LAS bf16_t* vfp = (const LAS bf16_t*)(lds + (tok < 24 ? 160528 + tok * 128 : 41728 + (tok - 24) * 128)); vp0 = vv0 + (bf2f(vfp[l32]) - vv0) * VG[e0]; vp1 = vv1 + (bf2f(vfp[32 + l32]) - vv1) * VG[e1]; }
          KPp[e0] = kp0; KPp[e1] = kp1; VPp[e0] = vp0; VPp[e1] = vp1; APp[e0] = -kka; APp[e1] = -kkb; BPp[e0] = kka * a0; BPp[e1] = kkb * a1; if (l32 == 0) BON[tok] = bo;
          const int t = 32 * pp + tok;
          if (l == 0 && t < TT) { bf16_t* vf = VFG + (size_t)row_of(b, t) * DM; vf[hc0] = (bf16_t)f2bf(vv0); vf[hc1] = (bf16_t)f2bf(vv1); } }
        LDS_WAIT();
        RELAUNDER();
        { const int ch = wave >> 2, i0 = 4 * (wave & 3); LAS unsigned char* ob = lds + REG + ch * OPB;
          LAS bf16_t* AT_ = (LAS bf16_t*)(ob + O_AT); LAS bf16_t* RT_ = (LAS bf16_t*)(ob + O_RT); LAS bf16_t* BTl = (LAS bf16_t*)(ob + O_BT); LAS bf16_t* KTl = (LAS bf16_t*)(ob + O_KT);
          LAS bf16_t* BHt = (LAS bf16_t*)(ob + O_BH); LAS bf16_t* KHt = (LAS bf16_t*)(ob + O_KH); LAS bf16_t* VTt = (LAS bf16_t*)(ob + O_VT);
          float Pv[5]; float run = 1.f;
          const LAS float* wdp = WD + 16 * ch * 64 + lane;
          for (int j = 0; j < i0; ++j) run *= wdp[j * 64];
          Pv[0] = run;
#pragma unroll
          for (int tt = 0; tt < 4; ++tt) { run *= wdp[(i0 + tt) * 64]; Pv[1 + tt] = run; }
          for (int j = i0 + 4; j < 16; ++j) run *= wdp[j * 64];
          const float Pall = run;
          float av[4], bv[4], kv[4], rv[4], vv[4];
#pragma unroll
          for (int tt = 0; tt < 4; ++tt) { const int e = (16 * ch + i0 + tt) * 64 + lane; av[tt] = APp[e]; bv[tt] = BPp[e]; kv[tt] = KPp[e]; rv[tt] = RM[e]; vv[tt] = VPp[e]; }
#pragma unroll
          for (int tt = 0; tt < 4; ++tt) { const int i = i0 + tt; const float Pi = Pv[1 + tt], Pp = Pv[tt]; const float ip = __builtin_amdgcn_rcpf(Pi), hp = Pall * ip;
              AT_[i * 72 + lane] = (bf16_t)f2bf(av[tt] * Pp); RT_[i * 72 + lane] = (bf16_t)f2bf(rv[tt] * Pi); BTl[i * 72 + lane] = (bf16_t)f2bf(bv[tt] * ip); KTl[i * 72 + lane] = (bf16_t)f2bf(kv[tt] * ip);
              BHt[lane * TS + i] = (bf16_t)f2bf(bv[tt] * hp); KHt[lane * TS + i] = (bf16_t)f2bf(kv[tt] * hp); VTt[lane * TS + i] = (bf16_t)f2bf(vv[tt]); }
          if ((wave & 3) == 0) PC[ch * 64 + lane] = Pall; }
        BAR_LDS();
        RELAUNDER();
        bf16x4 nrb4, rhs4, v4; f32x4 Y;
#define RWKV_PRE(ch) do { LAS unsigned char* ob = lds + REG + (ch) * OPB; \
            const LAS bf16_t* AT_ = (const LAS bf16_t*)(ob + O_AT); const LAS bf16_t* RT_ = (const LAS bf16_t*)(ob + O_RT); const LAS bf16_t* BTl = (const LAS bf16_t*)(ob + O_BT); const LAS bf16_t* KTl = (const LAS bf16_t*)(ob + O_KT); \
            const LAS bf16_t* VTt = (const LAS bf16_t*)(ob + O_VT); \
            f32x4 mk = (f32x4){0.f, 0.f, 0.f, 0.f}, nb = mk, nk = mk; \
            _Pragma("unroll") for (int ks = 0; ks < 2; ++ks) { const bf16x8 fa = ldfrag(AT_ + 32 * ks, 72, r, q), fr_ = ldfrag(RT_ + 32 * ks, 72, r, q), fb = ldfrag(BTl + 32 * ks, 72, r, q), fk = ldfrag(KTl + 32 * ks, 72, r, q); \
                mk = mma32(fk, fa, mk); nb = mma32(fb, fr_, nb); nk = mma32(fk, fr_, nk); } \
            _Pragma("unroll") for (int j = 0; j < 4; ++j) { const int s_ = 4 * q + j; if (!(s_ < r)) mk[j] = 0.f; if (!(s_ <= r)) { nb[j] = 0.f; nk[j] = 0.f; } } \
            const bf16x4 mak4 = cvt4(mk), nrk4 = cvt4(nk); nrb4 = cvt4(nb); \
            v4 = ldfrag4(VTt + 16 * wave * TS, TS, r, q); \
            bf16x4 sb[4]; \
            _Pragma("unroll") for (int kt = 0; kt < 4; ++kt) sb[kt] = cvt4(sT[kt]); \
            f32x4 RHS = (f32x4){0.f, 0.f, 0.f, 0.f}; Y = RHS; \
            RHS = mma16(mak4, v4, RHS); Y = mma16(nrk4, v4, Y); \
            _Pragma("unroll") for (int kt = 0; kt < 4; ++kt) { RHS = mma16(ldfrag4(AT_ + 16 * kt, 72, r, q), sb[kt], RHS); Y = mma16(ldfrag4(RT_ + 16 * kt, 72, r, q), sb[kt], Y); } \
            rhs4 = cvt4(RHS); } while (0)
#define RWKV_FIN(ch) do { LAS unsigned char* ob = lds + REG + (ch) * OPB; \
            const LAS bf16_t* BHt = (const LAS bf16_t*)(ob + O_BH); const LAS bf16_t* KHt = (const LAS bf16_t*)(ob + O_KH); const LAS bf16_t* TTm = (const LAS bf16_t*)(ob + O_TT); \
            f32x4 U = (f32x4){0.f, 0.f, 0.f, 0.f}; U = mma16(ldfrag4(TTm, 24, r, q), rhs4, U); \
            const bf16x4 ub = cvt4(U); \
            Y = mma16(nrb4, ub, Y); \
            _Pragma("unroll") for (int j = 0; j < 4; ++j) YY[(16 * (ch) + 4 * q + j) * 64 + 16 * wave + r] = Y[j]; \
            _Pragma("unroll") for (int kt = 0; kt < 4; ++kt) { const f32x4 pc4 = *(const LAS f32x4*)(PC + (ch) * 64 + 16 * kt + 4 * q); f32x4 s_ = sT[kt] * pc4; \
                s_ = mma16(ldfrag4(BHt + 16 * kt * TS, TS, r, q), ub, s_); s_ = mma16(ldfrag4(KHt + 16 * kt * TS, TS, r, q), v4, s_); sT[kt] = s_; } } while (0)
        if (wave == 4 || wave == 5) { LAS unsigned char* ob = lds + REG + (wave - 4) * OPB;
            const LAS bf16_t* AT_ = (const LAS bf16_t*)(ob + O_AT); const LAS bf16_t* BTl = (const LAS bf16_t*)(ob + O_BT); LAS bf16_t* TTm = (LAS bf16_t*)(ob + O_TT);
            const f32x4 z4 = (f32x4){0.f, 0.f, 0.f, 0.f}; f32x4 n = z4, nt = z4, eye;
#pragma unroll
            for (int ks = 0; ks < 2; ++ks) { const bf16x8 fa = ldfrag(AT_ + 32 * ks, 72, r, q), fb = ldfrag(BTl + 32 * ks, 72, r, q); n = mma32(fa, fb, n); nt = mma32(fb, fa, nt); }
#pragma unroll
            for (int j = 0; j < 4; ++j) { const int i_ = 4 * q + j; if (!(r < i_)) n[j] = 0.f; if (!(i_ < r)) nt[j] = 0.f; eye[j] = (i_ == r) ? 1.f : 0.f; }
            const bf16x4 nB = cvt4(n), nA = cvt4(nt);
            const f32x4 n2 = mma16(nA, nB, z4), n2t = mma16(nB, nA, z4); const bf16x4 n2B = cvt4(n2), n2A = cvt4(n2t);
            const f32x4 n4 = mma16(n2A, n2B, z4), n4t = mma16(n2B, n2A, z4); const bf16x4 n4B = cvt4(n4), n4A = cvt4(n4t);
            const f32x4 n3 = mma16(nA, n2B, z4), n3t = mma16(n2B, nA, z4);
            const f32x4 n8 = mma16(n4A, n4B, z4); const f32x4 n12 = mma16(n4A, cvt4(n8), z4);
            const f32x4 p1 = ((eye + n) + (n2 + n3)), p1t = ((eye + nt) + (n2t + n3t)), rr = (n4 + n8) + n12;
            const f32x4 tt = mma16(cvt4(p1t), cvt4(rr), p1);
#pragma unroll
            for (int j = 0; j < 4; ++j) TTm[(4 * q + j) * 24 + r] = (bf16_t)f2bf(tt[j]); }
        else if (wave < 4) RWKV_PRE(0);
        BAR_LDS();
        RELAUNDER();
        if (wave < 4) { RWKV_FIN(0); RWKV_PRE(1); RWKV_FIN(1); }
        BAR_LDS();
#undef RWKV_PRE
#undef RWKV_FIN
        RELAUNDER();
#pragma unroll
        for (int rep = 0; rep < 2; ++rep) { const int tok = 4 * wave + 2 * rep + thalf, e0 = tok * 64 + l32, e1 = e0 + 32; const float y0 = YY[e0], y1 = YY[e1];
          float s1 = y0 + y1, s2 = y0 * y0 + y1 * y1;
          s1 = half_sum32(s1); s2 = half_sum32(s2);
          const float mean = s1 * (1.f / 64.f), var = fmaxf(s2 * (1.f / 64.f) - mean * mean, 0.f), rs = rsqrtf(var + 64e-5f), bon = BON[tok];
          const float o0 = ((y0 - mean) * rs * lnw_c0 + lnb_c0 + bon * VPp[e0]) * GL[e0], o1 = ((y1 - mean) * rs * lnw_c1 + lnb_c1 + bon * VPp[e1]) * GL[e1];
          const int t = 32 * pp + tok;
          if (t < TT) { bf16_t* yo = YS + (size_t)row_of(b, t) * DM; yo[hc0] = (bf16_t)f2bf(o0); yo[hc1] = (bf16_t)f2bf(o1); } }
    }
#undef RWKV_PREFETCH
#undef RELAUNDER
    __syncthreads();
}

__device__ __forceinline__ int swz72(int row, int chunk) { return row * 72 + (((chunk ^ (row >> 3)) & 7) << 3); }
__device__ __forceinline__ void ssd_unit(const KP& p, int l, int b, int g, LAS unsigned char* lds, const int WAVE_U) {
    int tid = TIDX; asm volatile("" : "+v"(tid)); const int wave = __builtin_amdgcn_readfirstlane(tid >> 6); int lane = tid & 63, r = lane & 15, q = lane >> 4;
#define RELAUNDER() do { asm volatile("" : "+v"(tid)); lane = tid & 63; r = lane & 15; q = lane >> 4; } while (0)
    const bf16_t* P = (const bf16_t*)(p.ws + WS_P);
    bf16_t* YS1 = (bf16_t*)(p.ws + WS_YS) + (size_t)1 * MP * DM;
    const float* conv_w = p.in[14] + (size_t)l * 4 * 2048; const float* conv_b = p.in[15] + (size_t)l * 2048;
    const float* dt_bias = p.in[16] + l * 16; const float* a_log = p.in[17] + l * 16; const float* dsk = p.in[18] + l * 16; const float* normw = p.in[19] + (size_t)l * DM;
    LAS bf16_t* Cm = (LAS bf16_t*)(lds + 0); LAS bf16_t* Bm = (LAS bf16_t*)(lds + 17408); LAS bf16_t* BT = (LAS bf16_t*)(lds + 34816); LAS bf16_t* CB = (LAS bf16_t*)(lds + 53248);
    LAS bf16_t* XT = (LAS bf16_t*)(lds + 62464); LAS float* ACU = (LAS float*)(lds + 99328); LAS float* DTV = (LAS float*)(lds + 100352); LAS float* RED = (LAS float*)(lds + 101376); LAS bf16_t* YL = (LAS bf16_t*)(lds + 103424); (void)RED;
    const int e = wave >> 1, ptb = 2 * (wave & 1);
    f32x4 st[8][2];
#pragma unroll
    for (int i = 0; i < 8; ++i) { st[i][0] = (f32x4){0.f, 0.f, 0.f, 0.f}; st[i][1] = (f32x4){0.f, 0.f, 0.f, 0.f}; }
    const float De = dsk[4 * g + e];
    unsigned short dtraw = 0;
#define SSD_DT_PREFETCH(cn) do { if (tid < 256) { const int t = 64 * (cn) - 48 + (tid & 63); dtraw = P[(size_t)row_of(b, t >= 0 ? t : 0) * NP + OFF_SSM + 3072 + 4 * g + (tid >> 6)]; } } while (0)
    SSD_DT_PREFETCH(0);
    for (int c = 0; c < 65; ++c) {
        RELAUNDER();
        if (tid < 256) { const int ee = wave, t = 64 * c - 48 + lane; float dtv = 0.f;
            if (t >= 0) dtv = softplusf_(bf2f(dtraw) + dt_bias[4 * g + ee]);
            float a = -dtv * __expf(a_log[4 * g + ee]);
#pragma unroll
            for (int off = 1; off < 64; off <<= 1) { const float v = __shfl_up(a, off); if (lane >= off) a += v; }
            ACU[ee * 64 + lane] = a; DTV[ee * 64 + lane] = dtv; }
        { const int cgp = tid & 63, tg = tid >> 6;
          const int xbc_idx = cgp < 32 ? 256 * g + 8 * cgp : (cgp < 48 ? 1024 + 128 * g + 8 * (cgp - 32) : 1536 + 128 * g + 8 * (cgp - 48));
          const int pcol = OFF_SSM + 1024 + xbc_idx;
          typedef float f32x2 __attribute__((ext_vector_type(2)));
          f32x2 cw0[4], cw1[4], cw2[4], cw3[4], cb[4]; u32x4 raw[11]; unsigned pk[8][4];
          const int i0 = 8 * tg, t0 = 64 * c - 48 + i0;
#pragma unroll
          for (int j = 0; j < 11; ++j) { const int t = t0 - 3 + j; raw[j] = *(const u32x4*)(P + (size_t)row_of(b, t >= 0 ? t : 0) * NP + pcol); if (t < 0) raw[j] = (u32x4){0u, 0u, 0u, 0u}; }
#pragma unroll
          for (int m = 0; m < 4; ++m) { cw0[m] = *(const f32x2*)(conv_w + xbc_idx + 2 * m); cw1[m] = *(const f32x2*)(conv_w + 2048 + xbc_idx + 2 * m); cw2[m] = *(const f32x2*)(conv_w + 4096 + xbc_idx + 2 * m);
              cw3[m] = *(const f32x2*)(conv_w + 6144 + xbc_idx + 2 * m); cb[m] = *(const f32x2*)(conv_b + xbc_idx + 2 * m); }
#define UNPK2(RW, VV) do { const u32x4 rw_ = (RW); VV[0] = (f32x2){__builtin_bit_cast(float, rw_[0] << 16), __builtin_bit_cast(float, rw_[0] & 0xffff0000u)}; VV[1] = (f32x2){__builtin_bit_cast(float, rw_[1] << 16), __builtin_bit_cast(float, rw_[1] & 0xffff0000u)}; \
                           VV[2] = (f32x2){__builtin_bit_cast(float, rw_[2] << 16), __builtin_bit_cast(float, rw_[2] & 0xffff0000u)}; VV[3] = (f32x2){__builtin_bit_cast(float, rw_[3] << 16), __builtin_bit_cast(float, rw_[3] & 0xffff0000u)}; } while (0)
          f32x2 x0[4], x1[4], x2[4];
          UNPK2(raw[0], x0); UNPK2(raw[1], x1); UNPK2(raw[2], x2);
#pragma unroll
          for (int i2 = 0; i2 < 4; ++i2) { f32x2 oa[4], ob[4];
#pragma unroll
              for (int hh = 0; hh < 2; ++hh) { const int ii = 2 * i2 + hh, t = t0 + ii; f32x2 x3[4];
                  UNPK2(raw[ii + 3], x3);
#pragma unroll
                  for (int m = 0; m < 4; ++m) { const f32x2 z = cb[m] + cw0[m] * x0[m] + cw1[m] * x1[m] + cw2[m] * x2[m] + cw3[m] * x3[m]; f32x2 o;
                      o.x = z.x * __builtin_amdgcn_rcpf(1.f + __expf(-z.x)); o.y = z.y * __builtin_amdgcn_rcpf(1.f + __expf(-z.y)); if (t < 0) o = (f32x2){0.f, 0.f};
                      if (hh == 0) oa[m] = o; else ob[m] = o;
                      x0[m] = x1[m]; x1[m] = x2[m]; x2[m] = x3[m]; }
                  if (cgp >= 32) { const f32x2* o = hh == 0 ? oa : ob; u32x4 w; w.x = pk2(o[0].x, o[0].y); w.y = pk2(o[1].x, o[1].y); w.z = pk2(o[2].x, o[2].y); w.w = pk2(o[3].x, o[3].y);
                      if (cgp < 48) *(LAS u32x4*)(Bm + (i0 + ii) * 136 + 8 * (cgp - 32)) = w; else *(LAS u32x4*)(Cm + (i0 + ii) * 136 + 8 * (cgp - 48)) = w; } }
#pragma unroll
              for (int m = 0; m < 4; ++m) { pk[2 * m][i2] = pk2(oa[m].x, ob[m].x); pk[2 * m + 1][i2] = pk2(oa[m].y, ob[m].y); } }
#undef UNPK2
          if (cgp < 48) { LAS bf16_t* dstT = cgp < 32 ? XT : BT; const int rb = cgp < 32 ? 8 * cgp : 8 * (cgp - 32);
#pragma unroll
              for (int k = 0; k < 8; ++k) *(LAS u32x4*)(dstT + swz72(rb + k, tg)) = (u32x4){pk[k][0], pk[k][1], pk[k][2], pk[k][3]}; } }
        BAR_LDS();
        RELAUNDER();
        { const int mt = wave & 3;
#pragma unroll
          for (int tn = 0; tn < 2; ++tn) { const int nt = 2 * (wave >> 2) + tn; f32x4 acc = (f32x4){0.f, 0.f, 0.f, 0.f};
#pragma unroll
              for (int ks = 0; ks < 4; ++ks) acc = mma32(ldfrag(Cm + 16 * mt * 136 + 32 * ks, 136, r, q), ldfrag(Bm + 16 * nt * 136 + 32 * ks, 136, r, q), acc);
#pragma unroll
              for (int j = 0; j < 4; ++j) CB[(16 * mt + 4 * q + j) * 72 + 16 * nt + r] = (bf16_t)f2bf(acc[j]); } }
        BAR_LDS();
        RELAUNDER();
        SSD_DT_PREFETCH(c + 1 < 65 ? c + 1 : 64);
        f32x4 acc1[4][2];
#pragma unroll
        for (int lt = 0; lt < 4; ++lt) { acc1[lt][0] = (f32x4){0.f, 0.f, 0.f, 0.f}; acc1[lt][1] = acc1[lt][0]; }
        const LAS float* acu = ACU + e * 64; const LAS float* dtv = DTV + e * 64;
#pragma unroll
        for (int nt = 0; nt < 8; ++nt) { const bf16x4 sb0 = cvt4(st[nt][0]), sb1 = cvt4(st[nt][1]);
#pragma unroll
            for (int lt = 0; lt < 4; ++lt) { const bf16x4 a4 = ldfrag4(Cm + 16 * lt * 136 + 16 * nt, 136, r, q); acc1[lt][0] = mma16(a4, sb0, acc1[lt][0]); acc1[lt][1] = mma16(a4, sb1, acc1[lt][1]); }
            __builtin_amdgcn_sched_barrier(0); }
#pragma unroll
        for (int lt = 0; lt < 4; ++lt)
#pragma unroll
            for (int j = 0; j < 4; ++j) { const float ea = __expf(acu[16 * lt + 4 * q + j]); acc1[lt][0][j] *= ea; acc1[lt][1][j] *= ea; }
#pragma unroll
        for (int lt = 0; lt < 4; ++lt)
#pragma unroll
            for (int ks = 0; ks < 2; ++ks) { if (ks == 1 && lt < 2) continue;
                const bf16x8 fr0 = ldfrag(CB + 16 * lt * 72 + 32 * ks, 72, r, q); const int ll = 16 * lt + r; const float al = acu[ll]; float f[8];
                const f32x4 ac0 = *(const LAS f32x4*)(acu + 32 * ks + 8 * q), ac1 = *(const LAS f32x4*)(acu + 32 * ks + 8 * q + 4), dt0 = *(const LAS f32x4*)(dtv + 32 * ks + 8 * q), dt1 = *(const LAS f32x4*)(dtv + 32 * ks + 8 * q + 4);
#pragma unroll
                for (int i = 0; i < 8; ++i) { const int s = 32 * ks + 8 * q + i; const float as_ = i < 4 ? ac0[i & 3] : ac1[i & 3], ds_ = i < 4 ? dt0[i & 3] : dt1[i & 3]; f[i] = (s <= ll) ? __expf(al - as_) * ds_ : 0.f; }
                const bf16x8 fm = scale8(fr0, f);
#pragma unroll
                for (int pt = 0; pt < 2; ++pt) acc1[lt][pt] = mma32(fm, *(const LAS bf16x8*)(XT + swz72(64 * e + 16 * (ptb + pt) + r, 4 * ks + q)), acc1[lt][pt]);
                __builtin_amdgcn_sched_barrier(0); }
#pragma unroll
        for (int lt = 0; lt < 4; ++lt)
#pragma unroll
            for (int j = 0; j < 4; ++j) { const int ll = 16 * lt + 4 * q + j;
#pragma unroll
                for (int pt = 0; pt < 2; ++pt) { const int pp = 16 * (ptb + pt) + r; YL[ll * 264 + 64 * e + pp] = (bf16_t)f2bf(acc1[lt][pt][j] + De * bf2f(XT[swz72(64 * e + pp, ll >> 3) + (ll & 7)])); } }
        u32x4 zreg[4];
#pragma unroll
        for (int rep = 0; rep < 4; ++rep) { const int idx = tid + 512 * rep, ll = idx >> 5, grp = idx & 31, t = 64 * c - 48 + ll;
            zreg[rep] = *(const u32x4*)(P + (size_t)row_of(b, t >= 0 ? t : 0) * NP + OFF_SSM + 256 * g + 8 * grp); }
        { const float a63 = acu[63], sc = __expf(a63); bf16x8 fx[2][2];
#pragma unroll
          for (int pt = 0; pt < 2; ++pt)
#pragma unroll
              for (int ks = 0; ks < 2; ++ks) { float f[8];
                  const f32x4 ac0 = *(const LAS f32x4*)(acu + 32 * ks + 8 * q), ac1 = *(const LAS f32x4*)(acu + 32 * ks + 8 * q + 4), dt0 = *(const LAS f32x4*)(dtv + 32 * ks + 8 * q), dt1 = *(const LAS f32x4*)(dtv + 32 * ks + 8 * q + 4);
#pragma unroll
                  for (int i = 0; i < 8; ++i) { const float as_ = i < 4 ? ac0[i & 3] : ac1[i & 3], ds_ = i < 4 ? dt0[i & 3] : dt1[i & 3]; f[i] = __expf(a63 - as_) * ds_; }
                  fx[pt][ks] = scale8(*(const LAS bf16x8*)(XT + swz72(64 * e + 16 * (ptb + pt) + r, 4 * ks + q)), f); }
#pragma unroll
          for (int nt = 0; nt < 8; ++nt) { const bf16x8 b0 = *(const LAS bf16x8*)(BT + swz72(16 * nt + r, q)), b1 = *(const LAS bf16x8*)(BT + swz72(16 * nt + r, 4 + q));
#pragma unroll
              for (int pt = 0; pt < 2; ++pt) { f32x4 s_ = st[nt][pt] * sc; s_ = mma32(b0, fx[pt][0], s_); s_ = mma32(b1, fx[pt][1], s_); st[nt][pt] = s_; }
              __builtin_amdgcn_sched_barrier(0); } }
        BAR_LDS();
        RELAUNDER();
#pragma unroll
        for (int rep = 0; rep < 4; ++rep) { const int idx = tid + 512 * rep, ll = idx >> 5, grp = idx & 31, t = 64 * c - 48 + ll; float y[8], zz[8];
            unpack8(*(const LAS u32x4*)(YL + ll * 264 + 8 * grp), y);
            const size_t row = (size_t)row_of(b, t >= 0 ? t : 0);
            unpack8(zreg[rep], zz);
            float ss = 0.f;
#pragma unroll
            for (int k = 0; k < 8; ++k) { y[k] *= siluf_(zz[k]); ss += y[k] * y[k]; }
            ss = half_sum32(ss);
            const float rs = rsqrtf(ss * (1.f / 256.f) + 1e-5f); const float* nwp = normw + 256 * g + 8 * grp;
            u32x4 w; w.x = pk2(y[0] * rs * nwp[0], y[1] * rs * nwp[1]); w.y = pk2(y[2] * rs * nwp[2], y[3] * rs * nwp[3]); w.z = pk2(y[4] * rs * nwp[4], y[5] * rs * nwp[5]); w.w = pk2(y[6] * rs * nwp[6], y[7] * rs * nwp[7]);
            if (t >= 0) *(u32x4*)(YS1 + row * DM + 256 * g + 8 * grp) = w; }
        BAR_LDS();
    }
}
#undef RELAUNDER
#undef SSD_DT_PREFETCH

__device__ __forceinline__ void ret_unit(const KP& p, int b, int h, LAS unsigned char* lds, const int WAVE_U) {
    int tid_ = TIDX; asm volatile("" : "+v"(tid_)); const int tid = tid_, wave = __builtin_amdgcn_readfirstlane(tid >> 6), lane = tid & 63, r = lane & 15, q = lane >> 4;
    const bf16_t* P = (const bf16_t*)(p.ws + WS_P);
    bf16_t* YS2 = (bf16_t*)(p.ws + WS_YS) + (size_t)2 * MP * DM;
    LAS bf16_t* Q = (LAS bf16_t*)(lds + 0); LAS bf16_t* K = (LAS bf16_t*)(lds + 9216); LAS bf16_t* KT = (LAS bf16_t*)(lds + 18432); LAS bf16_t* VT = (LAS bf16_t*)(lds + 27648);
    LAS bf16_t* CB = (LAS bf16_t*)(lds + 46080); LAS bf16_t* YL = (LAS bf16_t*)(lds + 57344);
    const float lg0 = log2f(1.f - exp2f(-5.f - (float)h));
    f32x4 st[4];
#pragma unroll
    for (int i = 0; i < 4; ++i) st[i] = (f32x4){0.f, 0.f, 0.f, 0.f};
    const int f_ = tid & 31, it = tid >> 5; const float freq = powf(10000.f, -(float)f_ / 32.f);
    float lg = lg0;
    for (int c = 0; c < 65; ++c) {
        asm volatile("" : "+v"(lg));
        u32x4 greg[2];
#pragma unroll
        for (int rep = 0; rep < 2; ++rep) { const int idx = tid + 512 * rep, ll = idx >> 4, grp = idx & 15, t = 64 * c - 48 + ll;
            greg[rep] = *(const u32x4*)(P + (size_t)row_of(b, t >= 0 ? t : 0) * NP + OFF_RET + 2048 + 128 * h + 8 * grp); }
#pragma unroll
        for (int rep = 0; rep < 4; ++rep) { const int i = it + 16 * rep, t = 64 * c - 48 + i; float qa = 0.f, qb = 0.f, ka = 0.f, kb = 0.f;
            { const bf16_t* pr = P + (size_t)row_of(b, t >= 0 ? t : 0) * NP + OFF_RET + 64 * h + f_; const float vz = t >= 0 ? 1.f : 0.f; const float q1 = vz * bf2f(pr[0]), q2 = vz * bf2f(pr[32]), k1 = vz * bf2f(pr[512]), k2 = vz * bf2f(pr[544]);
                double rv = (double)((float)t * freq) * 0.15915494309189535; rv -= __builtin_rint(rv); const float rf = (float)rv; const float sn = __builtin_amdgcn_sinf(rf), cs = __builtin_amdgcn_cosf(rf); qa = q1 * cs - q2 * sn; qb = q2 * cs + q1 * sn; ka = (k1 * cs - k2 * sn) * 0.125f; kb = (k2 * cs + k1 * sn) * 0.125f; }
            Q[i * 72 + f_] = (bf16_t)f2bf(qa); Q[i * 72 + 32 + f_] = (bf16_t)f2bf(qb); const bf16_t kab = (bf16_t)f2bf(ka), kbb = (bf16_t)f2bf(kb);
            K[i * 72 + f_] = kab; K[i * 72 + 32 + f_] = kbb; KT[f_ * 72 + i] = kab; KT[(f_ + 32) * 72 + i] = kbb; }
#pragma unroll
        for (int rep = 0; rep < 2; ++rep) { const int idx = tid + 512 * rep, i = idx >> 4, grp = idx & 15, t = 64 * c - 48 + i; u32x4 w = (u32x4){0u, 0u, 0u, 0u};
            w = *(const u32x4*)(P + (size_t)row_of(b, t >= 0 ? t : 0) * NP + OFF_RET + 1024 + 128 * h + 8 * grp); if (t < 0) w = (u32x4){0u, 0u, 0u, 0u};
            LAS bf16_t* d = VT + (8 * grp) * 72 + i;
            d[0] = (bf16_t)(w.x & 0xffffu); d[72] = (bf16_t)(w.x >> 16); d[144] = (bf16_t)(w.y & 0xffffu); d[216] = (bf16_t)(w.y >> 16);
            d[288] = (bf16_t)(w.z & 0xffffu); d[360] = (bf16_t)(w.z >> 16); d[432] = (bf16_t)(w.w & 0xffffu); d[504] = (bf16_t)(w.w >> 16); }
        BAR_LDS();
        { const int mt = wave & 3;
#pragma unroll
          for (int tn = 0; tn < 2; ++tn) { const int nt = 2 * (wave >> 2) + tn; f32x4 acc = (f32x4){0.f, 0.f, 0.f, 0.f};
#pragma unroll
              for (int ks = 0; ks < 2; ++ks) acc = mma32(ldfrag(Q + 16 * mt * 72 + 32 * ks, 72, r, q), ldfrag(K + 16 * nt * 72 + 32 * ks, 72, r, q), acc);
#pragma unroll
              for (int j = 0; j < 4; ++j) CB[(16 * mt + 4 * q + j) * 72 + 16 * nt + r] = (bf16_t)f2bf(acc[j]); } }
        BAR_LDS();
        f32x4 acc1[4];
#pragma unroll
        for (int lt = 0; lt < 4; ++lt) acc1[lt] = (f32x4){0.f, 0.f, 0.f, 0.f};
#pragma unroll
        for (int dt = 0; dt < 4; ++dt) { const bf16x4 sb = cvt4(st[dt]);
#pragma unroll
            for (int lt = 0; lt < 4; ++lt) acc1[lt] = mma16(ldfrag4(Q + 16 * lt * 72 + 16 * dt, 72, r, q), sb, acc1[lt]); }
#pragma unroll
        for (int lt = 0; lt < 4; ++lt)
#pragma unroll
            for (int j = 0; j < 4; ++j) acc1[lt][j] *= __builtin_amdgcn_exp2f((float)(16 * lt + 4 * q + j + 1) * lg);
#pragma unroll
        for (int lt = 0; lt < 4; ++lt)
#pragma unroll
            for (int ks = 0; ks < 2; ++ks) { if (ks == 1 && lt < 2) continue;
                const int ll = 16 * lt + r; float f[8];
#pragma unroll
                for (int i = 0; i < 8; ++i) { const int s = 32 * ks + 8 * q + i; f[i] = (s <= ll) ? __builtin_amdgcn_exp2f((float)(ll - s) * lg) : 0.f; }
                acc1[lt] = mma32(scale8(ldfrag(CB + 16 * lt * 72 + 32 * ks, 72, r, q), f), ldfrag(VT + 16 * wave * 72 + 32 * ks, 72, r, q), acc1[lt]); }
#pragma unroll
        for (int lt = 0; lt < 4; ++lt)
#pragma unroll
            for (int j = 0; j < 4; ++j) YL[(16 * lt + 4 * q + j) * 136 + 16 * wave + r] = (bf16_t)f2bf(acc1[lt][j]);
        { const float sc = __builtin_amdgcn_exp2f(64.f * lg); bf16x8 fv[2];
#pragma unroll
          for (int ks = 0; ks < 2; ++ks) { float f[8];
#pragma unroll
              for (int i = 0; i < 8; ++i) f[i] = __builtin_amdgcn_exp2f((float)(63 - (32 * ks + 8 * q + i)) * lg);
              fv[ks] = scale8(ldfrag(VT + 16 * wave * 72 + 32 * ks, 72, r, q), f); }
#pragma unroll
          for (int dt = 0; dt < 4; ++dt) { f32x4 s_ = st[dt] * sc; s_ = mma32(ldfrag(KT + 16 * dt * 72, 72, r, q), fv[0], s_); s_ = mma32(ldfrag(KT + 16 * dt * 72 + 32, 72, r, q), fv[1], s_); st[dt] = s_; } }
        BAR_LDS();
#pragma unroll
        for (int rep = 0; rep < 2; ++rep) { const int idx = tid + 512 * rep, ll = idx >> 4, grp = idx & 15, t = 64 * c - 48 + ll; float y[8], gg[8];
            unpack8(*(const LAS u32x4*)(YL + ll * 136 + 8 * grp), y);
            const size_t row = (size_t)row_of(b, t >= 0 ? t : 0);
            unpack8(greg[rep], gg);
            float ss = 0.f;
#pragma unroll
            for (int k = 0; k < 8; ++k) ss += y[k] * y[k];
            ss += __shfl_xor(ss, 1); ss += __shfl_xor(ss, 2); ss += __shfl_xor(ss, 4); ss += __shfl_xor(ss, 8);
            const float rs = rsqrtf(ss * (1.f / 128.f) + 1e-6f);
            u32x4 w; w.x = pk2(siluf_(gg[0]) * y[0] * rs, siluf_(gg[1]) * y[1] * rs); w.y = pk2(siluf_(gg[2]) * y[2] * rs, siluf_(gg[3]) * y[3] * rs);
            w.z = pk2(siluf_(gg[4]) * y[4] * rs, siluf_(gg[5]) * y[5] * rs); w.w = pk2(siluf_(gg[6]) * y[6] * rs, siluf_(gg[7]) * y[7] * rs);
            if (t >= 0) *(u32x4*)(YS2 + row * DM + 128 * h + 8 * grp) = w; }
        BAR_LDS();
    }
}

__device__ __forceinline__ void lru_unit(const KP& p, int l, int b, int n, int hf, LAS unsigned char* lds, const int WAVE_U) {
    int tid_ = TIDX; asm volatile("" : "+v"(tid_)); const int tid = tid_, wave = __builtin_amdgcn_readfirstlane(tid >> 6), lane = tid & 63, r = lane & 15, q = lane >> 4;
    const bf16_t* P = (const bf16_t*)(p.ws + WS_P);
    bf16_t* YS3 = (bf16_t*)(p.ws + WS_YS) + (size_t)3 * MP * DM;
    const float* conv_w = p.in[20] + (size_t)l * 4 * DM; const float* conv_b = p.in[21] + (size_t)l * DM;
    const float* wg = p.in[22] + (size_t)l * 2 * 8 * 128 * 128; const float* bg = p.in[23] + (size_t)l * 2 * DM; const float* lam = p.in[24] + (size_t)l * DM;
    LAS bf16_t* WGT = (LAS bf16_t*)(lds + 0); LAS bf16_t* XC = (LAS bf16_t*)(lds + 34816); LAS float* AA = (LAS float*)(lds + 52224); LAS float* UU = (LAS float*)(lds + 68608);
    LAS float* SEG = (LAS float*)(lds + 84992); LAS float* CAR = (LAS float*)(lds + 89088);
    for (int idx = tid; idx < 2 * 64 * 128; idx += 512) { const int k = idx >> 13, rem = idx & 8191, cc = rem >> 6, e = rem & 63;
        WGT[(k * 64 + e) * 136 + cc] = (bf16_t)f2bf(wg[((size_t)(k * 8 + n) * 128 + cc) * 128 + 64 * hf + e]); }
    if (tid < 64) CAR[tid] = 0.f;
    const int cgp = tid & 15, tg = tid >> 4, cb8 = 128 * n + 8 * cgp, pcol = OFF_LRU + 1024 + cb8;
    const int chs = 128 * n + 64 * hf + (tid & 63), seg = tid >> 6;
    __syncthreads();
    for (int c = 0; c < 65; ++c) {
        unsigned short yin[8];
#pragma unroll
        for (int i = 0; i < 8; ++i) { const int t = 64 * c - 48 + 8 * seg + i; yin[i] = P[(size_t)row_of(b, t >= 0 ? t : 0) * NP + OFF_LRU + chs]; }
        { float cw0[8], cw1[8], cw2[8], cw3[8], cb[8]; u32x4 raw[5];
          const int i0 = 2 * tg, t0 = 64 * c - 48 + i0;
#pragma unroll
          for (int j = 0; j < 5; ++j) { const int t = t0 - 3 + j; raw[j] = *(const u32x4*)(P + (size_t)row_of(b, t >= 0 ? t : 0) * NP + pcol); if (t < 0) raw[j] = (u32x4){0u, 0u, 0u, 0u}; }
#pragma unroll
          for (int k = 0; k < 8; ++k) { cw0[k] = conv_w[cb8 + k]; cw1[k] = conv_w[DM + cb8 + k]; cw2[k] = conv_w[2 * DM + cb8 + k]; cw3[k] = conv_w[3 * DM + cb8 + k]; cb[k] = conv_b[cb8 + k]; }
#pragma unroll
          for (int ii = 0; ii < 2; ++ii) { const int t = t0 + ii, i = i0 + ii; float x0[8], x1[8], x2[8], x3[8], o[8];
              unpack8(raw[ii], x0); unpack8(raw[ii + 1], x1); unpack8(raw[ii + 2], x2); unpack8(raw[ii + 3], x3);
#pragma unroll
              for (int k = 0; k < 8; ++k) { const float z = cb[k] + cw0[k] * x0[k] + cw1[k] * x1[k] + cw2[k] * x2[k] + cw3[k] * x3[k]; o[k] = t >= 0 ? z : 0.f; }
              u32x4 w; w.x = pk2(o[0], o[1]); w.y = pk2(o[2], o[3]); w.z = pk2(o[4], o[5]); w.w = pk2(o[6], o[7]);
              *(LAS u32x4*)(XC + i * 136 + 8 * cgp) = w; } }
        BAR_LDS();
        { const int lt = wave & 3;
#pragma unroll
          for (int te = 0; te < 2; ++te) { const int et = 2 * (wave >> 2) + te; f32x4 a0 = (f32x4){0.f, 0.f, 0.f, 0.f}, a1 = a0;
#pragma unroll
              for (int ks = 0; ks < 4; ++ks) { const bf16x8 xa = ldfrag(XC + 16 * lt * 136 + 32 * ks, 136, r, q);
                  a0 = mma32(xa, ldfrag(WGT + (16 * et) * 136 + 32 * ks, 136, r, q), a0); a1 = mma32(xa, ldfrag(WGT + (64 + 16 * et) * 136 + 32 * ks, 136, r, q), a1); }
              const int e = 16 * et + r, chn = 128 * n + 64 * hf + e; const float b0 = bg[chn], b1 = bg[DM + chn], spl = softplusf_(-lam[chn]);
#pragma unroll
              for (int j = 0; j < 4; ++j) { const int tok = 16 * lt + 4 * q + j, t = 64 * c - 48 + tok;
                  const float rg = sigmoidf_(a0[j] + b0), ig = sigmoidf_(a1[j] + b1), la = -8.f * rg * spl; float a = __expf(la), u = __builtin_amdgcn_sqrtf(fmaxf(1.f - __expf(2.f * la), 0.f)) * ig * bf2f(XC[tok * 136 + 64 * hf + e]);
                  if (t < 0) { a = 1.f; u = 0.f; }
                  AA[tok * 64 + e] = a; UU[tok * 64 + e] = u; } } }
        BAR_LDS();
        { const int ch = tid & 63; float A = 1.f, H = 0.f;
#pragma unroll
          for (int i = 0; i < 8; ++i) { const float a = AA[(8 * seg + i) * 64 + ch], u = UU[(8 * seg + i) * 64 + ch]; H = a * H + u; A *= a; }
          SEG[(seg * 64 + ch) * 2] = A; SEG[(seg * 64 + ch) * 2 + 1] = H;
          BAR_LDS();
          float hcar = CAR[ch];
          for (int s2 = 0; s2 < seg; ++s2) hcar = SEG[(s2 * 64 + ch) * 2] * hcar + SEG[(s2 * 64 + ch) * 2 + 1];
#pragma unroll
          for (int i = 0; i < 8; ++i) { const int tok = 8 * seg + i, t = 64 * c - 48 + tok; hcar = AA[tok * 64 + ch] * hcar + UU[tok * 64 + ch];
              if (t >= 0) { const size_t row = (size_t)row_of(b, t); const float x = bf2f(yin[i]);
                  const float tu = 0.7978845608f * (x + 0.044715f * x * x * x); const float ge = 0.5f * x * (2.f - 2.f * __builtin_amdgcn_rcpf(1.f + __expf(2.f * tu)));
                  YS3[row * DM + chs] = (bf16_t)f2bf(hcar * ge); } }
          BAR_LDS();
          if (seg == 7) CAR[ch] = hcar; }
        BAR_LDS();
    }
}


__device__ __forceinline__ f32x4 skinny_tile(const bf16_t* A, const bf16_t* Bt, int K, int j, LAS unsigned char* lds, int wave, int lane) {
    const int r = lane & 15, q = lane >> 4; f32x4 acc[4];
#pragma unroll
    for (int nt = 0; nt < 4; ++nt) acc[nt] = (f32x4){0.f, 0.f, 0.f, 0.f};
    const bf16_t* ap = A + (size_t)(MMAIN + r) * K + 8 * q; const bf16_t* bp = Bt + (size_t)(64 * j + r) * K + 8 * q;
    const int nks = K / 32;
    for (int ks = wave; ks < nks; ks += 8) { const bf16x8 a = *(const bf16x8*)(ap + 32 * ks);
#pragma unroll
        for (int nt = 0; nt < 4; ++nt) acc[nt] = mma32(a, *(const bf16x8*)(bp + (size_t)16 * nt * K + 32 * ks), acc[nt]); }
    LAS f32x4* red = (LAS f32x4*)lds;
#pragma unroll
    for (int nt = 0; nt < 4; ++nt) red[(wave * 4 + nt) * 64 + lane] = acc[nt];
    __syncthreads();
    f32x4 tot = (f32x4){0.f, 0.f, 0.f, 0.f};
    if (wave < 4) {
#pragma unroll
        for (int w = 0; w < 8; ++w) tot += red[(w * 4 + wave) * 64 + lane]; }
    __syncthreads();
    return tot;
}
__device__ __forceinline__ void skinny_branch(const bf16_t* YS, const bf16_t* br_t, const bf16_t* P, float* Z, bf16_t* ZB, int j, LAS unsigned char* lds, const int WAVE_U) {
    int tid = TIDX; asm volatile("" : "+v"(tid)); const int wave = __builtin_amdgcn_readfirstlane(tid >> 6), lane = tid & 63, r = lane & 15, q = lane >> 4;
    for (int n = 0; n < 4; ++n) {
        const f32x4 acc = skinny_tile(YS + (size_t)n * MP * DM, br_t + (size_t)n * 1024 * DM, DM, j, lds, wave, lane);
        if (wave < 4) { const int col = 64 * j + 16 * wave + r;
#pragma unroll
            for (int jj = 0; jj < 4; ++jj) { const size_t row = MMAIN + 4 * q + jj; float v = sigmoidf_(bf2f(P[row * NP + OFF_GATE + n * 1024 + col])) * acc[jj];
                if (n != 0) v += Z[row * DM + col];
                if (n != 3) Z[row * DM + col] = v; else ZB[row * DM + col] = (bf16_t)f2bf(v); } }
    }
}
__device__ __forceinline__ void skinny_resid(const bf16_t* A, const bf16_t* Bt, int K, float* S, bf16_t* HN, const float* nw, float* ssq, int j, LAS unsigned char* lds, const int WAVE_U) {
    int tid = TIDX; asm volatile("" : "+v"(tid)); const int wave = __builtin_amdgcn_readfirstlane(tid >> 6), lane = tid & 63, r = lane & 15, q = lane >> 4;
    const f32x4 acc = skinny_tile(A, Bt, K, j, lds, wave, lane);
    LAS float* part = (LAS float*)lds;
    if (wave < 4) { const int col = 64 * j + 16 * wave + r; const float w = nw[col];
#pragma unroll
        for (int jj = 0; jj < 4; ++jj) { const size_t row = MMAIN + 4 * q + jj; const float sn = S[row * DM + col] + acc[jj]; S[row * DM + col] = sn; HN[row * DM + col] = (bf16_t)f2bf(sn * w);
            float ss = sn * sn; ss = DPP_ADD(ss, 0xB1); ss = DPP_ADD(ss, 0x4E); ss = DPP_ADD(ss, 0x141); ss = DPP_ADD(ss, 0x140);
            if (r == 0) part[wave * 16 + 4 * q + jj] = ss; } }
    __syncthreads();
    if (tid < 16) ssq[(size_t)(MMAIN + tid) * 16 + j] = (part[tid] + part[16 + tid]) + (part[32 + tid] + part[48 + tid]);
    __syncthreads();
}


#define XB_TMO      128
#define XB_XCNT(j)  (256  + 64 * (j))
#define XB_XSUB(j)  (1280 + 64 * (j))
#define XB_XGEN(j)  (2304 + 64 * (j))
#define XB_TOP      3328
#define XB_TOPGEN   3392
#define XCD_BAR_WORDS 3456
#define XB_SPIN_CAP (1u << 20)
__device__ __forceinline__ unsigned xb_ld(unsigned* p)              { return __hip_atomic_load(p, __ATOMIC_RELAXED, __HIP_MEMORY_SCOPE_AGENT); }
__device__ __forceinline__ unsigned xb_add(unsigned* p, unsigned v) { return __hip_atomic_fetch_add(p, v, __ATOMIC_RELAXED, __HIP_MEMORY_SCOPE_AGENT); }
__device__ __forceinline__ unsigned xb_xcc_id() { return (unsigned)__builtin_amdgcn_s_getreg((3 << 11) | 20) & 0xFu; }
#define XB_SPIN(cond, bar) do { unsigned _sp = 0; while (cond) { __builtin_amdgcn_s_sleep(1); \
    if ((++_sp & 255u) == 0u) { if (xb_ld(&(bar)[XB_TMO])) break; if (_sp > XB_SPIN_CAP) { atomicAdd(&(bar)[XB_TMO], 1u); break; } } } } while (0)
struct XcdBarrier { unsigned* bar; unsigned x; volatile LAS unsigned* st; };
__device__ __forceinline__ XcdBarrier xcd_barrier_post(unsigned* bar, volatile LAS unsigned* st, const int WAVE_U) {
    XcdBarrier b; b.bar = bar; b.x = (unsigned)__builtin_amdgcn_readfirstlane((int)xb_xcc_id()); b.st = st;
    if (TIDX == 0) (void)xb_add(&bar[XB_XCNT(b.x)], 1u);
    return b;
}
__device__ __forceinline__ void xcd_barrier_complete(unsigned* bar, unsigned x, unsigned& nloc, unsigned& nx) {
    const unsigned G = gridDim.x * gridDim.y * gridDim.z;
    unsigned sum, cnt, mine, sp = 0u;
    for (;;) {
        sum = 0u; cnt = 0u; mine = 0u;
#pragma unroll
        for (unsigned j = 0; j < 16; ++j) { const unsigned c = xb_ld(&bar[XB_XCNT(j)]); sum += c; cnt += (c > 0u) ? 1u : 0u; mine = (j == x) ? c : mine; }
        if (sum == G) break;
        __builtin_amdgcn_s_sleep(1);
        if ((++sp & 255u) == 0u) { if (xb_ld(&bar[XB_TMO])) break; if (sp > XB_SPIN_CAP) { atomicAdd(&bar[XB_TMO], 1u); break; } }
    }
    nloc = mine > 0u ? mine : 1u; nx = cnt > 0u ? cnt : 1u;
}
__device__ __forceinline__ void xcd_barrier(const XcdBarrier& b, const int WAVE_U) {
    asm volatile("s_waitcnt vmcnt(0)" ::: "memory");
    __syncthreads();
    if (TIDX == 0) {
        unsigned* bar = b.bar;
        __builtin_amdgcn_s_waitcnt(0);
        unsigned nloc = b.st[0], nx = b.st[1];
        if (nloc == 0u) { xcd_barrier_complete(bar, b.x, nloc, nx); b.st[0] = nloc; b.st[1] = nx; }
        const unsigned old = xb_add(&bar[XB_XSUB(b.x)], 1u);
        const unsigned gen = old / nloc;
        if (old + 1u == (gen + 1u) * nloc) {
            __builtin_amdgcn_fence(__ATOMIC_RELEASE, "agent");
            asm volatile("s_waitcnt vmcnt(0)" ::: "memory");
            const unsigned og = xb_add(&bar[XB_TOP], 1u);
            const unsigned tg = og / nx;
            if (og + 1u == (tg + 1u) * nx) xb_add(&bar[XB_TOPGEN], 1u);
            else XB_SPIN(xb_ld(&bar[XB_TOPGEN]) == tg, bar);
            __builtin_amdgcn_fence(__ATOMIC_ACQUIRE, "agent");
            xb_add(&bar[XB_XGEN(b.x)], 1u);
            asm volatile("s_waitcnt vmcnt(0)" ::: "memory");
        } else {
            XB_SPIN(xb_ld(&bar[XB_XGEN(b.x)]) == gen, bar);
            __builtin_amdgcn_fence(__ATOMIC_ACQUIRE, "agent");
            asm volatile("s_waitcnt vmcnt(0)" ::: "memory");
        }
    }
    __syncthreads();
}


__device__ __forceinline__ void subgrid_arrive(unsigned* word, const int WAVE_U) {
    asm volatile("s_waitcnt vmcnt(0)" ::: "memory");
    __syncthreads();
    if (TIDX == 0) { __builtin_amdgcn_fence(__ATOMIC_RELEASE, "agent"); asm volatile("s_waitcnt vmcnt(0)" ::: "memory"); (void)xb_add(word, 1u); }
}
__device__ __forceinline__ void subgrid_wait(unsigned* word, unsigned nblocks, const int WAVE_U) {
    if (TIDX == 0) { unsigned sp = 0u; while (xb_ld(word) < nblocks) { __builtin_amdgcn_s_sleep(1); if (++sp > (1u << 22)) break; }
        __builtin_amdgcn_fence(__ATOMIC_ACQUIRE, "agent"); asm volatile("s_waitcnt vmcnt(0)" ::: "memory"); }
    __syncthreads();
}
__device__ __forceinline__ void subgrid_barrier(unsigned* word, unsigned nblocks, const int WAVE_U) {
    asm volatile("s_waitcnt vmcnt(0)" ::: "memory");
    __syncthreads();
    if (TIDX == 0) {
        __builtin_amdgcn_fence(__ATOMIC_RELEASE, "agent");
        asm volatile("s_waitcnt vmcnt(0)" ::: "memory");
        (void)xb_add(word, 1u);
        unsigned sp = 0u;
        while (xb_ld(word) < nblocks) { __builtin_amdgcn_s_sleep(1); if (++sp > (1u << 22)) break; }
        __builtin_amdgcn_fence(__ATOMIC_ACQUIRE, "agent");
        asm volatile("s_waitcnt vmcnt(0)" ::: "memory");
    }
    __syncthreads();
}

#ifndef REP_P1
#define REP_P1 1
#endif
#ifndef REP_RWKV
#define REP_RWKV 1
#endif
#ifndef REP_SSD
#define REP_SSD 1
#endif
#ifndef REP_RET
#define REP_RET 1
#endif
#ifndef REP_LRU
#define REP_LRU 1
#endif
#ifndef PH_MASK
#define PH_MASK 1023
#endif
constexpr int LDS_BYTES = 163840;
constexpr int NUNITS = 176;

__global__ void __launch_bounds__(512, 2) fwd_megakernel(KP p) {
    extern __shared__ __attribute__((aligned(16))) unsigned char lds_raw[];
    LAS unsigned char* lds = (LAS unsigned char*)lds_raw;
    cg::grid_group grid = cg::this_grid();
    const int WAVE_U = __builtin_amdgcn_readfirstlane((int)(threadIdx.x >> 6));
    constexpr int G = 256; int bx = blockIdx.x; constexpr int NGW = G * 8;
#define FRESH_TID() int tid_ = TIDX; asm volatile("" : "+v"(tid_)); const int tid = tid_, wave = tid >> 6, lane = tid & 63, gw = bx * 8 + wave; (void)gw; (void)lane
    float* ssq = (float*)(p.ws + WS_SSQ); float* S = (float*)(p.ws + WS_S); bf16_t* HN = (bf16_t*)(p.ws + WS_HN); bf16_t* P = (bf16_t*)(p.ws + WS_P);
    bf16_t* YS = (bf16_t*)(p.ws + WS_YS); float* Z = (float*)(p.ws + WS_Z); bf16_t* ZB = (bf16_t*)(p.ws + WS_ZB); bf16_t* WIN = (bf16_t*)(p.ws + WS_WIN);
    bf16_t* H = (bf16_t*)(p.ws + WS_P);
    {
        FRESH_TID();
        const float* nw0 = p.in[2];
        for (int m = gw; m < MP; m += NGW) {
            const float* src = m < MMAIN ? p.in[0] + (size_t)m * DM : (m < MMAIN + NMETA ? p.in[1] + (size_t)(m - MMAIN) * DM : nullptr);
            float ss = 0.f;
#pragma unroll
            for (int j = 0; j < 4; ++j) { const int col = 4 * lane + 256 * j; f32x4 v = (f32x4){0.f, 0.f, 0.f, 0.f}; if (src) v = *(const f32x4*)(src + col);
                *(f32x4*)(S + (size_t)m * DM + col) = v; const f32x4 w = *(const f32x4*)(nw0 + col);
                u32x2 o; o.x = pk2(v[0] * w[0], v[1] * w[1]); o.y = pk2(v[2] * w[2], v[3] * w[3]); *(u32x2*)(HN + (size_t)m * DM + col) = o;
                ss += (v[0] * v[0] + v[1] * v[1]) + (v[2] * v[2] + v[3] * v[3]); }
#pragma unroll
            for (int o = 1; o < 64; o <<= 1) ss += __shfl_xor(ss, o);
            if (lane < 16) ssq[(size_t)m * 16 + lane] = lane == 0 ? ss : 0.f;
        }
        for (int i = bx * 512 + tid; i < (NP - INW) * DM / 8; i += G * 512) ((u32x4*)(WIN + (size_t)INW * DM))[i] = (u32x4){0u, 0u, 0u, 0u};
        convert_layer(p, 0, lds, gw, NGW, wave, lane);
        if (bx == 0) for (int i = tid; i < XCD_BAR_WORDS + 512; i += 512) ((unsigned*)(p.ws + WS_XBAR))[i] = 0u;
        if (tid == 0) { ((volatile LAS unsigned*)(lds + LDS_BYTES - 16))[0] = 0u; ((volatile LAS unsigned*)(lds + LDS_BYTES - 16))[1] = 0u; }
    }
    grid.sync();
    XcdBarrier xbar = xcd_barrier_post((unsigned*)(p.ws + WS_XBAR), (volatile LAS unsigned*)(lds + LDS_BYTES - 16), WAVE_U);
    for (int l_ = 0; l_ < NLAYER; ++l_) {
        int l = l_; asm volatile("" : "+s"(l)); asm volatile("" : "+s"(bx));
        unsigned char* sm = p.ws + WS_WSM + (size_t)(l & 1) * WSM_SIZE;
        const bf16_t* br_t = (const bf16_t*)(sm + WSM_BR); const bf16_t* out_t = (const bf16_t*)(sm + WSM_OUT); const bf16_t* fi_t = (const bf16_t*)(sm + WSM_FI); const bf16_t* fo_t = (const bf16_t*)(sm + WSM_FO);
        if (PH_MASK & 1) for (int rp = 0; rp < REP_P1; ++rp) { pg8::Gemm g{HN, WIN, DM}; pg8::RemapOrder So; So.b.init(NTM, PT_A + 1, G, bx); So.from = PT_A; So.to = NP / 256 - 1; pg8::EpiInProj E{P, ssq + (size_t)(2 * l) * MP * 16, 0}; pg8::gemm_phase(lds, g, So, E, WAVE_U); }
        xcd_barrier(xbar, WAVE_U);
        asm volatile("" : "+s"(bx));
        { FRESH_TID(); rwkv_lora_inputs(p, l, gw, NGW, lane); }
        xcd_barrier(xbar, WAVE_U);
        asm volatile("" : "+s"(bx));
        {
            int l = l_; asm volatile("" : "+s"(l));
            if (bx < 64) rwkv_unit(p, l, bx >> 4, bx & 15, lds, WAVE_U);
            else if (bx < 80) ssd_unit(p, l, (bx - 64) >> 2, (bx - 64) & 3, lds, WAVE_U);
            else {
                { pg8::Gemm g{HN, WIN + (size_t)PT_A * 256 * DM, DM}; pg8::StaticOrder So; So.init(NTM, GT0 - PT_A, G - 80, bx - 80);
                  pg8::EpiInProj E{P, ssq + (size_t)(2 * l) * MP * 16, PT_A}; pg8::gemm_phase(lds, g, So, E, WAVE_U); }
                unsigned* sbw = (unsigned*)(p.ws + WS_XBAR) + XCD_BAR_WORDS + 64 + 64 * l;
                subgrid_arrive(sbw, WAVE_U);
                if (bx < 176) subgrid_wait(sbw, (unsigned)(G - 80), WAVE_U);
                if (bx < 112) ret_unit(p, (bx - 80) >> 3, (bx - 80) & 7, lds, WAVE_U);
                else if (bx < 176) { const int v = bx - 112; lru_unit(p, l, v >> 4, (v >> 1) & 7, v & 1, lds, WAVE_U); }
                else { { pg8::Gemm g{HN, (const bf16_t*)(p.ws + WS_WING + (size_t)(l & 1) * WING_SIZE), DM}; pg8::StaticOrder So; So.init(NTM, GTN, G - 176, bx - 176);
                         pg8::EpiInProj E{P, ssq + (size_t)(2 * l) * MP * 16, GT0}; pg8::gemm_phase(lds, g, So, E, WAVE_U); }
                       subgrid_wait(sbw, (unsigned)(G - 80), WAVE_U);
                       if (l_ + 1 < NLAYER) { FRESH_TID(); convert_layer(p, l + 1, lds, (bx - 176) * 8 + wave, (G - 176) * 8, wave, lane); } }
            }
        }
        xcd_barrier(xbar, WAVE_U);
        asm volatile("" : "+s"(bx));
        if (PH_MASK & 32) { pg8::Gemm g{YS, br_t, DM}; pg8::BranchOrder So{G, bx}; pg8::EpiBranch E{P, Z, ZB}; pg8::gemm_phase(lds, g, So, E, WAVE_U);
          if (bx < 16) skinny_branch(YS, br_t, P, Z, ZB, bx, lds, WAVE_U); }
        xcd_barrier(xbar, WAVE_U);
        asm volatile("" : "+s"(bx));
        if (PH_MASK & 64) { pg8::Gemm g{ZB, out_t, DM}; pg8::StaticOrder So; So.init(NTM - 1, 4, G, bx); pg8::EpiResid E{S, HN, p.in[3] + (size_t)l * DM, ssq + (size_t)(2 * l + 1) * MP * 16}; pg8::gemm_phase(lds, g, So, E, WAVE_U);
          if (bx < 16) skinny_resid(ZB, out_t, DM, S, HN, p.in[3] + (size_t)l * DM, ssq + (size_t)(2 * l + 1) * MP * 16, bx, lds, WAVE_U); }
        xcd_barrier(xbar, WAVE_U);
        asm volatile("" : "+s"(bx));
        if (PH_MASK & 128) { pg8::Gemm g{HN, fi_t, DM}; pg8::StaticOrder So; So.init(NTM, 2 * FF / 256, G, bx); pg8::EpiSwiglu E{H, ssq + (size_t)(2 * l + 1) * MP * 16}; pg8::gemm_phase(lds, g, So, E, WAVE_U); }
        xcd_barrier(xbar, WAVE_U);
        asm volatile("" : "+s"(bx));
        if (PH_MASK & 256) { pg8::Gemm g{H, fo_t, FF}; pg8::StaticOrder So; So.init(NTM - 1, 4, G, bx); const float* nwn = (l + 1 < NLAYER) ? p.in[2] + (size_t)(l + 1) * DM : p.in[29];
          pg8::EpiResid E{S, HN, nwn, ssq + (size_t)(2 * l + 2) * MP * 16}; pg8::gemm_phase(lds, g, So, E, WAVE_U);
          if (bx < 16) skinny_resid(H, fo_t, FF, S, HN, nwn, ssq + (size_t)(2 * l + 2) * MP * 16, bx, lds, WAVE_U); }
        xcd_barrier(xbar, WAVE_U);
        asm volatile("" : "+s"(bx));
    }
    { FRESH_TID(); const float* fw = p.in[29]; const float* sq = ssq + (size_t)8 * MP * 16;
      for (int m = gw; m < MMAIN; m += NGW) { const float rs = rsqrtf(ssq_total(sq, m) * (1.f / 1024.f) + 1e-6f);
#pragma unroll
          for (int j = 0; j < 4; ++j) { const int col = 4 * lane + 256 * j; const f32x4 v = *(const f32x4*)(S + (size_t)m * DM + col), w = *(const f32x4*)(fw + col);
              *(f32x4*)(p.out + (size_t)m * DM + col) = v * rs * w; } } }
}

extern "C" void kernel_launch(void* const* d_in, const int* in_sizes, int n_in, void* d_out, int out_size, void* d_ws, size_t ws_size, hipStream_t stream) {
    static int grid = 0;
    if (grid == 0) {
        if (n_in != 30 || ws_size < WS_END) { fprintf(stderr, "kernel_launch: unexpected n_in %d / ws %zu (need %zu)\n", n_in, ws_size, (size_t)WS_END); grid = -1; return; }
        int dev = 0, cus = 0, per_cu = 0;
        hipGetDevice(&dev); hipDeviceGetAttribute(&cus, hipDeviceAttributeMultiprocessorCount, dev);
        hipFuncSetAttribute((const void*)fwd_megakernel, hipFuncAttributeMaxDynamicSharedMemorySize, LDS_BYTES);
        hipOccupancyMaxActiveBlocksPerMultiprocessor(&per_cu, (const void*)fwd_megakernel, 512, LDS_BYTES);
        if (per_cu < 1) { fprintf(stderr, "kernel_launch: occupancy query says %d blocks/CU\n", per_cu); per_cu = 1; }
        (void)hipGetLastError();
        grid = 256;
        if (cus < 256) { fprintf(stderr, "kernel_launch: this kernel needs 256 CUs (got %d)\n", cus); grid = -1; return; }
    }
    if (grid < 0) return;
    KP p{};
    for (int i = 0; i < 30; ++i) p.in[i] = (const float*)d_in[i];
    p.out = (float*)d_out; p.ws = (unsigned char*)d_ws;
    void* args[] = {&p};
    hipError_t e = hipLaunchCooperativeKernel((const void*)fwd_megakernel, dim3(grid), dim3(512), args, LDS_BYTES, stream);
    if (e != hipSuccess) fprintf(stderr, "cooperative launch failed: %s (grid %d)\n", hipGetErrorString(e), grid);
}
```

```cpp
#include <hip/hip_runtime.h>
#include <hip/hip_cooperative_groups.h>
#include <cstdio>
#include <cstdint>
namespace cg = cooperative_groups;

#define LAS __attribute__((address_space(3)))
typedef unsigned short bf16_t;
typedef short bf16x8 __attribute__((ext_vector_type(8)));
typedef short bf16x4 __attribute__((ext_vector_type(4)));
typedef float f32x4 __attribute__((ext_vector_type(4)));
typedef unsigned u32x4 __attribute__((ext_vector_type(4)));
typedef unsigned u32x2 __attribute__((ext_vector_type(2)));

constexpr int DM = 1024, NB = 4, SEQ = 4096, NMETA = 16, TT = SEQ + NMETA;
constexpr int MMAIN = NB * SEQ;
constexpr int MP = 16640, NTM = MP / 256;
constexpr int INW = 15632, NP = 15872;
constexpr int OFF_SSM = 3328, OFF_RET = 6416, OFF_LRU = 9488, OFF_GATE = 11536, OFF_VLO = 15632;
constexpr int FF = 2816;
constexpr int NLAYER = 4;

constexpr size_t WS_SSQ = 0;
constexpr size_t WS_XBAR = 12u << 20;
constexpr size_t WS_S = 16u << 20;
constexpr size_t WS_HN = WS_S + (size_t)MP * DM * 4;
constexpr size_t WS_P = WS_HN + (size_t)MP * DM * 2;
constexpr size_t WS_YS = WS_P + (size_t)MP * NP * 2;
constexpr size_t WS_VF = WS_YS + (size_t)4 * MP * DM * 2;
constexpr size_t WS_Z = WS_VF + (size_t)MP * DM * 2;
constexpr size_t WS_ZB = WS_Z + (size_t)MP * DM * 4;
constexpr size_t WS_WIN = WS_ZB + (size_t)MP * DM * 2;
constexpr size_t WSM_BR = 0, WSM_OUT = (size_t)4096 * 1024 * 2, WSM_FI = WSM_OUT + (size_t)1024 * 1024 * 2,
                 WSM_FO = WSM_FI + (size_t)2 * FF * 1024 * 2, WSM_SIZE = WSM_FO + (size_t)1024 * FF * 2;
constexpr size_t WS_WSM = WS_WIN + (size_t)NP * DM * 2;
constexpr int PT_A = 26;
constexpr int GT0 = 46, GTN = 15;
constexpr size_t WS_WING = WS_WSM + 2 * WSM_SIZE, WING_SIZE = (size_t)GTN * 256 * DM * 2;
constexpr size_t WS_END = WS_WING + 2 * WING_SIZE;
static_assert(WS_END <= 1024458752ull, "workspace map exceeds 4 x w_in bytes");

typedef float f32x2_t __attribute__((ext_vector_type(2))); typedef __bf16 bf16x2_t __attribute__((ext_vector_type(2)));
__device__ __forceinline__ unsigned pk2(float lo, float hi) { f32x2_t v = {lo, hi}; bf16x2_t b = __builtin_convertvector(v, bf16x2_t); return __builtin_bit_cast(unsigned, b); }
__device__ __forceinline__ unsigned f2bf(float f) { return pk2(f, f); }
__device__ __forceinline__ float bf2f(unsigned h) { return __builtin_bit_cast(float, h << 16); }
__device__ __forceinline__ float sigmoidf_(float x) { return __builtin_amdgcn_rcpf(1.f + __expf(-x)); }
__device__ __forceinline__ float softplusf_(float x) { return x > 20.f ? x : log1pf(__expf(x)); }
__device__ __forceinline__ float siluf_(float x) { return x * __builtin_amdgcn_rcpf(1.f + __expf(-x)); }
__device__ __forceinline__ int row_of(int b, int t) { return t < NMETA ? MMAIN + t : b * SEQ + (t - NMETA); }
__device__ __forceinline__ void unpack8(u32x4 w, float* f) {
    f[0] = bf2f(w.x & 0xffffu); f[1] = bf2f(w.x >> 16); f[2] = bf2f(w.y & 0xffffu); f[3] = bf2f(w.y >> 16);
    f[4] = bf2f(w.z & 0xffffu); f[5] = bf2f(w.z >> 16); f[6] = bf2f(w.w & 0xffffu); f[7] = bf2f(w.w >> 16);
}
__device__ __forceinline__ float dpp_f(float x, const int ctrl_is_const_only) { return x; }
#define DPP_ADD(x, ctrl) ((x) + __builtin_bit_cast(float, __builtin_amdgcn_update_dpp(0, __builtin_bit_cast(int, (x)), (ctrl), 0xf, 0xf, true)))
__device__ __forceinline__ float half_sum32(float x) { x = DPP_ADD(x, 0xB1); x = DPP_ADD(x, 0x4E); x = DPP_ADD(x, 0x141); x = DPP_ADD(x, 0x140); x += __shfl_xor(x, 16); return x; }
#define TIDX ((void)WAVE_U, (int)threadIdx.x)
#define LDS_WAIT() asm volatile("s_waitcnt lgkmcnt(0)" ::: "memory")
#ifndef REP_A
#define REP_A 1
#endif
#ifndef REP_B
#define REP_B 1
#endif
#define BAR_LDS() asm volatile("s_waitcnt lgkmcnt(0)\n\ts_barrier" ::: "memory")
__device__ __forceinline__ float ssq_total(const float* ssq, int row) {
    const f32x4 a = *(const f32x4*)(ssq + (size_t)row * 16), b = *(const f32x4*)(ssq + (size_t)row * 16 + 4), c = *(const f32x4*)(ssq + (size_t)row * 16 + 8), d = *(const f32x4*)(ssq + (size_t)row * 16 + 12);
    return (((a[0] + a[1]) + (a[2] + a[3])) + ((b[0] + b[1]) + (b[2] + b[3]))) + (((c[0] + c[1]) + (c[2] + c[3])) + ((d[0] + d[1]) + (d[2] + d[3])));
}

namespace pg8 {
constexpr int BM = 256, BK = 64, HALF = 128, HTB = HALF * BK * 2, STAGE_BYTES = 8 * HTB, NXCD = 8, WGM = 8;
__host__ __device__ __forceinline__ int lds_byte(int r, int c) { const int st = (r >> 4) * 2 + (c >> 5), rr = r & 15, cc = c & 31, ob = rr * 64 + cc * 2; return st * 1024 + (ob ^ (((ob >> 9) & 1) << 5)); }
__host__ __device__ __forceinline__ void stage_rc(int b, int& R, int& C) { const int st = b / 1024, sb = b % 1024, swz = sb ^ (((sb >> 9) & 1) << 5); R = (st >> 1) * 16 + swz / 64; C = (st & 1) * 32 + (swz % 64) / 2; }
__host__ __device__ __forceinline__ int perm32(int rho) { const int n = rho >> 4, i = rho & 15; return 8 * (i >> 2) + 4 * n + (i & 3); }
struct Unit { int pm, pn; };
struct Gemm { const bf16_t* A; const bf16_t* Bt; int K; };
struct StaticOrder {
    int nM, nN, nwg, G, c;
    __device__ void init(int nM_, int nN_, int G_, int c_) { nM = nM_; nN = nN_; nwg = nM * nN; G = G_; c = c_; }
    __device__ bool next(int i, Unit& u) const {
        const long L = (long)i * G + c; if (L >= nwg) return false;
        int wgid = (int)L; { const int q = nwg / NXCD, r = nwg % NXCD, xcd = wgid % NXCD, off = wgid / NXCD; wgid = (xcd < r ? xcd * (q + 1) : r * (q + 1) + (xcd - r) * q) + off; }
        const int nig = WGM * nN, gid = wgid / nig, fm = gid * WGM, gsz = (nM - fm) < WGM ? (nM - fm) : WGM;
        u.pm = fm + ((wgid % nig) % gsz); u.pn = (wgid % nig) / gsz; return true;
    }
};
struct RemapOrder { StaticOrder b; int from, to;
    __device__ bool next(int i, Unit& u) const { if (!b.next(i, u)) return false; if (u.pn == from) u.pn = to; return true; } };
struct BranchOrder {
    int G, c;
    __device__ bool next(int i, Unit& u) const {
        const int su = (i >> 2) * G + c, n = i & 3; if (su >= (NTM - 1) * 4) return false;
        u.pm = n * NTM + (su >> 2); u.pn = n * 4 + (su & 3); return true;
    }
};

template <class Epi, class Sched>
__device__ __forceinline__ void gemm_phase(LAS unsigned char* lds, const Gemm g, const Sched& S, const Epi& E, const int WAVE_U) {
    int tid_ = TIDX; asm volatile("" : "+v"(tid_)); const int tid = tid_, wid = __builtin_amdgcn_readfirstlane(tid >> 6), lane = tid & 63, wr = wid >> 2, wc = wid & 3, fr = lane & 15, fq = lane >> 4;
    const int K = g.K, nt = K / BK;
    unsigned voffA[2], voffB[2];
#pragma unroll
    for (int i = 0; i < 2; ++i) { int R, C; stage_rc(tid * 16 + i * 8192, R, C); const int Rb = (R & ~31) + perm32(R & 31);
        voffA[i] = (unsigned)(R * K + C) * 2u; voffB[i] = (unsigned)(Rb * K + C) * 2u; }
    const size_t kstep = (size_t)(BK * 2);
    const size_t hstep = (size_t)HALF * K * 2;
    const size_t tstep = 2 * hstep;
    const unsigned ldsw = (unsigned)wid * 1024u;
    const int aoff = lds_byte(wr * 64 + fr, fq * 8), boff = lds_byte(wc * 32 + fr, fq * 8);
#define PG8_SA(b, h) (((b) * 2 + (h)) * HTB)
#define PG8_SB(b, h) ((4 + (b) * 2 + (h)) * HTB)
#define PG8_STAGE(bufoff, gbase, voff) do { _Pragma("unroll") for (int _i = 0; _i < 2; ++_i) \
        __builtin_amdgcn_global_load_lds((const unsigned*)((const char*)(gbase) + (voff)[_i]), (LAS unsigned*)(lds + (bufoff) + ldsw + _i * 8192), 16, 0, 0); } while (0)
#define PG8_LDA(dst, b, h) do { _Pragma("unroll") for (int m = 0; m < 4; ++m) _Pragma("unroll") for (int k = 0; k < 2; ++k) dst[m][k] = *(const LAS bf16x8*)(lds + PG8_SA(b, h) + aoff + m * 2048 + k * 1024); } while (0)
#define PG8_LDB(dst, b, h) do { _Pragma("unroll") for (int n = 0; n < 2; ++n) _Pragma("unroll") for (int k = 0; k < 2; ++k) dst[n][k] = *(const LAS bf16x8*)(lds + PG8_SB(b, h) + boff + n * 2048 + k * 1024); } while (0)
#define PG8_MMA(ai, bj, At, Bt) do { __builtin_amdgcn_s_setprio(1); _Pragma("unroll") for (int m = 0; m < 4; ++m) _Pragma("unroll") for (int n = 0; n < 2; ++n) _Pragma("unroll") for (int k = 0; k < 2; ++k) \
        acc[ai][bj][m][n] = __builtin_amdgcn_mfma_f32_16x16x32_bf16(Bt[n][k], At[m][k], acc[ai][bj][m][n], 0, 0, 0); __builtin_amdgcn_s_setprio(0); } while (0)
#define PG8_WAIT_V(n) asm volatile("s_waitcnt vmcnt(" #n ")" ::: "memory")
#define PG8_WAIT_L(n) asm volatile("s_waitcnt lgkmcnt(" #n ")" ::: "memory")
#define PG8_BAR __builtin_amdgcn_s_barrier()
#define PG8_SCHED __builtin_amdgcn_sched_barrier(0)
    Unit cur, nxt; int ui = 0;
    if (!S.next(0, cur)) return;
    f32x4 acc[2][2][4][2];
#pragma unroll
    for (int a = 0; a < 2; ++a)
#pragma unroll
        for (int b = 0; b < 2; ++b)
#pragma unroll
            for (int m = 0; m < 4; ++m)
#pragma unroll
                for (int n = 0; n < 2; ++n) acc[a][b][m][n] = (f32x4){0.f, 0.f, 0.f, 0.f};
    bf16x8 At[4][2], B0[2][2], B1[2][2];
    const char* cA = (const char*)g.A + (size_t)cur.pm * tstep; const char* cB = (const char*)g.Bt + (size_t)cur.pn * tstep;
    PG8_STAGE(PG8_SB(0, 0), cB, voffB); PG8_STAGE(PG8_SB(0, 1), cB + hstep, voffB); PG8_STAGE(PG8_SA(0, 0), cA, voffA); PG8_STAGE(PG8_SA(0, 1), cA + hstep, voffA);
    if (wr == 1) PG8_BAR;
    PG8_WAIT_V(2); PG8_BAR;
    PG8_STAGE(PG8_SB(1, 0), cB + kstep, voffB); PG8_STAGE(PG8_SA(1, 0), cA + kstep, voffA); PG8_STAGE(PG8_SB(1, 1), cB + hstep + kstep, voffB);
    PG8_WAIT_V(6); PG8_BAR;
    for (;;) {
        const bool has_next = S.next(ui + 1, nxt);
        const char* nA = has_next ? (const char*)g.A + (size_t)nxt.pm * tstep : cA; const char* nB = has_next ? (const char*)g.Bt + (size_t)nxt.pn * tstep : cB;
        for (int t = 0; t < nt; t += 2) {
            const bool last = (t == nt - 2);
            const char* a1 = cA + (size_t)(t + 1) * kstep;
            const char* a2 = last ? nA : cA + (size_t)(t + 2) * kstep; const char* b2 = last ? nB : cB + (size_t)(t + 2) * kstep;
            const char* a3 = a2 + kstep; const char* b3 = b2 + kstep;
            PG8_LDB(B0, 0, 0); PG8_LDB(B1, 0, 1); PG8_SCHED; PG8_LDA(At, 0, 0); PG8_STAGE(PG8_SA(1, 1), a1 + hstep, voffA);
            PG8_WAIT_V(8); PG8_WAIT_L(0); PG8_BAR; PG8_MMA(0, 0, At, B0); PG8_MMA(0, 1, At, B1); PG8_BAR; PG8_SCHED;
            PG8_LDA(At, 0, 1); PG8_STAGE(PG8_SB(0, 0), b2, voffB); PG8_STAGE(PG8_SB(0, 1), b2 + hstep, voffB); PG8_STAGE(PG8_SA(0, 0), a2, voffA);
            PG8_WAIT_V(8); PG8_WAIT_L(0); PG8_BAR; PG8_MMA(1, 0, At, B0); PG8_MMA(1, 1, At, B1); PG8_BAR; PG8_SCHED;
            PG8_LDB(B0, 1, 0); PG8_LDB(B1, 1, 1); PG8_SCHED; PG8_LDA(At, 1, 0); PG8_STAGE(PG8_SA(0, 1), a2 + hstep, voffA);
            PG8_WAIT_V(8); PG8_WAIT_L(0); PG8_BAR; PG8_MMA(0, 0, At, B0); PG8_MMA(0, 1, At, B1); PG8_BAR; PG8_SCHED;
            PG8_LDA(At, 1, 1); PG8_STAGE(PG8_SB(1, 0), b3, voffB); PG8_STAGE(PG8_SB(1, 1), b3 + hstep, voffB); PG8_STAGE(PG8_SA(1, 0), a3, voffA);
            PG8_WAIT_V(8); PG8_WAIT_L(0); PG8_BAR; PG8_MMA(1, 0, At, B0); PG8_MMA(1, 1, At, B1); PG8_BAR; PG8_SCHED;
        }
        if (wr == 0) PG8_BAR;
        E(acc, cur, wr, wc, fr, fq);
        if (!has_next) break;
#pragma unroll
        for (int a = 0; a < 2; ++a)
#pragma unroll
            for (int b = 0; b < 2; ++b)
#pragma unroll
                for (int m = 0; m < 4; ++m)
#pragma unroll
                    for (int n = 0; n < 2; ++n) acc[a][b][m][n] = (f32x4){0.f, 0.f, 0.f, 0.f};
        cur = nxt; cA = nA; cB = nB; ++ui;
        if (wr == 1) PG8_BAR;
    }
    PG8_WAIT_V(0);
    PG8_BAR;
#undef PG8_SA
#undef PG8_SB
#undef PG8_STAGE
#undef PG8_LDA
#undef PG8_LDB
#undef PG8_MMA
#undef PG8_WAIT_V
#undef PG8_WAIT_L
#undef PG8_BAR
#undef PG8_SCHED
}

struct EpiInProj {
    bf16_t* P; const float* ssq; int pn_off;
    __device__ __forceinline__ void operator()(const f32x4 (&acc)[2][2][4][2], const Unit& u, int wr, int wc, int fr, int fq) const {
#pragma unroll
        for (int ai = 0; ai < 2; ++ai)
#pragma unroll
            for (int m = 0; m < 4; ++m) {
                const int row = u.pm * 256 + ai * 128 + wr * 64 + m * 16 + fr;
                const float rs = rsqrtf(ssq_total(ssq, row) * (1.f / 1024.f) + 1e-6f);
#pragma unroll
                for (int bj = 0; bj < 2; ++bj) {
                    const int col = (u.pn + pn_off) * 256 + bj * 128 + wc * 32 + 8 * fq;
                    const f32x4 v0 = acc[ai][bj][m][0] * rs, v1 = acc[ai][bj][m][1] * rs;
                    u32x4 w; w.x = pk2(v0[0], v0[1]); w.y = pk2(v0[2], v0[3]); w.z = pk2(v1[0], v1[1]); w.w = pk2(v1[2], v1[3]);
                    *(u32x4*)(P + (size_t)row * NP + col) = w;
                }
            }
    }
};
struct EpiBranch {
    const bf16_t* P; float* Z; bf16_t* ZB;
    __device__ __forceinline__ void operator()(const f32x4 (&acc)[2][2][4][2], const Unit& u, int wr, int wc, int fr, int fq) const {
        const int n = u.pn >> 2, pn = u.pn & 3, pm = u.pm - n * NTM;
#pragma unroll
        for (int ai = 0; ai < 2; ++ai)
#pragma unroll
            for (int m = 0; m < 4; ++m) {
                const int row = pm * 256 + ai * 128 + wr * 64 + m * 16 + fr;
#pragma unroll
                for (int bj = 0; bj < 2; ++bj) {
                    const int col = pn * 256 + bj * 128 + wc * 32 + 8 * fq;
                    const u32x4 gw = *(const u32x4*)(P + (size_t)row * NP + OFF_GATE + n * 1024 + col);
                    float gt[8]; unpack8(gw, gt);
                    float v[8];
#pragma unroll
                    for (int j = 0; j < 4; ++j) { v[j] = sigmoidf_(gt[j]) * acc[ai][bj][m][0][j]; v[4 + j] = sigmoidf_(gt[4 + j]) * acc[ai][bj][m][1][j]; }
                    bf16_t* zp = ZB + (size_t)row * DM + col; (void)Z;
                    if (n != 0) { float zo[8]; unpack8(*(const u32x4*)zp, zo);
#pragma unroll
                        for (int j = 0; j < 8; ++j) v[j] += zo[j]; }
                    { u32x4 w; w.x = pk2(v[0], v[1]); w.y = pk2(v[2], v[3]); w.z = pk2(v[4], v[5]); w.w = pk2(v[6], v[7]); *(u32x4*)zp = w; }
                }
            }
    }
};
struct EpiResid {
    float* S; bf16_t* HN; const float* nw; float* ssq;
    __device__ __forceinline__ void operator()(const f32x4 (&acc)[2][2][4][2], const Unit& u, int wr, int wc, int fr, int fq) const {
#pragma unroll
        for (int ai = 0; ai < 2; ++ai)
#pragma unroll
            for (int m = 0; m < 4; ++m) {
                const int row = u.pm * 256 + ai * 128 + wr * 64 + m * 16 + fr;
                float ss = 0.f;
#pragma unroll
                for (int bj = 0; bj < 2; ++bj) {
                    const int col = u.pn * 256 + bj * 128 + wc * 32 + 8 * fq;
                    float* sp = S + (size_t)row * DM + col;
                    f32x4 s0 = *(const f32x4*)sp, s1 = *(const f32x4*)(sp + 4);
                    s0 += acc[ai][bj][m][0]; s1 += acc[ai][bj][m][1];
                    *(f32x4*)sp = s0; *(f32x4*)(sp + 4) = s1;
                    const f32x4 w0 = *(const f32x4*)(nw + col), w1 = *(const f32x4*)(nw + col + 4);
                    u32x4 w; w.x = pk2(s0[0] * w0[0], s0[1] * w0[1]); w.y = pk2(s0[2] * w0[2], s0[3] * w0[3]); w.z = pk2(s1[0] * w1[0], s1[1] * w1[1]); w.w = pk2(s1[2] * w1[2], s1[3] * w1[3]);
                    *(u32x4*)(HN + (size_t)row * DM + col) = w;
                    ss += (s0[0] * s0[0] + s0[1] * s0[1]) + (s0[2] * s0[2] + s0[3] * s0[3]) + (s1[0] * s1[0] + s1[1] * s1[1]) + (s1[2] * s1[2] + s1[3] * s1[3]);
                }
                ss += __shfl_xor(ss, 16); ss += __shfl_xor(ss, 32);
                if (fq == 0) ssq[(size_t)row * 16 + u.pn * 4 + wc] = ss;
            }
    }
};
struct EpiSwiglu {
    bf16_t* H; const float* ssq;
    __device__ __forceinline__ void operator()(const f32x4 (&acc)[2][2][4][2], const Unit& u, int wr, int wc, int fr, int fq) const {
#pragma unroll
        for (int ai = 0; ai < 2; ++ai)
#pragma unroll
            for (int m = 0; m < 4; ++m) {
                const int row = u.pm * 256 + ai * 128 + wr * 64 + m * 16 + fr;
                const float rs = rsqrtf(ssq_total(ssq, row) * (1.f / 1024.f) + 1e-6f);
                float v[8];
#pragma unroll
                for (int n = 0; n < 2; ++n)
#pragma unroll
                    for (int j = 0; j < 4; ++j) { const float gg = acc[ai][0][m][n][j] * rs, uu = acc[ai][1][m][n][j] * rs; v[4 * n + j] = siluf_(gg) * uu; }
                u32x4 w; w.x = pk2(v[0], v[1]); w.y = pk2(v[2], v[3]); w.z = pk2(v[4], v[5]); w.w = pk2(v[6], v[7]);
                *(u32x4*)(H + (size_t)row * FF + u.pn * 128 + wc * 32 + 8 * fq) = w;
            }
    }
};
}

__device__ __forceinline__ bf16x8 ldfrag(const LAS bf16_t* p, int ld, int r, int q) { return *(const LAS bf16x8*)(p + r * ld + q * 8); }
__device__ __forceinline__ bf16x4 ldfrag4(const LAS bf16_t* p, int ld, int r, int q) { return *(const LAS bf16x4*)(p + r * ld + q * 4); }
__device__ __forceinline__ f32x4 mma32(bf16x8 a, bf16x8 b, f32x4 c) { return __builtin_amdgcn_mfma_f32_16x16x32_bf16(a, b, c, 0, 0, 0); }
__device__ __forceinline__ f32x4 mma16(bf16x4 a, bf16x4 b, f32x4 c) { return __builtin_amdgcn_mfma_f32_16x16x16bf16_1k(a, b, c, 0, 0, 0); }
__device__ __forceinline__ bf16x4 cvt4(f32x4 v) { u32x2 w; w.x = pk2(v[0], v[1]); w.y = pk2(v[2], v[3]); return __builtin_bit_cast(bf16x4, w); }
__device__ __forceinline__ bf16x8 scale8(bf16x8 x, const float* f) { const u32x4 w = __builtin_bit_cast(u32x4, x); float v[8]; unpack8(w, v); u32x4 o;
    o.x = pk2(v[0] * f[0], v[1] * f[1]); o.y = pk2(v[2] * f[2], v[3] * f[3]); o.z = pk2(v[4] * f[4], v[5] * f[5]); o.w = pk2(v[6] * f[6], v[7] * f[7]); return __builtin_bit_cast(bf16x8, o); }

struct KP { const float* in[30]; float* out; unsigned char* ws; };

__device__ __forceinline__ void tr_item(const float* W, int N, bf16_t* WT, int ldk, int k0, int n0, int dst_row0, LAS float* scr, int lane) {
#pragma unroll 8
    for (int i = 0; i < 32; ++i) { const int kk = 2 * i + (lane >> 5); const int n = n0 + (lane & 31); scr[kk * 33 + (lane & 31)] = (n < N) ? W[(size_t)(k0 + kk) * N + n] : 0.f; }
    LDS_WAIT(); asm volatile("" ::: "memory");
    const int c = lane & 7;
#pragma unroll
    for (int j = 0; j < 4; ++j) { const int n = (lane >> 3) + 8 * j; const LAS float* s = scr + (8 * c) * 33 + n;
        u32x4 o; o.x = pk2(s[0 * 33], s[1 * 33]); o.y = pk2(s[2 * 33], s[3 * 33]); o.z = pk2(s[4 * 33], s[5 * 33]); o.w = pk2(s[6 * 33], s[7 * 33]);
        if (n0 + n < N) *(u32x4*)(WT + (size_t)(dst_row0 + n) * ldk + k0 + 8 * c) = o; }
    LDS_WAIT(); asm volatile("" ::: "memory");
}
__device__ __forceinline__ void convert_layer(const KP& p, int l, LAS unsigned char* lds, int gw, int NGW, int wave, int lane) {
    asm volatile("" : "+v"(lane)); asm volatile("" : "+v"(wave)); wave = __builtin_amdgcn_readfirstlane(wave);
    LAS float* scr = (LAS float*)(lds + wave * 8448);
    bf16_t* win_t = (bf16_t*)(p.ws + WS_WIN); bf16_t* wing_t = (bf16_t*)(p.ws + WS_WING + (size_t)(l & 1) * WING_SIZE);
    unsigned char* sm = p.ws + WS_WSM + (size_t)(l & 1) * WSM_SIZE;
    bf16_t* br_t = (bf16_t*)(sm + WSM_BR); bf16_t* out_t = (bf16_t*)(sm + WSM_OUT); bf16_t* fi_t = (bf16_t*)(sm + WSM_FI); bf16_t* fo_t = (bf16_t*)(sm + WSM_FO);
    constexpr int NB_IN = (INW + 31) / 32;
    constexpr int I_IN = 16 * NB_IN, I_BR = 4 * 16 * 32, I_OUT = 16 * 32, I_FI = 16 * (2 * FF / 32), I_FO = (FF / 64) * 32;
    constexpr int NITEMS = I_IN + I_BR + I_OUT + I_FI + I_FO;
    for (int it = gw; it < NITEMS; it += NGW) {
        int r = it;
        if (r < I_IN) { const int kb = r / NB_IN, nb = r % NB_IN; const bool gt = nb >= GT0 * 8 && nb < (GT0 + GTN) * 8;
            tr_item(p.in[4] + (size_t)l * DM * INW, INW, gt ? wing_t : win_t, DM, kb * 64, nb * 32, gt ? nb * 32 - GT0 * 256 : nb * 32, scr, lane); continue; } r -= I_IN;
        if (r < I_BR) { const int n = r / 512, rr = r % 512, kb = rr / 32, nb = rr % 32; tr_item(p.in[25] + (size_t)(l * 4 + n) * DM * DM, DM, br_t, DM, kb * 64, nb * 32, n * 1024 + nb * 32, scr, lane); continue; } r -= I_BR;
        if (r < I_OUT) { const int kb = r / 32, nb = r % 32; tr_item(p.in[26] + (size_t)l * DM * DM, DM, out_t, DM, kb * 64, nb * 32, nb * 32, scr, lane); continue; } r -= I_OUT;
        if (r < I_FI) { const int nbn = 2 * FF / 32, kb = r / nbn, nb = r % nbn; const int c0 = nb * 32, bj = c0 / FF, j = c0 % FF, pn = j / 128, rr = j % 128;
            tr_item(p.in[27] + (size_t)l * DM * 2 * FF, 2 * FF, fi_t, DM, kb * 64, c0, 256 * pn + 128 * bj + rr, scr, lane); continue; } r -= I_FI;
        { const int kb = r / 32, nb = r % 32; tr_item(p.in[28] + (size_t)l * FF * DM, DM, fo_t, FF, kb * 64, nb * 32, nb * 32, scr, lane); }
    }
    if (l >= 1) {
        const float* Wv = p.in[4] + (size_t)l * DM * INW + 2048; const float* mu = p.in[5] + (size_t)l * 3328 + 2048; const float* v1 = p.in[12] + (size_t)(l - 1) * DM * 32;
        for (int k = gw; k < DM; k += NGW) {
            float wv[16], m1[16];
#pragma unroll
            for (int m = 0; m < 16; ++m) { const int c = lane + 64 * m; wv[m] = Wv[(size_t)k * INW + c]; m1[m] = mu[c]; }
            for (int j = 0; j < 32; ++j) {
                float e1 = 0.f, e2 = 0.f;
#pragma unroll
                for (int m = 0; m < 16; ++m) { const int c = lane + 64 * m; const float vv = v1[c * 32 + j] * wv[m]; e1 += vv * (1.f - m1[m]); e2 += vv * m1[m]; }
#pragma unroll
                for (int o = 1; o < 64; o <<= 1) { e1 += __shfl_xor(e1, o); e2 += __shfl_xor(e2, o); }
                if (lane == 0) { win_t[(size_t)(OFF_VLO + j) * DM + k] = (bf16_t)f2bf(e1); win_t[(size_t)(OFF_VLO + 32 + j) * DM + k] = (bf16_t)f2bf(e2); }
            }
        }
    }
}


constexpr int XLW = 320;
__device__ __forceinline__ void rwkv_lora_inputs(const KP& p, int l, int gw, int NGW, int lane) {
    const bf16_t* P = (const bf16_t*)(p.ws + WS_P); bf16_t* XLO = (bf16_t*)(p.ws + WS_Z);
    const float* mu = p.in[5] + (size_t)l * 3328 + 3072;
    float muv[4];
#pragma unroll
    for (int j = 0; j < 4; ++j) muv[j] = mu[lane + 64 * j];
    for (int m = gw; m < MMAIN + NMETA; m += NGW) {
        int prev; if (m < MMAIN) prev = ((m & (SEQ - 1)) == 0) ? MMAIN + NMETA - 1 : m - 1; else prev = (m == MMAIN) ? -1 : m - 1;
        const bf16_t* cr = P + (size_t)m * NP; const bf16_t* pr = P + (size_t)(prev < 0 ? m : prev) * NP; const float pz = prev < 0 ? 0.f : 1.f;
        float cur[4], prv[4];
#pragma unroll
        for (int j = 0; j < 4; ++j) { cur[j] = bf2f(cr[3072 + lane + 64 * j]); prv[j] = pz * bf2f(pr[3072 + lane + 64 * j]); }
        float vl = 0.f; if (lane < 32) vl = bf2f(cr[OFF_VLO + lane]) + pz * bf2f(pr[OFF_VLO + 32 + lane]);
        bf16_t* o = XLO + (size_t)m * XLW;
#pragma unroll
        for (int j = 0; j < 4; ++j) { const float val = cur[j] + (prv[j] - cur[j]) * muv[j]; float r_;
            if (j == 0) { const float e2 = __expf(2.f * val); r_ = 1.f - 2.f * __builtin_amdgcn_rcpf(e2 + 1.f); } else if (j == 1) r_ = val; else r_ = __builtin_amdgcn_rcpf(1.f + __expf(-val));
            o[lane + 64 * j] = (bf16_t)f2bf(r_); }
        if (lane < 32) o[256 + lane] = (bf16_t)f2bf(vl);
    }
}

__device__ __forceinline__ void rwkv_unit(const KP& p, int l, int b, int h, LAS unsigned char* lds, const int WAVE_U) {
    int tid = TIDX; asm volatile("" : "+v"(tid)); const int wave = __builtin_amdgcn_readfirstlane(tid >> 6); int lane = tid & 63, r = lane & 15, q = lane >> 4;
#define RELAUNDER() do { asm volatile("" : "+v"(tid)); lane = tid & 63; r = lane & 15; q = lane >> 4; l32 = lane & 31; thalf = lane >> 5; } while (0)
    const bf16_t* P = (const bf16_t*)(p.ws + WS_P);
    bf16_t* YS = (bf16_t*)(p.ws + WS_YS);
    bf16_t* VFG = (bf16_t*)(p.ws + WS_VF); const bf16_t* XLO = (const bf16_t*)(p.ws + WS_Z);
    const float* mu = p.in[5] + (size_t)l * 3328;
    const float* vec = p.in[9] + (size_t)l * 6 * DM;
    const float* rk = p.in[10] + (size_t)l * DM;
    const float* v0 = (l >= 1) ? p.in[11] + (size_t)(l - 1) * DM : nullptr;
    LAS bf16_t* W2T = (LAS bf16_t*)(lds + 0); LAS bf16_t* A2T = (LAS bf16_t*)(lds + 9216); LAS bf16_t* G2T = (LAS bf16_t*)(lds + 18432); LAS bf16_t* V2T = (LAS bf16_t*)(lds + 35840);
    LAS float* MU = (LAS float*)(lds + 40960); LAS float* W0L = (LAS float*)(lds + 42752); LAS float* A0L = W0L + 64; LAS float* V0L = A0L + 64;
    LAS float* BON = (LAS float*)(lds + 43520); LAS float* PC = (LAS float*)(lds + 43648);
    LAS float* RM = (LAS float*)(lds + 44160); LAS float* KM = RM + 2048; LAS float* VM = KM + 2048; LAS float* WD = VM + 2048; LAS float* AG = WD + 2048; LAS float* VG = AG + 2048; LAS float* GL = VG + 2048;
    LAS float* YY = RM; LAS float* KPp = KM; LAS float* VPp = VM; LAS float* APp = AG; LAS float* BPp = VG;
    constexpr int REG = 101504; constexpr int TS = 20;
    LAS bf16_t* RAW = (LAS bf16_t*)(lds + REG);
    LAS bf16_t* XW = (LAS bf16_t*)(lds + 140048); LAS bf16_t* XA = (LAS bf16_t*)(lds + 144656); LAS bf16_t* XG = (LAS bf16_t*)(lds + 149264); LAS bf16_t* XV = (LAS bf16_t*)(lds + 157968);
    constexpr int O_AT = 0, O_RT = 2304, O_BT = 4608, O_KT = 6912, O_BH = 9216, O_KH = 12288, O_VT = 15360, O_MAB = 18432, O_TT = 19712, OPB = 20480;
    { const float* w2g = p.in[6] + (size_t)l * 64 * DM + 64 * h; const float* a2g = p.in[7] + (size_t)l * 64 * DM + 64 * h; const float* g2g = p.in[8] + (size_t)l * 128 * DM + 64 * h;
      for (int idx = tid; idx < 64 * 64; idx += 512) { const int k = idx >> 6, n = idx & 63; W2T[n * 72 + k] = (bf16_t)f2bf(w2g[k * DM + n]); A2T[n * 72 + k] = (bf16_t)f2bf(a2g[k * DM + n]); }
      for (int idx = tid; idx < 128 * 64; idx += 512) { const int k = idx >> 6, n = idx & 63; G2T[n * 136 + k] = (bf16_t)f2bf(g2g[k * DM + n]); }
      if (l >= 1) { const float* v2g = p.in[13] + (size_t)(l - 1) * 32 * DM + 64 * h; for (int idx = tid; idx < 32 * 64; idx += 512) { const int k = idx >> 6, n = idx & 63; V2T[n * 40 + k] = (bf16_t)f2bf(v2g[k * DM + n]); } } }
    if (tid < 192) MU[tid] = mu[(tid >> 6) * 1024 + 64 * h + (tid & 63)];
    if (tid < 64) { W0L[tid] = vec[64 * h + tid]; A0L[tid] = vec[DM + 64 * h + tid]; V0L[tid] = l >= 1 ? v0[64 * h + tid] : 0.f; }
    f32x4 sT[4];
#pragma unroll
    for (int i = 0; i < 4; ++i) sT[i] = (f32x4){0.f, 0.f, 0.f, 0.f};
    int l32 = lane & 31, thalf = lane >> 5; const int hc0 = 64 * h + l32, hc1 = hc0 + 32;
    const float kk_c0 = vec[2 * DM + hc0], ka_c0 = vec[3 * DM + hc0], lnw_c0 = vec[4 * DM + hc0], lnb_c0 = vec[5 * DM + hc0], rk_c0 = rk[hc0];
    const float kk_c1 = vec[2 * DM + hc1], ka_c1 = vec[3 * DM + hc1], lnw_c1 = vec[4 * DM + hc1], lnb_c1 = vec[5 * DM + hc1], rk_c1 = rk[hc1];
    auto trow = [&](int t) -> size_t { return (size_t)row_of(b, t < 0 ? 0 : (t >= TT ? TT - 1 : t)); };
    constexpr int RS = 264;
    const int ra0 = tid, ra1 = tid + 512; const int rr0 = ra0 / 24, pc0 = ra0 % 24, rr1 = ra1 / 24, pc1 = ra1 % 24;
    const int gc0 = (pc0 >> 3) * 1024 + 64 * h + 8 * (pc0 & 7), gc1 = (pc1 >> 3) * 1024 + 64 * h + 8 * (pc1 & 7);
    int xtok[3], xpc[3], xdst[3];
#pragma unroll
    for (int j = 0; j < 3; ++j) { const int xa = tid + 512 * j; xtok[j] = xa / 36; xpc[j] = xa % 36; const int pc = xpc[j], tk = xtok[j];
        xdst[j] = pc < 8 ? 140048 + (tk * 72 + 8 * pc) * 2 : (pc < 16 ? 144656 + (tk * 72 + 8 * (pc - 8)) * 2 : (pc < 32 ? 149264 + (tk * 136 + 8 * (pc - 16)) * 2 : 157968 + (tk * 40 + 8 * (pc - 32)) * 2)); }
    u32x4 pfa0, pfa1, pfv, pfx0, pfx1, pfx2;
#define RWKV_PREFETCH(pn) do { const int t0_ = 32 * (pn) - 1; \
        pfa0 = *(const u32x4*)(P + trow(t0_ + rr0) * NP + gc0); if (t0_ + rr0 < 0) pfa0 = (u32x4){0u, 0u, 0u, 0u}; \
        if (ra1 < 792) pfa1 = *(const u32x4*)(P + trow(t0_ + rr1) * NP + gc1); \
        if (tid < 256) pfv = *(const u32x4*)(VFG + trow(t0_ + 1 + (tid >> 3)) * DM + 64 * h + 8 * (tid & 7)); \
        pfx0 = *(const u32x4*)(XLO + trow(t0_ + 1 + xtok[0]) * XLW + 8 * xpc[0]); pfx1 = *(const u32x4*)(XLO + trow(t0_ + 1 + xtok[1]) * XLW + 8 * xpc[1]); \
        if (tid < 128) pfx2 = *(const u32x4*)(XLO + trow(t0_ + 1 + xtok[2]) * XLW + 8 * xpc[2]); } while (0)
    pfa1 = (u32x4){0u, 0u, 0u, 0u}; pfv = pfa1; pfx2 = pfa1;
    RWKV_PREFETCH(0);
    __syncthreads();
    for (int pp = 0; pp < 129; ++pp) {
        *(LAS u32x4*)(RAW + rr0 * RS + 8 * pc0) = pfa0;
        if (ra1 < 792) *(LAS u32x4*)(RAW + rr1 * RS + 8 * pc1) = pfa1;
        if (tid < 256) *(LAS u32x4*)(RAW + (1 + (tid >> 3)) * RS + 192 + 8 * (tid & 7)) = pfv;
        *(LAS u32x4*)(lds + xdst[0]) = pfx0; *(LAS u32x4*)(lds + xdst[1]) = pfx1; if (tid < 128) *(LAS u32x4*)(lds + xdst[2]) = pfx2;
        if (pp + 1 < 129) RWKV_PREFETCH(pp + 1);
        BAR_LDS();
        RELAUNDER();
        typedef float f32x2 __attribute__((ext_vector_type(2)));
        { unsigned cwv[6], pwv[6]; f32x2 m2v[3];
#pragma unroll
          for (int pj = 0; pj < 6; ++pj) { const int grp = pj % 3, i = 4 * wave + 2 * (pj / 3) + thalf, col = 64 * grp + 2 * l32;
              cwv[pj] = *(const LAS unsigned*)(RAW + (i + 1) * RS + col); pwv[pj] = *(const LAS unsigned*)(RAW + i * RS + col); if (pj < 3) m2v[pj] = *(const LAS f32x2*)(MU + col); }
#pragma unroll
          for (int pj = 0; pj < 6; ++pj) { const int grp = pj % 3, i = 4 * wave + 2 * (pj / 3) + thalf;
              const unsigned cw = cwv[pj], pw = pwv[pj]; const f32x2 m2 = m2v[grp];
              const float c0 = __builtin_bit_cast(float, cw << 16), c1 = __builtin_bit_cast(float, cw & 0xffff0000u), p0 = __builtin_bit_cast(float, pw << 16), p1 = __builtin_bit_cast(float, pw & 0xffff0000u);
              LAS float* dst = grp == 0 ? RM : (grp == 1 ? KM : VM); *(LAS f32x2*)(dst + i * 64 + 2 * l32) = (f32x2){c0 + (p0 - c0) * m2.x, c1 + (p1 - c1) * m2.y}; } }
        RELAUNDER();
        { auto s2_tile = [&](int which, int mt, int nt) { f32x4 acc = (f32x4){0.f, 0.f, 0.f, 0.f};
            if (which == 0) { acc = mma32(ldfrag(XW + 16 * mt * 72, 72, r, q), ldfrag(W2T + nt * 16 * 72, 72, r, q), acc); acc = mma32(ldfrag(XW + 16 * mt * 72 + 32, 72, r, q), ldfrag(W2T + nt * 16 * 72 + 32, 72, r, q), acc); }
            else if (which == 1) { acc = mma32(ldfrag(XA + 16 * mt * 72, 72, r, q), ldfrag(A2T + nt * 16 * 72, 72, r, q), acc); acc = mma32(ldfrag(XA + 16 * mt * 72 + 32, 72, r, q), ldfrag(A2T + nt * 16 * 72 + 32, 72, r, q), acc); }
            else if (which == 2) {
#pragma unroll
                for (int ks = 0; ks < 4; ++ks) acc = mma32(ldfrag(XG + 16 * mt * 136 + 32 * ks, 136, r, q), ldfrag(G2T + nt * 16 * 136 + 32 * ks, 136, r, q), acc); }
            else { acc = mma32(ldfrag(XV + 16 * mt * 40, 40, r, q), ldfrag(V2T + nt * 16 * 40, 40, r, q), acc); }
            const int cc = 16 * nt + r;
#pragma unroll
            for (int j = 0; j < 4; ++j) { const int tok = 16 * mt + 4 * q + j; const float x = acc[j];
                if (which == 0) { const float ex = __expf(-(W0L[cc] + x)); WD[tok * 64 + cc] = __expf(-0.6065306597f * __builtin_amdgcn_rcpf(1.f + ex)); }
                else if (which == 1) AG[tok * 64 + cc] = __builtin_amdgcn_rcpf(1.f + __expf(-(A0L[cc] + x)));
                else if (which == 2) GL[tok * 64 + cc] = x;
                else VG[tok * 64 + cc] = __builtin_amdgcn_rcpf(1.f + __expf(-(V0L[cc] + x))); } };
          if (wave < 4) { const int which = wave >> 1;
#pragma unroll
              for (int mt = 0; mt < 2; ++mt)
#pragma unroll
                  for (int tnt = 0; tnt < 2; ++tnt) s2_tile(which, mt, 2 * (wave & 1) + tnt); }
          else { const int mtg = (wave - 4) >> 1;
#pragma unroll
              for (int tnt = 0; tnt < 2; ++tnt) s2_tile(2, mtg, 2 * (wave & 1) + tnt);
              if (l >= 1) {
#pragma unroll
                  for (int tnt = 0; tnt < 2; ++tnt) s2_tile(3, mtg, 2 * (wave & 1) + tnt); } } }
        BAR_LDS();
        RELAUNDER();
#pragma unroll
        for (int rep = 0; rep < 2; ++rep) { const int tok = 4 * wave + 2 * rep + thalf, e0 = tok * 64 + l32, e1 = e0 + 32;
          const float k0 = KM[e0], k1 = KM[e1], a0 = AG[e0], a1 = AG[e1], vv0 = VM[e0], vv1 = VM[e1], r0 = RM[e0], r1 = RM[e1];
          float kka = k0 * kk_c0, kkb = k1 * kk_c1; float n2 = kka * kka + kkb * kkb;
          const float kp0 = k0 * (1.f + (a0 - 1.f) * ka_c0), kp1 = k1 * (1.f + (a1 - 1.f) * ka_c1);
          float bo = r0 * kp0 * rk_c0 + r1 * kp1 * rk_c1;
          n2 = half_sum32(n2); bo = half_sum32(bo);
          const float inv = rsqrtf(fmaxf(n2, 1e-24f)); kka *= inv; kkb *= inv;
          float vp0 = vv0, vp1 = vv1;
          if (l >= 1) { vp0 = vv0 + (bf2f(RAW[(tok + 1) * RS + 192 + l32]) - vv0) * VG[e0]; vp1 = vv1 + (bf2f(RAW[(tok + 1) * RS + 224 + l32]) - vv1) * VG[e1]; }
          KPp[e0] = kp0; KPp[e1] = kp1; VPp[e0] = vp0; VPp[e1] = vp1; APp[e0] = -kka; APp[e1] = -kkb; BPp[e0] = kka * a0; BPp[e1] = kkb * a1; if (l32 == 0) BON[tok] = bo;
          const int t = 32 * pp + tok;
          if (l == 0 && t < TT) { bf16_t* vf = VFG + (size_t)row_of(b, t) * DM; vf[hc0] = (bf16_t)f2bf(vv0); vf[hc1] = (bf16_t)f2bf(vv1); } }
        BAR_LDS();
        RELAUNDER();
        { const int ch = wave >> 2, i0 = 4 * (wave & 3); LAS unsigned char* ob = lds + REG + ch * OPB;
          LAS bf16_t* AT_ = (LAS bf16_t*)(ob + O_AT); LAS bf16_t* RT_ = (LAS bf16_t*)(ob + O_RT); LAS bf16_t* BTl = (LAS bf16_t*)(ob + O_BT); LAS bf16_t* KTl = (LAS bf16_t*)(ob + O_KT);
          LAS bf16_t* BHt = (LAS bf16_t*)(ob + O_BH); LAS bf16_t* KHt = (LAS bf16_t*)(ob + O_KH); LAS bf16_t* VTt = (LAS bf16_t*)(ob + O_VT);
          float Pv[5]; float run = 1.f;
          const LAS float* wdp = WD + 16 * ch * 64 + lane;
          for (int j = 0; j < i0; ++j) run *= wdp[j * 64];
          Pv[0] = run;
#pragma unroll
          for (int tt = 0; tt < 4; ++tt) { run *= wdp[(i0 + tt) * 64]; Pv[1 + tt] = run; }
          for (int j = i0 + 4; j < 16; ++j) run *= wdp[j * 64];
          const float Pall = run;
          float av[4], bv[4], kv[4], rv[4], vv[4];
#pragma unroll
          for (int tt = 0; tt < 4; ++tt) { const int e = (16 * ch + i0 + tt) * 64 + lane; av[tt] = APp[e]; bv[tt] = BPp[e]; kv[tt] = KPp[e]; rv[tt] = RM[e]; vv[tt] = VPp[e]; }
#pragma unroll
          for (int tt = 0; tt < 4; ++tt) { const int i = i0 + tt; const float Pi = Pv[1 + tt], Pp = Pv[tt]; const float ip = __builtin_amdgcn_rcpf(Pi), hp = Pall * ip;
              AT_[i * 72 + lane] = (bf16_t)f2bf(av[tt] * Pp); RT_[i * 72 + lane] = (bf16_t)f2bf(rv[tt] * Pi); BTl[i * 72 + lane] = (bf16_t)f2bf(bv[tt] * ip); KTl[i * 72 + lane] = (bf16_t)f2bf(kv[tt] * ip);
              BHt[lane * TS + i] = (bf16_t)f2bf(bv[tt] * hp); KHt[lane * TS + i] = (bf16_t)f2bf(kv[tt] * hp); VTt[lane * TS + i] = (bf16_t)f2bf(vv[tt]); }
          if ((wave & 3) == 0) PC[ch * 64 + lane] = Pall; }
        BAR_LDS();
        RELAUNDER();
        bf16x4 nrb4, rhs4, v4; f32x4 Y;
#define RWKV_PRE(ch) do { LAS unsigned char* ob = lds + REG + (ch) * OPB; \
            const LAS bf16_t* AT_ = (const LAS bf16_t*)(ob + O_AT); const LAS bf16_t* RT_ = (const LAS bf16_t*)(ob + O_RT); const LAS bf16_t* BTl = (const LAS bf16_t*)(ob + O_BT); const LAS bf16_t* KTl = (const LAS bf16_t*)(ob + O_KT); \
            const LAS bf16_t* VTt = (const LAS bf16_t*)(ob + O_VT); \
            f32x4 mk = (f32x4){0.f, 0.f, 0.f, 0.f}, nb = mk, nk = mk; \
            _Pragma("unroll") for (int ks = 0; ks < 2; ++ks) { const bf16x8 fa = ldfrag(AT_ + 32 * ks, 72, r, q), fr_ = ldfrag(RT_ + 32 * ks, 72, r, q), fb = ldfrag(BTl + 32 * ks, 72, r, q), fk = ldfrag(KTl + 32 * ks, 72, r, q); \
                mk = mma32(fk, fa, mk); nb = mma32(fb, fr_, nb); nk = mma32(fk, fr_, nk); } \
            _Pragma("unroll") for (int j = 0; j < 4; ++j) { const int s_ = 4 * q + j; if (!(s_ < r)) mk[j] = 0.f; if (!(s_ <= r)) { nb[j] = 0.f; nk[j] = 0.f; } } \
            const bf16x4 mak4 = cvt4(mk), nrk4 = cvt4(nk); nrb4 = cvt4(nb); \
            v4 = ldfrag4(VTt + 16 * wave * TS, TS, r, q); \
            bf16x4 sb[4]; \
            _Pragma("unroll") for (int kt = 0; kt < 4; ++kt) sb[kt] = cvt4(sT[kt]); \
            f32x4 RHS = (f32x4){0.f, 0.f, 0.f, 0.f}; Y = RHS; \
            RHS = mma16(mak4, v4, RHS); Y = mma16(nrk4, v4, Y); \
            _Pragma("unroll") for (int kt = 0; kt < 4; ++kt) { RHS = mma16(ldfrag4(AT_ + 16 * kt, 72, r, q), sb[kt], RHS); Y = mma16(ldfrag4(RT_ + 16 * kt, 72, r, q), sb[kt], Y); } \
            rhs4 = cvt4(RHS); } while (0)
#define RWKV_FIN(ch) do { LAS unsigned char* ob = lds + REG + (ch) * OPB; \
            const LAS bf16_t* BHt = (const LAS bf16_t*)(ob + O_BH); const LAS bf16_t* KHt = (const LAS bf16_t*)(ob + O_KH); const LAS bf16_t* TTm = (const LAS bf16_t*)(ob + O_TT); \
            f32x4 U = (f32x4){0.f, 0.f, 0.f, 0.f}; U = mma16(ldfrag4(TTm, 24, r, q), rhs4, U); \
            const bf16x4 ub = cvt4(U); \
            Y = mma16(nrb4, ub, Y); \
            _Pragma("unroll") for (int j = 0; j < 4; ++j) YY[(16 * (ch) + 4 * q + j) * 64 + 16 * wave + r] = Y[j]; \
            _Pragma("unroll") for (int kt = 0; kt < 4; ++kt) { const f32x4 pc4 = *(const LAS f32x4*)(PC + (ch) * 64 + 16 * kt + 4 * q); f32x4 s_ = sT[kt] * pc4; \
                s_ = mma16(ldfrag4(BHt + 16 * kt * TS, TS, r, q), ub, s_); s_ = mma16(ldfrag4(KHt + 16 * kt * TS, TS, r, q), v4, s_); sT[kt] = s_; } } while (0)
        if (wave == 4 || wave == 5) { LAS unsigned char* ob = lds + REG + (wave - 4) * OPB;
            const LAS bf16_t* AT_ = (const LAS bf16_t*)(ob + O_AT); const LAS bf16_t* BTl = (const LAS bf16_t*)(ob + O_BT); LAS bf16_t* TTm = (LAS bf16_t*)(ob + O_TT);
            const f32x4 z4 = (f32x4){0.f, 0.f, 0.f, 0.f}; f32x4 n = z4, nt = z4, eye;
#pragma unroll
            for (int ks = 0; ks < 2; ++ks) { const bf16x8 fa = ldfrag(AT_ + 32 * ks, 72, r, q), fb = ldfrag(BTl + 32 * ks, 72, r, q); n = mma32(fa, fb, n); nt = mma32(fb, fa, nt); }
#pragma unroll
            for (int j = 0; j < 4; ++j) { const int i_ = 4 * q + j; if (!(r < i_)) n[j] = 0.f; if (!(i_ < r)) nt[j] = 0.f; eye[j] = (i_ == r) ? 1.f : 0.f; }
            const bf16x4 nB = cvt4(n), nA = cvt4(nt);
            const f32x4 n2 = mma16(nA, nB, z4), n2t = mma16(nB, nA, z4); const bf16x4 n2B = cvt4(n2), n2A = cvt4(n2t);
            const f32x4 n4 = mma16(n2A, n2B, z4), n4t = mma16(n2B, n2A, z4); const bf16x4 n4B = cvt4(n4), n4A = cvt4(n4t);
            const f32x4 n3 = mma16(nA, n2B, z4), n3t = mma16(n2B, nA, z4);
            const f32x4 n8 = mma16(n4A, n4B, z4); const f32x4 n12 = mma16(n4A, cvt4(n8), z4);
            const f32x4 p1 = ((eye + n) + (n2 + n3)), p1t = ((eye + nt) + (n2t + n3t)), rr = (n4 + n8) + n12;
            const f32x4 tt = mma16(cvt4(p1t), cvt4(rr), p1);
#pragma unroll
            for (int j = 0; j < 4; ++j) TTm[(4 * q + j) * 24 + r] = (bf16_t)f2bf(tt[j]); }
        else if (wave < 4) RWKV_PRE(0);
        BAR_LDS();
        RELAUNDER();
        if (wave < 4) { RWKV_FIN(0); RWKV_PRE(1); RWKV_FIN(1); }
        BAR_LDS();
#undef RWKV_PRE
#undef RWKV_FIN
        RELAUNDER();
#pragma unroll
        for (int rep = 0; rep < 2; ++rep) { const int tok = 4 * wave + 2 * rep + thalf, e0 = tok * 64 + l32, e1 = e0 + 32; const float y0 = YY[e0], y1 = YY[e1];
          float s1 = y0 + y1, s2 = y0 * y0 + y1 * y1;
          s1 = half_sum32(s1); s2 = half_sum32(s2);
          const float mean = s1 * (1.f / 64.f), var = fmaxf(s2 * (1.f / 64.f) - mean * mean, 0.f), rs = rsqrtf(var + 64e-5f), bon = BON[tok];
          const float o0 = ((y0 - mean) * rs * lnw_c0 + lnb_c0 + bon * VPp[e0]) * GL[e0], o1 = ((y1 - mean) * rs * lnw_c1 + lnb_c1 + bon * VPp[e1]) * GL[e1];
          const int t = 32 * pp + tok;
          if (t < TT) { bf16_t* yo = YS + (size_t)row_of(b, t) * DM; yo[hc0] = (bf16_t)f2bf(o0); yo[hc1] = (bf16_t)f2bf(o1); } }
    }
#undef RWKV_PREFETCH
#undef RELAUNDER
    __syncthreads();
}

__device__ __forceinline__ int swz72(int row, int chunk) { return row * 72 + (((chunk ^ (row >> 3)) & 7) << 3); }
__device__ __forceinline__ void ssd_unit(const KP& p, int l, int b, int g, LAS unsigned char* lds, const int WAVE_U) {
    int tid = TIDX; asm volatile("" : "+v"(tid)); const int wave = __builtin_amdgcn_readfirstlane(tid >> 6); int lane = tid & 63, r = lane & 15, q = lane >> 4;
#define RELAUNDER() do { asm volatile("" : "+v"(tid)); lane = tid & 63; r = lane & 15; q = lane >> 4; } while (0)
    const bf16_t* P = (const bf16_t*)(p.ws + WS_P);
    bf16_t* YS1 = (bf16_t*)(p.ws + WS_YS) + (size_t)1 * MP * DM;
    const float* conv_w = p.in[14] + (size_t)l * 4 * 2048; const float* conv_b = p.in[15] + (size_t)l * 2048;
    const float* dt_bias = p.in[16] + l * 16; const float* a_log = p.in[17] + l * 16; const float* dsk = p.in[18] + l * 16; const float* normw = p.in[19] + (size_t)l * DM;
    LAS bf16_t* Cm = (LAS bf16_t*)(lds + 0); LAS bf16_t* Bm = (LAS bf16_t*)(lds + 17408); LAS bf16_t* BT = (LAS bf16_t*)(lds + 34816); LAS bf16_t* CB = (LAS bf16_t*)(lds + 53248);
    LAS bf16_t* XT = (LAS bf16_t*)(lds + 62464); LAS float* ACU = (LAS float*)(lds + 99328); LAS float* DTV = (LAS float*)(lds + 100352); LAS float* RED = (LAS float*)(lds + 101376); LAS bf16_t* YL = (LAS bf16_t*)(lds + 103424); (void)RED;
    const int e = wave >> 1, ptb = 2 * (wave & 1);
    f32x4 st[8][2];
#pragma unroll
    for (int i = 0; i < 8; ++i) { st[i][0] = (f32x4){0.f, 0.f, 0.f, 0.f}; st[i][1] = (f32x4){0.f, 0.f, 0.f, 0.f}; }
    const float De = dsk[4 * g + e];
    unsigned short dtraw = 0;
#define SSD_DT_PREFETCH(cn) do { if (tid < 256) { const int t = 64 * (cn) - 48 + (tid & 63); dtraw = P[(size_t)row_of(b, t >= 0 ? t : 0) * NP + OFF_SSM + 3072 + 4 * g + (tid >> 6)]; } } while (0)
    SSD_DT_PREFETCH(0);
    for (int c = 0; c < 65; ++c) {
        RELAUNDER();
        if (tid < 256) { const int ee = wave, t = 64 * c - 48 + lane; float dtv = 0.f;
            if (t >= 0) dtv = softplusf_(bf2f(dtraw) + dt_bias[4 * g + ee]);
            float a = -dtv * __expf(a_log[4 * g + ee]);
#pragma unroll
            for (int off = 1; off < 64; off <<= 1) { const float v = __shfl_up(a, off); if (lane >= off) a += v; }
            ACU[ee * 64 + lane] = a; DTV[ee * 64 + lane] = dtv; }
        { const int cgp = tid & 63, tg = tid >> 6;
          const int xbc_idx = cgp < 32 ? 256 * g + 8 * cgp : (cgp < 48 ? 1024 + 128 * g + 8 * (cgp - 32) : 1536 + 128 * g + 8 * (cgp - 48));
          const int pcol = OFF_SSM + 1024 + xbc_idx;
          typedef float f32x2 __attribute__((ext_vector_type(2)));
          f32x2 cw0[4], cw1[4], cw2[4], cw3[4], cb[4]; u32x4 raw[11]; unsigned pk[8][4];
          const int i0 = 8 * tg, t0 = 64 * c - 48 + i0;
#pragma unroll
          for (int j = 0; j < 11; ++j) { const int t = t0 - 3 + j; raw[j] = *(const u32x4*)(P + (size_t)row_of(b, t >= 0 ? t : 0) * NP + pcol); if (t < 0) raw[j] = (u32x4){0u, 0u, 0u, 0u}; }
#pragma unroll
          for (int m = 0; m < 4; ++m) { cw0[m] = *(const f32x2*)(conv_w + xbc_idx + 2 * m); cw1[m] = *(const f32x2*)(conv_w + 2048 + xbc_idx + 2 * m); cw2[m] = *(const f32x2*)(conv_w + 4096 + xbc_idx + 2 * m);
              cw3[m] = *(const f32x2*)(conv_w + 6144 + xbc_idx + 2 * m); cb[m] = *(const f32x2*)(conv_b + xbc_idx + 2 * m); }
#define UNPK2(RW, VV) do { const u32x4 rw_ = (RW); VV[0] = (f32x2){__builtin_bit_cast(float, rw_[0] << 16), __builtin_bit_cast(float, rw_[0] & 0xffff0000u)}; VV[1] = (f32x2){__builtin_bit_cast(float, rw_[1] << 16), __builtin_bit_cast(float, rw_[1] & 0xffff0000u)}; \
                           VV[2] = (f32x2){__builtin_bit_cast(float, rw_[2] << 16), __builtin_bit_cast(float, rw_[2] & 0xffff0000u)}; VV[3] = (f32x2){__builtin_bit_cast(float, rw_[3] << 16), __builtin_bit_cast(float, rw_[3] & 0xffff0000u)}; } while (0)
          f32x2 x0[4], x1[4], x2[4];
          UNPK2(raw[0], x0); UNPK2(raw[1], x1); UNPK2(raw[2], x2);
#pragma unroll
          for (int i2 = 0; i2 < 4; ++i2) { f32x2 oa[4], ob[4];
#pragma unroll
              for (int hh = 0; hh < 2; ++hh) { const int ii = 2 * i2 + hh, t = t0 + ii; f32x2 x3[4];
                  UNPK2(raw[ii + 3], x3);
#pragma unroll
                  for (int m = 0; m < 4; ++m) { const f32x2 z = cb[m] + cw0[m] * x0[m] + cw1[m] * x1[m] + cw2[m] * x2[m] + cw3[m] * x3[m]; f32x2 o;
                      o.x = z.x * __builtin_amdgcn_rcpf(1.f + __expf(-z.x)); o.y = z.y * __builtin_amdgcn_rcpf(1.f + __expf(-z.y)); if (t < 0) o = (f32x2){0.f, 0.f};
                      if (hh == 0) oa[m] = o; else ob[m] = o;
                      x0[m] = x1[m]; x1[m] = x2[m]; x2[m] = x3[m]; }
                  if (cgp >= 32) { const f32x2* o = hh == 0 ? oa : ob; u32x4 w; w.x = pk2(o[0].x, o[0].y); w.y = pk2(o[1].x, o[1].y); w.z = pk2(o[2].x, o[2].y); w.w = pk2(o[3].x, o[3].y);
                      if (cgp < 48) *(LAS u32x4*)(Bm + (i0 + ii) * 136 + 8 * (cgp - 32)) = w; else *(LAS u32x4*)(Cm + (i0 + ii) * 136 + 8 * (cgp - 48)) = w; } }
#pragma unroll
              for (int m = 0; m < 4; ++m) { pk[2 * m][i2] = pk2(oa[m].x, ob[m].x); pk[2 * m + 1][i2] = pk2(oa[m].y, ob[m].y); } }
#undef UNPK2
          if (cgp < 48) { LAS bf16_t* dstT = cgp < 32 ? XT : BT; const int rb = cgp < 32 ? 8 * cgp : 8 * (cgp - 32);
#pragma unroll
              for (int k = 0; k < 8; ++k) *(LAS u32x4*)(dstT + swz72(rb + k, tg)) = (u32x4){pk[k][0], pk[k][1], pk[k][2], pk[k][3]}; } }
        BAR_LDS();
        RELAUNDER();
        { const int mt = wave & 3;
#pragma unroll
          for (int tn = 0; tn < 2; ++tn) { const int nt = 2 * (wave >> 2) + tn; f32x4 acc = (f32x4){0.f, 0.f, 0.f, 0.f};
#pragma unroll
              for (int ks = 0; ks < 4; ++ks) acc = mma32(ldfrag(Cm + 16 * mt * 136 + 32 * ks, 136, r, q), ldfrag(Bm + 16 * nt * 136 + 32 * ks, 136, r, q), acc);
#pragma unroll
              for (int j = 0; j < 4; ++j) CB[(16 * mt + 4 * q + j) * 72 + 16 * nt + r] = (bf16_t)f2bf(acc[j]); } }
        BAR_LDS();
        RELAUNDER();
        SSD_DT_PREFETCH(c + 1 < 65 ? c + 1 : 64);
        f32x4 acc1[4][2];
#pragma unroll
        for (int lt = 0; lt < 4; ++lt) { acc1[lt][0] = (f32x4){0.f, 0.f, 0.f, 0.f}; acc1[lt][1] = acc1[lt][0]; }
        const LAS float* acu = ACU + e * 64; const LAS float* dtv = DTV + e * 64;
#pragma unroll
        for (int nt = 0; nt < 8; ++nt) { const bf16x4 sb0 = cvt4(st[nt][0]), sb1 = cvt4(st[nt][1]);
#pragma unroll
            for (int lt = 0; lt < 4; ++lt) { const bf16x4 a4 = ldfrag4(Cm + 16 * lt * 136 + 16 * nt, 136, r, q); acc1[lt][0] = mma16(a4, sb0, acc1[lt][0]); acc1[lt][1] = mma16(a4, sb1, acc1[lt][1]); }
            __builtin_amdgcn_sched_barrier(0); }
#pragma unroll
        for (int lt = 0; lt < 4; ++lt)
#pragma unroll
            for (int j = 0; j < 4; ++j) { const float ea = __expf(acu[16 * lt + 4 * q + j]); acc1[lt][0][j] *= ea; acc1[lt][1][j] *= ea; }
#pragma unroll
        for (int lt = 0; lt < 4; ++lt)
#pragma unroll
            for (int ks = 0; ks < 2; ++ks) { if (ks == 1 && lt < 2) continue;
                const bf16x8 fr0 = ldfrag(CB + 16 * lt * 72 + 32 * ks, 72, r, q); const int ll = 16 * lt + r; const float al = acu[ll]; float f[8];
                const f32x4 ac0 = *(const LAS f32x4*)(acu + 32 * ks + 8 * q), ac1 = *(const LAS f32x4*)(acu + 32 * ks + 8 * q + 4), dt0 = *(const LAS f32x4*)(dtv + 32 * ks + 8 * q), dt1 = *(const LAS f32x4*)(dtv + 32 * ks + 8 * q + 4);
#pragma unroll
                for (int i = 0; i < 8; ++i) { const int s = 32 * ks + 8 * q + i; const float as_ = i < 4 ? ac0[i & 3] : ac1[i & 3], ds_ = i < 4 ? dt0[i & 3] : dt1[i & 3]; f[i] = (s <= ll) ? __expf(al - as_) * ds_ : 0.f; }
                const bf16x8 fm = scale8(fr0, f);
#pragma unroll
                for (int pt = 0; pt < 2; ++pt) acc1[lt][pt] = mma32(fm, *(const LAS bf16x8*)(XT + swz72(64 * e + 16 * (ptb + pt) + r, 4 * ks + q)), acc1[lt][pt]);
                __builtin_amdgcn_sched_barrier(0); }
#pragma unroll
        for (int lt = 0; lt < 4; ++lt)
#pragma unroll
            for (int j = 0; j < 4; ++j) { const int ll = 16 * lt + 4 * q + j;
#pragma unroll
                for (int pt = 0; pt < 2; ++pt) { const int pp = 16 * (ptb + pt) + r; YL[ll * 264 + 64 * e + pp] = (bf16_t)f2bf(acc1[lt][pt][j] + De * bf2f(XT[swz72(64 * e + pp, ll >> 3) + (ll & 7)])); } }
        u32x4 zreg[4];
#pragma unroll
        for (int rep = 0; rep < 4; ++rep) { const int idx = tid + 512 * rep, ll = idx >> 5, grp = idx & 31, t = 64 * c - 48 + ll;
            zreg[rep] = *(const u32x4*)(P + (size_t)row_of(b, t >= 0 ? t : 0) * NP + OFF_SSM + 256 * g + 8 * grp); }
        { const float a63 = acu[63], sc = __expf(a63); bf16x8 fx[2][2];
#pragma unroll
          for (int pt = 0; pt < 2; ++pt)
#pragma unroll
              for (int ks = 0; ks < 2; ++ks) { float f[8];
                  const f32x4 ac0 = *(const LAS f32x4*)(acu + 32 * ks + 8 * q), ac1 = *(const LAS f32x4*)(acu + 32 * ks + 8 * q + 4), dt0 = *(const LAS f32x4*)(dtv + 32 * ks + 8 * q), dt1 = *(const LAS f32x4*)(dtv + 32 * ks + 8 * q + 4);
#pragma unroll
                  for (int i = 0; i < 8; ++i) { const float as_ = i < 4 ? ac0[i & 3] : ac1[i & 3], ds_ = i < 4 ? dt0[i & 3] : dt1[i & 3]; f[i] = __expf(a63 - as_) * ds_; }
                  fx[pt][ks] = scale8(*(const LAS bf16x8*)(XT + swz72(64 * e + 16 * (ptb + pt) + r, 4 * ks + q)), f); }
#pragma unroll
          for (int nt = 0; nt < 8; ++nt) { const bf16x8 b0 = *(const LAS bf16x8*)(BT + swz72(16 * nt + r, q)), b1 = *(const LAS bf16x8*)(BT + swz72(16 * nt + r, 4 + q));
#pragma unroll
              for (int pt = 0; pt < 2; ++pt) { f32x4 s_ = st[nt][pt] * sc; s_ = mma32(b0, fx[pt][0], s_); s_ = mma32(b1, fx[pt][1], s_); st[nt][pt] = s_; }
              __builtin_amdgcn_sched_barrier(0); } }
        BAR_LDS();
        RELAUNDER();
#pragma unroll
        for (int rep = 0; rep < 4; ++rep) { const int idx = tid + 512 * rep, ll = idx >> 5, grp = idx & 31, t = 64 * c - 48 + ll; float y[8], zz[8];
            unpack8(*(const LAS u32x4*)(YL + ll * 264 + 8 * grp), y);
            const size_t row = (size_t)row_of(b, t >= 0 ? t : 0);
            unpack8(zreg[rep], zz);
            float ss = 0.f;
#pragma unroll
            for (int k = 0; k < 8; ++k) { y[k] *= siluf_(zz[k]); ss += y[k] * y[k]; }
            ss += __shfl_xor(ss, 1); ss += __shfl_xor(ss, 2); ss += __shfl_xor(ss, 4); ss += __shfl_xor(ss, 8); ss += __shfl_xor(ss, 16);
            const float rs = rsqrtf(ss * (1.f / 256.f) + 1e-5f); const float* nwp = normw + 256 * g + 8 * grp;
            u32x4 w; w.x = pk2(y[0] * rs * nwp[0], y[1] * rs * nwp[1]); w.y = pk2(y[2] * rs * nwp[2], y[3] * rs * nwp[3]); w.z = pk2(y[4] * rs * nwp[4], y[5] * rs * nwp[5]); w.w = pk2(y[6] * rs * nwp[6], y[7] * rs * nwp[7]);
            if (t >= 0) *(u32x4*)(YS1 + row * DM + 256 * g + 8 * grp) = w; }
        BAR_LDS();
    }
}
#undef RELAUNDER
#undef SSD_DT_PREFETCH

__device__ __forceinline__ void ret_unit(const KP& p, int b, int h, LAS unsigned char* lds, const int WAVE_U) {
    int tid_ = TIDX; asm volatile("" : "+v"(tid_)); const int tid = tid_, wave = __builtin_amdgcn_readfirstlane(tid >> 6), lane = tid & 63, r = lane & 15, q = lane >> 4;
    const bf16_t* P = (const bf16_t*)(p.ws + WS_P);
    bf16_t* YS2 = (bf16_t*)(p.ws + WS_YS) + (size_t)2 * MP * DM;
    LAS bf16_t* Q = (LAS bf16_t*)(lds + 0); LAS bf16_t* K = (LAS bf16_t*)(lds + 9216); LAS bf16_t* KT = (LAS bf16_t*)(lds + 18432); LAS bf16_t* VT = (LAS bf16_t*)(lds + 27648);
    LAS bf16_t* CB = (LAS bf16_t*)(lds + 46080); LAS bf16_t* YL = (LAS bf16_t*)(lds + 57344);
    const float lg0 = log2f(1.f - exp2f(-5.f - (float)h));
    f32x4 st[4];
#pragma unroll
    for (int i = 0; i < 4; ++i) st[i] = (f32x4){0.f, 0.f, 0.f, 0.f};
    const int f_ = tid & 31, it = tid >> 5; const float freq = powf(10000.f, -(float)f_ / 32.f);
    float lg = lg0;
    for (int c = 0; c < 65; ++c) {
        asm volatile("" : "+v"(lg));
        u32x4 greg[2];
#pragma unroll
        for (int rep = 0; rep < 2; ++rep) { const int idx = tid + 512 * rep, ll = idx >> 4, grp = idx & 15, t = 64 * c - 48 + ll;
            greg[rep] = *(const u32x4*)(P + (size_t)row_of(b, t >= 0 ? t : 0) * NP + OFF_RET + 2048 + 128 * h + 8 * grp); }
#pragma unroll
        for (int rep = 0; rep < 4; ++rep) { const int i = it + 16 * rep, t = 64 * c - 48 + i; float qa = 0.f, qb = 0.f, ka = 0.f, kb = 0.f;
            { const bf16_t* pr = P + (size_t)row_of(b, t >= 0 ? t : 0) * NP + OFF_RET + 64 * h + f_; const float vz = t >= 0 ? 1.f : 0.f; const float q1 = vz * bf2f(pr[0]), q2 = vz * bf2f(pr[32]), k1 = vz * bf2f(pr[512]), k2 = vz * bf2f(pr[544]);
                double rv = (double)((float)t * freq) * 0.15915494309189535; rv -= __builtin_rint(rv); const float rf = (float)rv; const float sn = __builtin_amdgcn_sinf(rf), cs = __builtin_amdgcn_cosf(rf); qa = q1 * cs - q2 * sn; qb = q2 * cs + q1 * sn; ka = (k1 * cs - k2 * sn) * 0.125f; kb = (k2 * cs + k1 * sn) * 0.125f; }
            Q[i * 72 + f_] = (bf16_t)f2bf(qa); Q[i * 72 + 32 + f_] = (bf16_t)f2bf(qb); const bf16_t kab = (bf16_t)f2bf(ka), kbb = (bf16_t)f2bf(kb);
            K[i * 72 + f_] = kab; K[i * 72 + 32 + f_] = kbb; KT[f_ * 72 + i] = kab; KT[(f_ + 32) * 72 + i] = kbb; }
#pragma unroll
        for (int rep = 0; rep < 2; ++rep) { const int idx = tid + 512 * rep, i = idx >> 4, grp = idx & 15, t = 64 * c - 48 + i; u32x4 w = (u32x4){0u, 0u, 0u, 0u};
            w = *(const u32x4*)(P + (size_t)row_of(b, t >= 0 ? t : 0) * NP + OFF_RET + 1024 + 128 * h + 8 * grp); if (t < 0) w = (u32x4){0u, 0u, 0u, 0u};
            LAS bf16_t* d = VT + (8 * grp) * 72 + i;
            d[0] = (bf16_t)(w.x & 0xffffu); d[72] = (bf16_t)(w.x >> 16); d[144] = (bf16_t)(w.y & 0xffffu); d[216] = (bf16_t)(w.y >> 16);
            d[288] = (bf16_t)(w.z & 0xffffu); d[360] = (bf16_t)(w.z >> 16); d[432] = (bf16_t)(w.w & 0xffffu); d[504] = (bf16_t)(w.w >> 16); }
        BAR_LDS();
        { const int mt = wave & 3;
#pragma unroll
          for (int tn = 0; tn < 2; ++tn) { const int nt = 2 * (wave >> 2) + tn; f32x4 acc = (f32x4){0.f, 0.f, 0.f, 0.f};
#pragma unroll
              for (int ks = 0; ks < 2; ++ks) acc = mma32(ldfrag(Q + 16 * mt * 72 + 32 * ks, 72, r, q), ldfrag(K + 16 * nt * 72 + 32 * ks, 72, r, q), acc);
#pragma unroll
              for (int j = 0; j < 4; ++j) CB[(16 * mt + 4 * q + j) * 72 + 16 * nt + r] = (bf16_t)f2bf(acc[j]); } }
        BAR_LDS();
        f32x4 acc1[4];
#pragma unroll
        for (int lt = 0; lt < 4; ++lt) acc1[lt] = (f32x4){0.f, 0.f, 0.f, 0.f};
#pragma unroll
        for (int dt = 0; dt < 4; ++dt) { const bf16x4 sb = cvt4(st[dt]);
#pragma unroll
            for (int lt = 0; lt < 4; ++lt) acc1[lt] = mma16(ldfrag4(Q + 16 * lt * 72 + 16 * dt, 72, r, q), sb, acc1[lt]); }
#pragma unroll
        for (int lt = 0; lt < 4; ++lt)
#pragma unroll
            for (int j = 0; j < 4; ++j) acc1[lt][j] *= __builtin_amdgcn_exp2f((float)(16 * lt + 4 * q + j + 1) * lg);
#pragma unroll
        for (int lt = 0; lt < 4; ++lt)
#pragma unroll
            for (int ks = 0; ks < 2; ++ks) { if (ks == 1 && lt < 2) continue;
                const int ll = 16 * lt + r; float f[8];
#pragma unroll
                for (int i = 0; i < 8; ++i) { const int s = 32 * ks + 8 * q + i; f[i] = (s <= ll) ? __builtin_amdgcn_exp2f((float)(ll - s) * lg) : 0.f; }
                acc1[lt] = mma32(scale8(ldfrag(CB + 16 * lt * 72 + 32 * ks, 72, r, q), f), ldfrag(VT + 16 * wave * 72 + 32 * ks, 72, r, q), acc1[lt]); }
#pragma unroll
        for (int lt = 0; lt < 4; ++lt)
#pragma unroll
            for (int j = 0; j < 4; ++j) YL[(16 * lt + 4 * q + j) * 136 + 16 * wave + r] = (bf16_t)f2bf(acc1[lt][j]);
        { const float sc = __builtin_amdgcn_exp2f(64.f * lg); bf16x8 fv[2];
#pragma unroll
          for (int ks = 0; ks < 2; ++ks) { float f[8];
#pragma unroll
              for (int i = 0; i < 8; ++i) f[i] = __builtin_amdgcn_exp2f((float)(63 - (32 * ks + 8 * q + i)) * lg);
              fv[ks] = scale8(ldfrag(VT + 16 * wave * 72 + 32 * ks, 72, r, q), f); }
#pragma unroll
          for (int dt = 0; dt < 4; ++dt) { f32x4 s_ = st[dt] * sc; s_ = mma32(ldfrag(KT + 16 * dt * 72, 72, r, q), fv[0], s_); s_ = mma32(ldfrag(KT + 16 * dt * 72 + 32, 72, r, q), fv[1], s_); st[dt] = s_; } }
        BAR_LDS();
#pragma unroll
        for (int rep = 0; rep < 2; ++rep) { const int idx = tid + 512 * rep, ll = idx >> 4, grp = idx & 15, t = 64 * c - 48 + ll; float y[8], gg[8];
            unpack8(*(const LAS u32x4*)(YL + ll * 136 + 8 * grp), y);
            const size_t row = (size_t)row_of(b, t >= 0 ? t : 0);
            unpack8(greg[rep], gg);
            float ss = 0.f;
#pragma unroll
            for (int k = 0; k < 8; ++k) ss += y[k] * y[k];
            ss += __shfl_xor(ss, 1); ss += __shfl_xor(ss, 2); ss += __shfl_xor(ss, 4); ss += __shfl_xor(ss, 8);
            const float rs = rsqrtf(ss * (1.f / 128.f) + 1e-6f);
            u32x4 w; w.x = pk2(siluf_(gg[0]) * y[0] * rs, siluf_(gg[1]) * y[1] * rs); w.y = pk2(siluf_(gg[2]) * y[2] * rs, siluf_(gg[3]) * y[3] * rs);
            w.z = pk2(siluf_(gg[4]) * y[4] * rs, siluf_(gg[5]) * y[5] * rs); w.w = pk2(siluf_(gg[6]) * y[6] * rs, siluf_(gg[7]) * y[7] * rs);
            if (t >= 0) *(u32x4*)(YS2 + row * DM + 128 * h + 8 * grp) = w; }
        BAR_LDS();
    }
}

__device__ __forceinline__ void lru_unit(const KP& p, int l, int b, int n, int hf, LAS unsigned char* lds, const int WAVE_U) {
    int tid_ = TIDX; asm volatile("" : "+v"(tid_)); const int tid = tid_, wave = __builtin_amdgcn_readfirstlane(tid >> 6), lane = tid & 63, r = lane & 15, q = lane >> 4;
    const bf16_t* P = (const bf16_t*)(p.ws + WS_P);
    bf16_t* YS3 = (bf16_t*)(p.ws + WS_YS) + (size_t)3 * MP * DM;
    const float* conv_w = p.in[20] + (size_t)l * 4 * DM; const float* conv_b = p.in[21] + (size_t)l * DM;
    const float* wg = p.in[22] + (size_t)l * 2 * 8 * 128 * 128; const float* bg = p.in[23] + (size_t)l * 2 * DM; const float* lam = p.in[24] + (size_t)l * DM;
    LAS bf16_t* WGT = (LAS bf16_t*)(lds + 0); LAS bf16_t* XC = (LAS bf16_t*)(lds + 34816); LAS float* AA = (LAS float*)(lds + 52224); LAS float* UU = (LAS float*)(lds + 68608);
    LAS float* SEG = (LAS float*)(lds + 84992); LAS float* CAR = (LAS float*)(lds + 89088);
    for (int idx = tid; idx < 2 * 64 * 128; idx += 512) { const int k = idx >> 13, rem = idx & 8191, cc = rem >> 6, e = rem & 63;
        WGT[(k * 64 + e) * 136 + cc] = (bf16_t)f2bf(wg[((size_t)(k * 8 + n) * 128 + cc) * 128 + 64 * hf + e]); }
    if (tid < 64) CAR[tid] = 0.f;
    const int cgp = tid & 15, tg = tid >> 4, cb8 = 128 * n + 8 * cgp, pcol = OFF_LRU + 1024 + cb8;
    const int chs = 128 * n + 64 * hf + (tid & 63), seg = tid >> 6;
    __syncthreads();
    for (int c = 0; c < 65; ++c) {
        unsigned short yin[8];
#pragma unroll
        for (int i = 0; i < 8; ++i) { const int t = 64 * c - 48 + 8 * seg + i; yin[i] = P[(size_t)row_of(b, t >= 0 ? t : 0) * NP + OFF_LRU + chs]; }
        { float cw0[8], cw1[8], cw2[8], cw3[8], cb[8]; u32x4 raw[5];
          const int i0 = 2 * tg, t0 = 64 * c - 48 + i0;
#pragma unroll
          for (int j = 0; j < 5; ++j) { const int t = t0 - 3 + j; raw[j] = *(const u32x4*)(P + (size_t)row_of(b, t >= 0 ? t : 0) * NP + pcol); if (t < 0) raw[j] = (u32x4){0u, 0u, 0u, 0u}; }
#pragma unroll
          for (int k = 0; k < 8; ++k) { cw0[k] = conv_w[cb8 + k]; cw1[k] = conv_w[DM + cb8 + k]; cw2[k] = conv_w[2 * DM + cb8 + k]; cw3[k] = conv_w[3 * DM + cb8 + k]; cb[k] = conv_b[cb8 + k]; }
#pragma unroll
          for (int ii = 0; ii < 2; ++ii) { const int t = t0 + ii, i = i0 + ii; float x0[8], x1[8], x2[8], x3[8], o[8];
              unpack8(raw[ii], x0); unpack8(raw[ii + 1], x1); unpack8(raw[ii + 2], x2); unpack8(raw[ii + 3], x3);
#pragma unroll
              for (int k = 0; k < 8; ++k) { const float z = cb[k] + cw0[k] * x0[k] + cw1[k] * x1[k] + cw2[k] * x2[k] + cw3[k] * x3[k]; o[k] = t >= 0 ? z : 0.f; }
              u32x4 w; w.x = pk2(o[0], o[1]); w.y = pk2(o[2], o[3]); w.z = pk2(o[4], o[5]); w.w = pk2(o[6], o[7]);
              *(LAS u32x4*)(XC + i * 136 + 8 * cgp) = w; } }
        BAR_LDS();
        { const int lt = wave & 3;
#pragma unroll
          for (int te = 0; te < 2; ++te) { const int et = 2 * (wave >> 2) + te; f32x4 a0 = (f32x4){0.f, 0.f, 0.f, 0.f}, a1 = a0;
#pragma unroll
              for (int ks = 0; ks < 4; ++ks) { const bf16x8 xa = ldfrag(XC + 16 * lt * 136 + 32 * ks, 136, r, q);
                  a0 = mma32(xa, ldfrag(WGT + (16 * et) * 136 + 32 * ks, 136, r, q), a0); a1 = mma32(xa, ldfrag(WGT + (64 + 16 * et) * 136 + 32 * ks, 136, r, q), a1); }
              const int e = 16 * et + r, chn = 128 * n + 64 * hf + e; const float b0 = bg[chn], b1 = bg[DM + chn], spl = softplusf_(-lam[chn]);
#pragma unroll
              for (int j = 0; j < 4; ++j) { const int tok = 16 * lt + 4 * q + j, t = 64 * c - 48 + tok;
                  const float rg = sigmoidf_(a0[j] + b0), ig = sigmoidf_(a1[j] + b1), la = -8.f * rg * spl; float a = __expf(la), u = __builtin_amdgcn_sqrtf(fmaxf(1.f - __expf(2.f * la), 0.f)) * ig * bf2f(XC[tok * 136 + 64 * hf + e]);
                  if (t < 0) { a = 1.f; u = 0.f; }
                  AA[tok * 64 + e] = a; UU[tok * 64 + e] = u; } } }
        BAR_LDS();
        { const int ch = tid & 63; float A = 1.f, H = 0.f;
#pragma unroll
          for (int i = 0; i < 8; ++i) { const float a = AA[(8 * seg + i) * 64 + ch], u = UU[(8 * seg + i) * 64 + ch]; H = a * H + u; A *= a; }
          SEG[(seg * 64 + ch) * 2] = A; SEG[(seg * 64 + ch) * 2 + 1] = H;
          BAR_LDS();
          float hcar = CAR[ch];
          for (int s2 = 0; s2 < seg; ++s2) hcar = SEG[(s2 * 64 + ch) * 2] * hcar + SEG[(s2 * 64 + ch) * 2 + 1];
#pragma unroll
          for (int i = 0; i < 8; ++i) { const int tok = 8 * seg + i, t = 64 * c - 48 + tok; hcar = AA[tok * 64 + ch] * hcar + UU[tok * 64 + ch];
              if (t >= 0) { const size_t row = (size_t)row_of(b, t); const float x = bf2f(yin[i]);
                  const float tu = 0.7978845608f * (x + 0.044715f * x * x * x); const float ge = 0.5f * x * (2.f - 2.f * __builtin_amdgcn_rcpf(1.f + __expf(2.f * tu)));
                  YS3[row * DM + chs] = (bf16_t)f2bf(hcar * ge); } }
          BAR_LDS();
          if (seg == 7) CAR[ch] = hcar; }
        BAR_LDS();
    }
}


__device__ __forceinline__ f32x4 skinny_tile(const bf16_t* A, const bf16_t* Bt, int K, int j, LAS unsigned char* lds, int wave, int lane) {
    const int r = lane & 15, q = lane >> 4; f32x4 acc[4];
#pragma unroll
    for (int nt = 0; nt < 4; ++nt) acc[nt] = (f32x4){0.f, 0.f, 0.f, 0.f};
    const bf16_t* ap = A + (size_t)(MMAIN + r) * K + 8 * q; const bf16_t* bp = Bt + (size_t)(64 * j + r) * K + 8 * q;
    const int nks = K / 32;
    for (int ks = wave; ks < nks; ks += 8) { const bf16x8 a = *(const bf16x8*)(ap + 32 * ks);
#pragma unroll
        for (int nt = 0; nt < 4; ++nt) acc[nt] = mma32(a, *(const bf16x8*)(bp + (size_t)16 * nt * K + 32 * ks), acc[nt]); }
    LAS f32x4* red = (LAS f32x4*)lds;
#pragma unroll
    for (int nt = 0; nt < 4; ++nt) red[(wave * 4 + nt) * 64 + lane] = acc[nt];
    __syncthreads();
    f32x4 tot = (f32x4){0.f, 0.f, 0.f, 0.f};
    if (wave < 4) {
#pragma unroll
        for (int w = 0; w < 8; ++w) tot += red[(w * 4 + wave) * 64 + lane]; }
    __syncthreads();
    return tot;
}
__device__ __forceinline__ void skinny_branch(const bf16_t* YS, const bf16_t* br_t, const bf16_t* P, float* Z, bf16_t* ZB, int j, LAS unsigned char* lds, const int WAVE_U) {
    int tid = TIDX; asm volatile("" : "+v"(tid)); const int wave = __builtin_amdgcn_readfirstlane(tid >> 6), lane = tid & 63, r = lane & 15, q = lane >> 4;
    for (int n = 0; n < 4; ++n) {
        const f32x4 acc = skinny_tile(YS + (size_t)n * MP * DM, br_t + (size_t)n * 1024 * DM, DM, j, lds, wave, lane);
        if (wave < 4) { const int col = 64 * j + 16 * wave + r;
#pragma unroll
            for (int jj = 0; jj < 4; ++jj) { const size_t row = MMAIN + 4 * q + jj; float v = sigmoidf_(bf2f(P[row * NP + OFF_GATE + n * 1024 + col])) * acc[jj];
                if (n != 0) v += Z[row * DM + col];
                if (n != 3) Z[row * DM + col] = v; else ZB[row * DM + col] = (bf16_t)f2bf(v); } }
    }
}
__device__ __forceinline__ void skinny_resid(const bf16_t* A, const bf16_t* Bt, int K, float* S, bf16_t* HN, const float* nw, float* ssq, int j, LAS unsigned char* lds, const int WAVE_U) {
    int tid = TIDX; asm volatile("" : "+v"(tid)); const int wave = __builtin_amdgcn_readfirstlane(tid >> 6), lane = tid & 63, r = lane & 15, q = lane >> 4;
    const f32x4 acc = skinny_tile(A, Bt, K, j, lds, wave, lane);
    LAS float* part = (LAS float*)lds;
    if (wave < 4) { const int col = 64 * j + 16 * wave + r; const float w = nw[col];
#pragma unroll
        for (int jj = 0; jj < 4; ++jj) { const size_t row = MMAIN + 4 * q + jj; const float sn = S[row * DM + col] + acc[jj]; S[row * DM + col] = sn; HN[row * DM + col] = (bf16_t)f2bf(sn * w);
            float ss = sn * sn; ss = DPP_ADD(ss, 0xB1); ss = DPP_ADD(ss, 0x4E); ss = DPP_ADD(ss, 0x141); ss = DPP_ADD(ss, 0x140);
            if (r == 0) part[wave * 16 + 4 * q + jj] = ss; } }
    __syncthreads();
    if (tid < 16) ssq[(size_t)(MMAIN + tid) * 16 + j] = (part[tid] + part[16 + tid]) + (part[32 + tid] + part[48 + tid]);
    __syncthreads();
}


#define XB_TMO      128
#define XB_XCNT(j)  (256  + 64 * (j))
#define XB_XSUB(j)  (1280 + 64 * (j))
#define XB_XGEN(j)  (2304 + 64 * (j))
#define XB_TOP      3328
#define XB_TOPGEN   3392
#define XCD_BAR_WORDS 3456
#define XB_SPIN_CAP (1u << 20)
__device__ __forceinline__ unsigned xb_ld(unsigned* p)              { return __hip_atomic_load(p, __ATOMIC_RELAXED, __HIP_MEMORY_SCOPE_AGENT); }
__device__ __forceinline__ unsigned xb_add(unsigned* p, unsigned v) { return __hip_atomic_fetch_add(p, v, __ATOMIC_RELAXED, __HIP_MEMORY_SCOPE_AGENT); }
__device__ __forceinline__ unsigned xb_xcc_id() { return (unsigned)__builtin_amdgcn_s_getreg((3 << 11) | 20) & 0xFu; }
#define XB_SPIN(cond, bar) do { unsigned _sp = 0; while (cond) { __builtin_amdgcn_s_sleep(1); \
    if ((++_sp & 255u) == 0u) { if (xb_ld(&(bar)[XB_TMO])) break; if (_sp > XB_SPIN_CAP) { atomicAdd(&(bar)[XB_TMO], 1u); break; } } } } while (0)
struct XcdBarrier { unsigned* bar; unsigned x; volatile LAS unsigned* st; };
__device__ __forceinline__ XcdBarrier xcd_barrier_post(unsigned* bar, volatile LAS unsigned* st, const int WAVE_U) {
    XcdBarrier b; b.bar = bar; b.x = (unsigned)__builtin_amdgcn_readfirstlane((int)xb_xcc_id()); b.st = st;
    if (TIDX == 0) (void)xb_add(&bar[XB_XCNT(b.x)], 1u);
    return b;
}
__device__ __forceinline__ void xcd_barrier_complete(unsigned* bar, unsigned x, unsigned& nloc, unsigned& nx) {
    const unsigned G = gridDim.x * gridDim.y * gridDim.z;
    unsigned sum, cnt, mine, sp = 0u;
    for (;;) {
        sum = 0u; cnt = 0u; mine = 0u;
#pragma unroll
        for (unsigned j = 0; j < 16; ++j) { const unsigned c = xb_ld(&bar[XB_XCNT(j)]); sum += c; cnt += (c > 0u) ? 1u : 0u; mine = (j == x) ? c : mine; }
        if (sum == G) break;
        __builtin_amdgcn_s_sleep(1);
        if ((++sp & 255u) == 0u) { if (xb_ld(&bar[XB_TMO])) break; if (sp > XB_SPIN_CAP) { atomicAdd(&bar[XB_TMO], 1u); break; } }
    }
    nloc = mine > 0u ? mine : 1u; nx = cnt > 0u ? cnt : 1u;
}
__device__ __forceinline__ void xcd_barrier(const XcdBarrier& b, const int WAVE_U) {
    asm volatile("s_waitcnt vmcnt(0)" ::: "memory");
    __syncthreads();
    if (TIDX == 0) {
        unsigned* bar = b.bar;
        __builtin_amdgcn_s_waitcnt(0);
        unsigned nloc = b.st[0], nx = b.st[1];
        if (nloc == 0u) { xcd_barrier_complete(bar, b.x, nloc, nx); b.st[0] = nloc; b.st[1] = nx; }
        const unsigned old = xb_add(&bar[XB_XSUB(b.x)], 1u);
        const unsigned gen = old / nloc;
        if (old + 1u == (gen + 1u) * nloc) {
            __builtin_amdgcn_fence(__ATOMIC_RELEASE, "agent");
            asm volatile("s_waitcnt vmcnt(0)" ::: "memory");
            const unsigned og = xb_add(&bar[XB_TOP], 1u);
            const unsigned tg = og / nx;
            if (og + 1u == (tg + 1u) * nx) xb_add(&bar[XB_TOPGEN], 1u);
            else XB_SPIN(xb_ld(&bar[XB_TOPGEN]) == tg, bar);
            __builtin_amdgcn_fence(__ATOMIC_ACQUIRE, "agent");
            xb_add(&bar[XB_XGEN(b.x)], 1u);
            asm volatile("s_waitcnt vmcnt(0)" ::: "memory");
        } else {
            XB_SPIN(xb_ld(&bar[XB_XGEN(b.x)]) == gen, bar);
            __builtin_amdgcn_fence(__ATOMIC_ACQUIRE, "agent");
            asm volatile("s_waitcnt vmcnt(0)" ::: "memory");
        }
    }
    __syncthreads();
}


__device__ __forceinline__ void subgrid_arrive(unsigned* word, const int WAVE_U) {
    asm volatile("s_waitcnt vmcnt(0)" ::: "memory");
    __syncthreads();
    if (TIDX == 0) { __builtin_amdgcn_fence(__ATOMIC_RELEASE, "agent"); asm volatile("s_waitcnt vmcnt(0)" ::: "memory"); (void)xb_add(word, 1u); }
}
__device__ __forceinline__ void subgrid_wait(unsigned* word, unsigned nblocks, const int WAVE_U) {
    if (TIDX == 0) { unsigned sp = 0u; while (xb_ld(word) < nblocks) { __builtin_amdgcn_s_sleep(1); if (++sp > (1u << 22)) break; }
        __builtin_amdgcn_fence(__ATOMIC_ACQUIRE, "agent"); asm volatile("s_waitcnt vmcnt(0)" ::: "memory"); }
    __syncthreads();
}
__device__ __forceinline__ void subgrid_barrier(unsigned* word, unsigned nblocks, const int WAVE_U) {
    asm volatile("s_waitcnt vmcnt(0)" ::: "memory");
    __syncthreads();
    if (TIDX == 0) {
        __builtin_amdgcn_fence(__ATOMIC_RELEASE, "agent");
        asm volatile("s_waitcnt vmcnt(0)" ::: "memory");
        (void)xb_add(word, 1u);
        unsigned sp = 0u;
        while (xb_ld(word) < nblocks) { __builtin_amdgcn_s_sleep(1); if (++sp > (1u << 22)) break; }
        __builtin_amdgcn_fence(__ATOMIC_ACQUIRE, "agent");
        asm volatile("s_waitcnt vmcnt(0)" ::: "memory");
    }
    __syncthreads();
}

#ifndef REP_P1
#define REP_P1 1
#endif
#ifndef REP_RWKV
#define REP_RWKV 1
#endif
#ifndef REP_SSD
#define REP_SSD 1
#endif
#ifndef REP_RET
#define REP_RET 1
#endif
#ifndef REP_LRU
#define REP_LRU 1
#endif
#ifndef PH_MASK
#define PH_MASK 1023
#endif
constexpr int LDS_BYTES = 160768;
constexpr int NUNITS = 176;

__global__ void __launch_bounds__(512, 2) fwd_megakernel(KP p) {
    extern __shared__ __attribute__((aligned(16))) unsigned char lds_raw[];
    LAS unsigned char* lds = (LAS unsigned char*)lds_raw;
    cg::grid_group grid = cg::this_grid();
    const int WAVE_U = __builtin_amdgcn_readfirstlane((int)(threadIdx.x >> 6));
    constexpr int G = 256; int bx = blockIdx.x; constexpr int NGW = G * 8;
#define FRESH_TID() int tid_ = TIDX; asm volatile("" : "+v"(tid_)); const int tid = tid_, wave = tid >> 6, lane = tid & 63, gw = bx * 8 + wave; (void)gw; (void)lane
    float* ssq = (float*)(p.ws + WS_SSQ); float* S = (float*)(p.ws + WS_S); bf16_t* HN = (bf16_t*)(p.ws + WS_HN); bf16_t* P = (bf16_t*)(p.ws + WS_P);
    bf16_t* YS = (bf16_t*)(p.ws + WS_YS); float* Z = (float*)(p.ws + WS_Z); bf16_t* ZB = (bf16_t*)(p.ws + WS_ZB); bf16_t* WIN = (bf16_t*)(p.ws + WS_WIN);
    bf16_t* H = (bf16_t*)(p.ws + WS_P);
    {
        FRESH_TID();
        const float* nw0 = p.in[2];
        for (int m = gw; m < MP; m += NGW) {
            const float* src = m < MMAIN ? p.in[0] + (size_t)m * DM : (m < MMAIN + NMETA ? p.in[1] + (size_t)(m - MMAIN) * DM : nullptr);
            float ss = 0.f;
#pragma unroll
            for (int j = 0; j < 4; ++j) { const int col = 4 * lane + 256 * j; f32x4 v = (f32x4){0.f, 0.f, 0.f, 0.f}; if (src) v = *(const f32x4*)(src + col);
                *(f32x4*)(S + (size_t)m * DM + col) = v; const f32x4 w = *(const f32x4*)(nw0 + col);
                u32x2 o; o.x = pk2(v[0] * w[0], v[1] * w[1]); o.y = pk2(v[2] * w[2], v[3] * w[3]); *(u32x2*)(HN + (size_t)m * DM + col) = o;
                ss += (v[0] * v[0] + v[1] * v[1]) + (v[2] * v[2] + v[3] * v[3]); }
#pragma unroll
            for (int o = 1; o < 64; o <<= 1) ss += __shfl_xor(ss, o);
            if (lane < 16) ssq[(size_t)m * 16 + lane] = lane == 0 ? ss : 0.f;
        }
        for (int i = bx * 512 + tid; i < (NP - INW) * DM / 8; i += G * 512) ((u32x4*)(WIN + (size_t)INW * DM))[i] = (u32x4){0u, 0u, 0u, 0u};
        convert_layer(p, 0, lds, gw, NGW, wave, lane);
        if (bx == 0) for (int i = tid; i < XCD_BAR_WORDS + 512; i += 512) ((unsigned*)(p.ws + WS_XBAR))[i] = 0u;
        if (tid == 0) { ((volatile LAS unsigned*)(lds + LDS_BYTES - 16))[0] = 0u; ((volatile LAS unsigned*)(lds + LDS_BYTES - 16))[1] = 0u; }
    }
    grid.sync();
    XcdBarrier xbar = xcd_barrier_post((unsigned*)(p.ws + WS_XBAR), (volatile LAS unsigned*)(lds + LDS_BYTES - 16), WAVE_U);
    for (int l_ = 0; l_ < NLAYER; ++l_) {
        int l = l_; asm volatile("" : "+s"(l)); asm volatile("" : "+s"(bx));
        unsigned char* sm = p.ws + WS_WSM + (size_t)(l & 1) * WSM_SIZE;
        const bf16_t* br_t = (const bf16_t*)(sm + WSM_BR); const bf16_t* out_t = (const bf16_t*)(sm + WSM_OUT); const bf16_t* fi_t = (const bf16_t*)(sm + WSM_FI); const bf16_t* fo_t = (const bf16_t*)(sm + WSM_FO);
        if (PH_MASK & 1) for (int rp = 0; rp < REP_P1; ++rp) { pg8::Gemm g{HN, WIN, DM}; pg8::RemapOrder So; So.b.init(NTM, PT_A + 1, G, bx); So.from = PT_A; So.to = NP / 256 - 1; pg8::EpiInProj E{P, ssq + (size_t)(2 * l) * MP * 16, 0}; pg8::gemm_phase(lds, g, So, E, WAVE_U); }
        xcd_barrier(xbar, WAVE_U);
        asm volatile("" : "+s"(bx));
        { FRESH_TID(); rwkv_lora_inputs(p, l, gw, NGW, lane); }
        xcd_barrier(xbar, WAVE_U);
        asm volatile("" : "+s"(bx));
        {
            int l = l_; asm volatile("" : "+s"(l));
            if (bx < 64) rwkv_unit(p, l, bx >> 4, bx & 15, lds, WAVE_U);
            else if (bx < 80) ssd_unit(p, l, (bx - 64) >> 2, (bx - 64) & 3, lds, WAVE_U);
            else {
                { pg8::Gemm g{HN, WIN + (size_t)PT_A * 256 * DM, DM}; pg8::StaticOrder So; So.init(NTM, GT0 - PT_A, G - 80, bx - 80);
                  pg8::EpiInProj E{P, ssq + (size_t)(2 * l) * MP * 16, PT_A}; pg8::gemm_phase(lds, g, So, E, WAVE_U); }
                unsigned* sbw = (unsigned*)(p.ws + WS_XBAR) + XCD_BAR_WORDS + 64 + 64 * l;
                subgrid_arrive(sbw, WAVE_U);
                if (bx < 176) subgrid_wait(sbw, (unsigned)(G - 80), WAVE_U);
                if (bx < 112) ret_unit(p, (bx - 80) >> 3, (bx - 80) & 7, lds, WAVE_U);
                else if (bx < 176) { const int v = bx - 112; lru_unit(p, l, v >> 4, (v >> 1) & 7, v & 1, lds, WAVE_U); }
                else { { pg8::Gemm g{HN, (const bf16_t*)(p.ws + WS_WING + (size_t)(l & 1) * WING_SIZE), DM}; pg8::StaticOrder So; So.init(NTM, GTN, G - 176, bx - 176);
                         pg8::EpiInProj E{P, ssq + (size_t)(2 * l) * MP * 16, GT0}; pg8::gemm_phase(lds, g, So, E, WAVE_U); }
                       subgrid_wait(sbw, (unsigned)(G - 80), WAVE_U);
                       if (l_ + 1 < NLAYER) { FRESH_TID(); convert_layer(p, l + 1, lds, (bx - 176) * 8 + wave, (G - 176) * 8, wave, lane); } }
            }
        }
        xcd_barrier(xbar, WAVE_U);
        asm volatile("" : "+s"(bx));
        if (PH_MASK & 32) { pg8::Gemm g{YS, br_t, DM}; pg8::BranchOrder So{G, bx}; pg8::EpiBranch E{P, Z, ZB}; pg8::gemm_phase(lds, g, So, E, WAVE_U);
          if (bx < 16) skinny_branch(YS, br_t, P, Z, ZB, bx, lds, WAVE_U); }
        xcd_barrier(xbar, WAVE_U);
        asm volatile("" : "+s"(bx));
        if (PH_MASK & 64) { pg8::Gemm g{ZB, out_t, DM}; pg8::StaticOrder So; So.init(NTM - 1, 4, G, bx); pg8::EpiResid E{S, HN, p.in[3] + (size_t)l * DM, ssq + (size_t)(2 * l + 1) * MP * 16}; pg8::gemm_phase(lds, g, So, E, WAVE_U);
          if (bx < 16) skinny_resid(ZB, out_t, DM, S, HN, p.in[3] + (size_t)l * DM, ssq + (size_t)(2 * l + 1) * MP * 16, bx, lds, WAVE_U); }
        xcd_barrier(xbar, WAVE_U);
        asm volatile("" : "+s"(bx));
        if (PH_MASK & 128) { pg8::Gemm g{HN, fi_t, DM}; pg8::StaticOrder So; So.init(NTM, 2 * FF / 256, G, bx); pg8::EpiSwiglu E{H, ssq + (size_t)(2 * l + 1) * MP * 16}; pg8::gemm_phase(lds, g, So, E, WAVE_U); }
        xcd_barrier(xbar, WAVE_U);
        asm volatile("" : "+s"(bx));
        if (PH_MASK & 256) { pg8::Gemm g{H, fo_t, FF}; pg8::StaticOrder So; So.init(NTM - 1, 4, G, bx); const float* nwn = (l + 1 < NLAYER) ? p.in[2] + (size_t)(l + 1) * DM : p.in[29];
          pg8::EpiResid E{S, HN, nwn, ssq + (size_t)(2 * l + 2) * MP * 16}; pg8::gemm_phase(lds, g, So, E, WAVE_U);
          if (bx < 16) skinny_resid(H, fo_t, FF, S, HN, nwn, ssq + (size_t)(2 * l + 2) * MP * 16, bx, lds, WAVE_U); }
        xcd_barrier(xbar, WAVE_U);
        asm volatile("" : "+s"(bx));
    }
    { FRESH_TID(); const float* fw = p.in[29]; const float* sq = ssq + (size_t)8 * MP * 16;
      for (int m = gw; m < MMAIN; m += NGW) { const float rs = rsqrtf(ssq_total(sq, m) * (1.f / 1024.f) + 1e-6f);
#pragma unroll
          for (int j = 0; j < 4; ++j) { const int col = 4 * lane + 256 * j; const f32x4 v = *(const f32x4*)(S + (size_t)m * DM + col), w = *(const f32x4*)(fw + col);
              *(f32x4*)(p.out + (size_t)m * DM + col) = v * rs * w; } } }
}

extern "C" void kernel_launch(void* const* d_in, const int* in_sizes, int n_in, void* d_out, int out_size, void* d_ws, size_t ws_size, hipStream_t stream) {
    static int grid = 0;
    if (grid == 0) {
        if (n_in != 30 || ws_size < WS_END) { fprintf(stderr, "kernel_launch: unexpected n_in %d / ws %zu (need %zu)\n", n_in, ws_size, (size_t)WS_END); grid = -1; return; }
        int dev = 0, cus = 0, per_cu = 0;
        hipGetDevice(&dev); hipDeviceGetAttribute(&cus, hipDeviceAttributeMultiprocessorCount, dev);
        hipFuncSetAttribute((const void*)fwd_megakernel, hipFuncAttributeMaxDynamicSharedMemorySize, LDS_BYTES);
        hipOccupancyMaxActiveBlocksPerMultiprocessor(&per_cu, (const void*)fwd_megakernel, 512, LDS_BYTES);
        if (per_cu < 1) { fprintf(stderr, "kernel_launch: occupancy query says %d blocks/CU\n", per_cu); per_cu = 1; }
        (void)hipGetLastError();
        grid = 256;
        if (cus < 256) { fprintf(stderr, "kernel_launch: this kernel needs 256 CUs (got %d)\n", cus); grid = -1; return; }
    }
    if (grid < 0) return;
    KP p{};
    for (int i = 0; i < 30; ++i) p.in[i] = (const float*)d_in[i];
    p.out = (float*)d_out; p.ws = (unsigned char*)d_ws;
    void* args[] = {&p};
    hipError_t e = hipLaunchCooperativeKernel((const void*)fwd_megakernel, dim3(grid), dim3(512), args, LDS_BYTES, stream);
    if (e != hipSuccess) fprintf(stderr, "cooperative launch failed: %s (grid %d)\n", hipGetErrorString(e), grid);
}
```

```cpp
#include <hip/hip_runtime.h>
#include <hip/hip_cooperative_groups.h>
#include <cstdio>
#include <cstdint>
namespace cg = cooperative_groups;

#define LAS __attribute__((address_space(3)))
typedef unsigned short bf16_t;
typedef short bf16x8 __attribute__((ext_vector_type(8)));
typedef short bf16x4 __attribute__((ext_vector_type(4)));
typedef float f32x4 __attribute__((ext_vector_type(4)));
typedef unsigned u32x4 __attribute__((ext_vector_type(4)));
typedef unsigned u32x2 __attribute__((ext_vector_type(2)));

constexpr int DM = 1024, NB = 4, SEQ = 4096, NMETA = 16, TT = SEQ + NMETA;
constexpr int MMAIN = NB * SEQ;
constexpr int MP = 16640, NTM = MP / 256;
constexpr int INW = 15632, NP = 15872;
constexpr int OFF_SSM = 3328, OFF_RET = 6416, OFF_LRU = 9488, OFF_GATE = 11536, OFF_VLO = 15632;
constexpr int FF = 2816;
constexpr int NLAYER = 4;

constexpr size_t WS_SSQ = 0;
constexpr size_t WS_XBAR = 12u << 20;
constexpr size_t WS_S = 16u << 20;
constexpr size_t WS_HN = WS_S + (size_t)MP * DM * 4;
constexpr size_t WS_P = WS_HN + (size_t)MP * DM * 2;
constexpr size_t WS_YS = WS_P + (size_t)MP * NP * 2;
constexpr size_t WS_VF = WS_YS + (size_t)4 * MP * DM * 2;
constexpr size_t WS_Z = WS_VF + (size_t)MP * DM * 2;
constexpr size_t WS_ZB = WS_Z + (size_t)MP * DM * 4;
constexpr size_t WS_WIN = WS_ZB + (size_t)MP * DM * 2;
constexpr size_t WSM_BR = 0, WSM_OUT = (size_t)4096 * 1024 * 2, WSM_FI = WSM_OUT + (size_t)1024 * 1024 * 2,
                 WSM_FO = WSM_FI + (size_t)2 * FF * 1024 * 2, WSM_SIZE = WSM_FO + (size_t)1024 * FF * 2;
constexpr size_t WS_WSM = WS_WIN + (size_t)NP * DM * 2;
constexpr int PT_A = 26;
constexpr int GT0 = 46, GTN = 15;
constexpr size_t WS_WING = WS_WSM + 2 * WSM_SIZE, WING_SIZE = (size_t)GTN * 256 * DM * 2;
constexpr size_t WS_END = WS_WING + 2 * WING_SIZE;
static_assert(WS_END <= 1024458752ull, "workspace map exceeds 4 x w_in bytes");

typedef float f32x2_t __attribute__((ext_vector_type(2))); typedef __bf16 bf16x2_t __attribute__((ext_vector_type(2)));
__device__ __forceinline__ unsigned pk2(float lo, float hi) { f32x2_t v = {lo, hi}; bf16x2_t b = __builtin_convertvector(v, bf16x2_t); return __builtin_bit_cast(unsigned, b); }
__device__ __forceinline__ unsigned f2bf(float f) { return pk2(f, f); }
__device__ __forceinline__ float bf2f(unsigned h) { return __builtin_bit_cast(float, h << 16); }
__device__ __forceinline__ float sigmoidf_(float x) { return __builtin_amdgcn_rcpf(1.f + __expf(-x)); }
__device__ __forceinline__ float softplusf_(float x) { return x > 20.f ? x : log1pf(__expf(x)); }
__device__ __forceinline__ float siluf_(float x) { return x * __builtin_amdgcn_rcpf(1.f + __expf(-x)); }
__device__ __forceinline__ int row_of(int b, int t) { return t < NMETA ? MMAIN + t : b * SEQ + (t - NMETA); }
__device__ __forceinline__ void unpack8(u32x4 w, float* f) {
    f[0] = bf2f(w.x & 0xffffu); f[1] = bf2f(w.x >> 16); f[2] = bf2f(w.y & 0xffffu); f[3] = bf2f(w.y >> 16);
    f[4] = bf2f(w.z & 0xffffu); f[5] = bf2f(w.z >> 16); f[6] = bf2f(w.w & 0xffffu); f[7] = bf2f(w.w >> 16);
}
__device__ __forceinline__ float dpp_f(float x, const int ctrl_is_const_only) { return x; }
#define DPP_ADD(x, ctrl) ((x) + __builtin_bit_cast(float, __builtin_amdgcn_update_dpp(0, __builtin_bit_cast(int, (x)), (ctrl), 0xf, 0xf, true)))
__device__ __forceinline__ float half_sum32(float x) { x = DPP_ADD(x, 0xB1); x = DPP_ADD(x, 0x4E); x = DPP_ADD(x, 0x141); x = DPP_ADD(x, 0x140); x += __shfl_xor(x, 16); return x; }
#define TIDX ((void)WAVE_U, (int)threadIdx.x)
__device__ __forceinline__ float ssq_total_q(const float* ssq, int row, int fq) {
    const f32x4 a = *(const f32x4*)(ssq + (size_t)row * 16 + 4 * fq); float t = (a[0] + a[1]) + (a[2] + a[3]);
    t += __shfl_xor(t, 16); t += __shfl_xor(t, 32); return t;
}
#define LDS_WAIT() asm volatile("s_waitcnt lgkmcnt(0)" ::: "memory")
#ifndef REP_A
#define REP_A 1
#endif
#ifndef REP_B
#define REP_B 1
#endif
#define BAR_LDS() asm volatile("s_waitcnt lgkmcnt(0)\n\ts_barrier" ::: "memory")
__device__ __forceinline__ float ssq_total(const float* ssq, int row) {
    const f32x4 a = *(const f32x4*)(ssq + (size_t)row * 16), b = *(const f32x4*)(ssq + (size_t)row * 16 + 4), c = *(const f32x4*)(ssq + (size_t)row * 16 + 8), d = *(const f32x4*)(ssq + (size_t)row * 16 + 12);
    return (((a[0] + a[1]) + (a[2] + a[3])) + ((b[0] + b[1]) + (b[2] + b[3]))) + (((c[0] + c[1]) + (c[2] + c[3])) + ((d[0] + d[1]) + (d[2] + d[3])));
}

namespace pg8 {
constexpr int BM = 256, BK = 64, HALF = 128, HTB = HALF * BK * 2, STAGE_BYTES = 8 * HTB, NXCD = 8, WGM = 8;
__host__ __device__ __forceinline__ int lds_byte(int r, int c) { const int st = (r >> 4) * 2 + (c >> 5), rr = r & 15, cc = c & 31, ob = rr * 64 + cc * 2; return st * 1024 + (ob ^ (((ob >> 9) & 1) << 5)); }
__host__ __device__ __forceinline__ void stage_rc(int b, int& R, int& C) { const int st = b / 1024, sb = b % 1024, swz = sb ^ (((sb >> 9) & 1) << 5); R = (st >> 1) * 16 + swz / 64; C = (st & 1) * 32 + (swz % 64) / 2; }
__host__ __device__ __forceinline__ int perm32(int rho) { const int n = rho >> 4, i = rho & 15; return 8 * (i >> 2) + 4 * n + (i & 3); }
struct Unit { int pm, pn; };
struct Gemm { const bf16_t* A; const bf16_t* Bt; int K; };
struct StaticOrder {
    int nM, nN, nwg, G, c;
    __device__ void init(int nM_, int nN_, int G_, int c_) { nM = nM_; nN = nN_; nwg = nM * nN; G = G_; c = c_; }
    __device__ bool next(int i, Unit& u) const {
        const long L = (long)i * G + c; if (L >= nwg) return false;
        int wgid = (int)L; { const int q = nwg / NXCD, r = nwg % NXCD, xcd = wgid % NXCD, off = wgid / NXCD; wgid = (xcd < r ? xcd * (q + 1) : r * (q + 1) + (xcd - r) * q) + off; }
        const int nig = WGM * nN, gid = wgid / nig, fm = gid * WGM, gsz = (nM - fm) < WGM ? (nM - fm) : WGM;
        u.pm = fm + ((wgid % nig) % gsz); u.pn = (wgid % nig) / gsz; return true;
    }
};
struct RemapOrder { StaticOrder b; int from, to;
    __device__ bool next(int i, Unit& u) const { if (!b.next(i, u)) return false; if (u.pn == from) u.pn = to; return true; } };
struct BranchOrder {
    int G, c;
    __device__ bool next(int i, Unit& u) const {
        const int su = (i >> 2) * G + c, n = i & 3; if (su >= (NTM - 1) * 4) return false;
        u.pm = n * NTM + (su >> 2); u.pn = n * 4 + (su & 3); return true;
    }
};

template <class Epi, class Sched>
__device__ __forceinline__ void gemm_phase(LAS unsigned char* lds, const Gemm g, const Sched& S, const Epi& E, const int WAVE_U) {
    int tid_ = TIDX; asm volatile("" : "+v"(tid_)); const int tid = tid_, wid = __builtin_amdgcn_readfirstlane(tid >> 6), lane = tid & 63, wr = wid >> 2, wc = wid & 3, fr = lane & 15, fq = lane >> 4;
    const int K = g.K, nt = K / BK;
    unsigned voffA[2], voffB[2];
#pragma unroll
    for (int i = 0; i < 2; ++i) { int R, C; stage_rc(tid * 16 + i * 8192, R, C); const int Rb = (R & ~31) + perm32(R & 31);
        voffA[i] = (unsigned)(R * K + C) * 2u; voffB[i] = (unsigned)(Rb * K + C) * 2u; }
    const size_t kstep = (size_t)(BK * 2);
    const size_t hstep = (size_t)HALF * K * 2;
    const size_t tstep = 2 * hstep;
    const unsigned ldsw = (unsigned)wid * 1024u;
    const int aoff = lds_byte(wr * 64 + fr, fq * 8), boff = lds_byte(wc * 32 + fr, fq * 8);
#define PG8_SA(b, h) (((b) * 2 + (h)) * HTB)
#define PG8_SB(b, h) ((4 + (b) * 2 + (h)) * HTB)
#define PG8_STAGE(bufoff, gbase, voff) do { _Pragma("unroll") for (int _i = 0; _i < 2; ++_i) \
        __builtin_amdgcn_global_load_lds((const unsigned*)((const char*)(gbase) + (voff)[_i]), (LAS unsigned*)(lds + (bufoff) + ldsw + _i * 8192), 16, 0, 0); } while (0)
#define PG8_LDA(dst, b, h) do { _Pragma("unroll") for (int m = 0; m < 4; ++m) _Pragma("unroll") for (int k = 0; k < 2; ++k) dst[m][k] = *(const LAS bf16x8*)(lds + PG8_SA(b, h) + aoff + m * 2048 + k * 1024); } while (0)
#define PG8_LDB(dst, b, h) do { _Pragma("unroll") for (int n = 0; n < 2; ++n) _Pragma("unroll") for (int k = 0; k < 2; ++k) dst[n][k] = *(const LAS bf16x8*)(lds + PG8_SB(b, h) + boff + n * 2048 + k * 1024); } while (0)
#define PG8_MMA(ai, bj, At, Bt) do { __builtin_amdgcn_s_setprio(1); _Pragma("unroll") for (int m = 0; m < 4; ++m) _Pragma("unroll") for (int n = 0; n < 2; ++n) _Pragma("unroll") for (int k = 0; k < 2; ++k) \
        acc[ai][bj][m][n] = __builtin_amdgcn_mfma_f32_16x16x32_bf16(Bt[n][k], At[m][k], acc[ai][bj][m][n], 0, 0, 0); __builtin_amdgcn_s_setprio(0); } while (0)
#define PG8_WAIT_V(n) asm volatile("s_waitcnt vmcnt(" #n ")" ::: "memory")
#define PG8_WAIT_L(n) asm volatile("s_waitcnt lgkmcnt(" #n ")" ::: "memory")
#define PG8_BAR __builtin_amdgcn_s_barrier()
#define PG8_SCHED __builtin_amdgcn_sched_barrier(0)
    Unit cur, nxt; int ui = 0;
    if (!S.next(0, cur)) return;
    f32x4 acc[2][2][4][2];
#pragma unroll
    for (int a = 0; a < 2; ++a)
#pragma unroll
        for (int b = 0; b < 2; ++b)
#pragma unroll
            for (int m = 0; m < 4; ++m)
#pragma unroll
                for (int n = 0; n < 2; ++n) acc[a][b][m][n] = (f32x4){0.f, 0.f, 0.f, 0.f};
    bf16x8 At[4][2], B0[2][2], B1[2][2];
    const char* cA = (const char*)g.A + (size_t)cur.pm * tstep; const char* cB = (const char*)g.Bt + (size_t)cur.pn * tstep;
    PG8_STAGE(PG8_SB(0, 0), cB, voffB); PG8_STAGE(PG8_SB(0, 1), cB + hstep, voffB); PG8_STAGE(PG8_SA(0, 0), cA, voffA); PG8_STAGE(PG8_SA(0, 1), cA + hstep, voffA);
    if (wr == 1) PG8_BAR;
    PG8_WAIT_V(2); PG8_BAR;
    PG8_STAGE(PG8_SB(1, 0), cB + kstep, voffB); PG8_STAGE(PG8_SA(1, 0), cA + kstep, voffA); PG8_STAGE(PG8_SB(1, 1), cB + hstep + kstep, voffB);
    PG8_WAIT_V(6); PG8_BAR;
    for (;;) {
        const bool has_next = S.next(ui + 1, nxt);
        const char* nA = has_next ? (const char*)g.A + (size_t)nxt.pm * tstep : cA; const char* nB = has_next ? (const char*)g.Bt + (size_t)nxt.pn * tstep : cB;
        for (int t = 0; t < nt; t += 2) {
            const bool last = (t == nt - 2);
            const char* a1 = cA + (size_t)(t + 1) * kstep;
            const char* a2 = last ? nA : cA + (size_t)(t + 2) * kstep; const char* b2 = last ? nB : cB + (size_t)(t + 2) * kstep;
            const char* a3 = a2 + kstep; const char* b3 = b2 + kstep;
            PG8_LDB(B0, 0, 0); PG8_LDB(B1, 0, 1); PG8_SCHED; PG8_LDA(At, 0, 0); PG8_STAGE(PG8_SA(1, 1), a1 + hstep, voffA);
            PG8_WAIT_V(8); PG8_WAIT_L(0); PG8_BAR; PG8_MMA(0, 0, At, B0); PG8_MMA(0, 1, At, B1); PG8_BAR; PG8_SCHED;
            PG8_LDA(At, 0, 1); PG8_STAGE(PG8_SB(0, 0), b2, voffB); PG8_STAGE(PG8_SB(0, 1), b2 + hstep, voffB); PG8_STAGE(PG8_SA(0, 0), a2, voffA);
            PG8_WAIT_V(8); PG8_WAIT_L(0); PG8_BAR; PG8_MMA(1, 0, At, B0); PG8_MMA(1, 1, At, B1); PG8_BAR; PG8_SCHED;
            PG8_LDB(B0, 1, 0); PG8_LDB(B1, 1, 1); PG8_SCHED; PG8_LDA(At, 1, 0); PG8_STAGE(PG8_SA(0, 1), a2 + hstep, voffA);
            PG8_WAIT_V(8); PG8_WAIT_L(0); PG8_BAR; PG8_MMA(0, 0, At, B0); PG8_MMA(0, 1, At, B1); PG8_BAR; PG8_SCHED;
            PG8_LDA(At, 1, 1); PG8_STAGE(PG8_SB(1, 0), b3, voffB); PG8_STAGE(PG8_SB(1, 1), b3 + hstep, voffB); PG8_STAGE(PG8_SA(1, 0), a3, voffA);
            PG8_WAIT_V(8); PG8_WAIT_L(0); PG8_BAR; PG8_MMA(1, 0, At, B0); PG8_MMA(1, 1, At, B1); PG8_BAR; PG8_SCHED;
        }
        if (wr == 0) PG8_BAR;
        E(acc, cur, wr, wc, fr, fq);
        if (!has_next) break;
#pragma unroll
        for (int a = 0; a < 2; ++a)
#pragma unroll
            for (int b = 0; b < 2; ++b)
#pragma unroll
                for (int m = 0; m < 4; ++m)
#pragma unroll
                    for (int n = 0; n < 2; ++n) acc[a][b][m][n] = (f32x4){0.f, 0.f, 0.f, 0.f};
        cur = nxt; cA = nA; cB = nB; ++ui;
        if (wr == 1) PG8_BAR;
    }
    PG8_WAIT_V(0);
    PG8_BAR;
#undef PG8_SA
#undef PG8_SB
#undef PG8_STAGE
#undef PG8_LDA
#undef PG8_LDB
#undef PG8_MMA
#undef PG8_WAIT_V
#undef PG8_WAIT_L
#undef PG8_BAR
#undef PG8_SCHED
}

struct EpiInProj {
    bf16_t* P; const float* ssq; int pn_off;
    __device__ __forceinline__ void operator()(const f32x4 (&acc)[2][2][4][2], const Unit& u, int wr, int wc, int fr, int fq) const {
#pragma unroll
        for (int ai = 0; ai < 2; ++ai)
#pragma unroll
            for (int m = 0; m < 4; ++m) {
                const int row = u.pm * 256 + ai * 128 + wr * 64 + m * 16 + fr;
                const float rs = rsqrtf(ssq_total_q(ssq, row, fq) * (1.f / 1024.f) + 1e-6f);
#pragma unroll
                for (int bj = 0; bj < 2; ++bj) {
                    const int col = (u.pn + pn_off) * 256 + bj * 128 + wc * 32 + 8 * fq;
                    const f32x4 v0 = acc[ai][bj][m][0] * rs, v1 = acc[ai][bj][m][1] * rs;
                    u32x4 w; w.x = pk2(v0[0], v0[1]); w.y = pk2(v0[2], v0[3]); w.z = pk2(v1[0], v1[1]); w.w = pk2(v1[2], v1[3]);
                    *(u32x4*)(P + (size_t)row * NP + col) = w;
                }
            }
    }
};
struct EpiBranch {
    const bf16_t* P; float* Z; bf16_t* ZB;
    __device__ __forceinline__ void operator()(const f32x4 (&acc)[2][2][4][2], const Unit& u, int wr, int wc, int fr, int fq) const {
        const int n = u.pn >> 2, pn = u.pn & 3, pm = u.pm - n * NTM;
#pragma unroll
        for (int ai = 0; ai < 2; ++ai)
#pragma unroll
            for (int m = 0; m < 4; ++m) {
                const int row = pm * 256 + ai * 128 + wr * 64 + m * 16 + fr;
#pragma unroll
                for (int bj = 0; bj < 2; ++bj) {
                    const int col = pn * 256 + bj * 128 + wc * 32 + 8 * fq;
                    const u32x4 gw = *(const u32x4*)(P + (size_t)row * NP + OFF_GATE + n * 1024 + col);
                    float gt[8]; unpack8(gw, gt);
                    float v[8];
#pragma unroll
                    for (int j = 0; j < 4; ++j) { v[j] = sigmoidf_(gt[j]) * acc[ai][bj][m][0][j]; v[4 + j] = sigmoidf_(gt[4 + j]) * acc[ai][bj][m][1][j]; }
                    bf16_t* zp = ZB + (size_t)row * DM + col; (void)Z;
                    if (n != 0) { float zo[8]; unpack8(*(const u32x4*)zp, zo);
#pragma unroll
                        for (int j = 0; j < 8; ++j) v[j] += zo[j]; }
                    { u32x4 w; w.x = pk2(v[0], v[1]); w.y = pk2(v[2], v[3]); w.z = pk2(v[4], v[5]); w.w = pk2(v[6], v[7]); *(u32x4*)zp = w; }
                }
            }
    }
};
struct EpiResid {
    float* S; bf16_t* HN; const float* nw; float* ssq;
    __device__ __forceinline__ void operator()(const f32x4 (&acc)[2][2][4][2], const Unit& u, int wr, int wc, int fr, int fq) const {
#pragma unroll
        for (int ai = 0; ai < 2; ++ai)
#pragma unroll
            for (int m = 0; m < 4; ++m) {
                const int row = u.pm * 256 + ai * 128 + wr * 64 + m * 16 + fr;
                float ss = 0.f;
#pragma unroll
                for (int bj = 0; bj < 2; ++bj) {
                    const int col = u.pn * 256 + bj * 128 + wc * 32 + 8 * fq;
                    float* sp = S + (size_t)row * DM + col;
                    f32x4 s0 = *(const f32x4*)sp, s1 = *(const f32x4*)(sp + 4);
                    s0 += acc[ai][bj][m][0]; s1 += acc[ai][bj][m][1];
                    *(f32x4*)sp = s0; *(f32x4*)(sp + 4) = s1;
                    const f32x4 w0 = *(const f32x4*)(nw + col), w1 = *(const f32x4*)(nw + col + 4);
                    u32x4 w; w.x = pk2(s0[0] * w0[0], s0[1] * w0[1]); w.y = pk2(s0[2] * w0[2], s0[3] * w0[3]); w.z = pk2(s1[0] * w1[0], s1[1] * w1[1]); w.w = pk2(s1[2] * w1[2], s1[3] * w1[3]);
                    *(u32x4*)(HN + (size_t)row * DM + col) = w;
                    ss += (s0[0] * s0[0] + s0[1] * s0[1]) + (s0[2] * s0[2] + s0[3] * s0[3]) + (s1[0] * s1[0] + s1[1] * s1[1]) + (s1[2] * s1[2] + s1[3] * s1[3]);
                }
                ss += __shfl_xor(ss, 16); ss += __shfl_xor(ss, 32);
                if (fq == 0) ssq[(size_t)row * 16 + u.pn * 4 + wc] = ss;
            }
    }
};
struct EpiSwiglu {
    bf16_t* H; const float* ssq;
    __device__ __forceinline__ void operator()(const f32x4 (&acc)[2][2][4][2], const Unit& u, int wr, int wc, int fr, int fq) const {
#pragma unroll
        for (int ai = 0; ai < 2; ++ai)
#pragma unroll
            for (int m = 0; m < 4; ++m) {
                const int row = u.pm * 256 + ai * 128 + wr * 64 + m * 16 + fr;
                const float rs = rsqrtf(ssq_total_q(ssq, row, fq) * (1.f / 1024.f) + 1e-6f);
                float v[8];
#pragma unroll
                for (int n = 0; n < 2; ++n)
#pragma unroll
                    for (int j = 0; j < 4; ++j) { const float gg = acc[ai][0][m][n][j] * rs, uu = acc[ai][1][m][n][j] * rs; v[4 * n + j] = siluf_(gg) * uu; }
                u32x4 w; w.x = pk2(v[0], v[1]); w.y = pk2(v[2], v[3]); w.z = pk2(v[4], v[5]); w.w = pk2(v[6], v[7]);
                *(u32x4*)(H + (size_t)row * FF + u.pn * 128 + wc * 32 + 8 * fq) = w;
            }
    }
};
}

__device__ __forceinline__ bf16x8 ldfrag(const LAS bf16_t* p, int ld, int r, int q) { return *(const LAS bf16x8*)(p + r * ld + q * 8); }
__device__ __forceinline__ bf16x4 ldfrag4(const LAS bf16_t* p, int ld, int r, int q) { return *(const LAS bf16x4*)(p + r * ld + q * 4); }
__device__ __forceinline__ f32x4 mma32(bf16x8 a, bf16x8 b, f32x4 c) { return __builtin_amdgcn_mfma_f32_16x16x32_bf16(a, b, c, 0, 0, 0); }
__device__ __forceinline__ f32x4 mma16(bf16x4 a, bf16x4 b, f32x4 c) { return __builtin_amdgcn_mfma_f32_16x16x16bf16_1k(a, b, c, 0, 0, 0); }
__device__ __forceinline__ bf16x4 cvt4(f32x4 v) { u32x2 w; w.x = pk2(v[0], v[1]); w.y = pk2(v[2], v[3]); return __builtin_bit_cast(bf16x4, w); }
__device__ __forceinline__ bf16x8 scale8(bf16x8 x, const float* f) { const u32x4 w = __builtin_bit_cast(u32x4, x); float v[8]; unpack8(w, v); u32x4 o;
    o.x = pk2(v[0] * f[0], v[1] * f[1]); o.y = pk2(v[2] * f[2], v[3] * f[3]); o.z = pk2(v[4] * f[4], v[5] * f[5]); o.w = pk2(v[6] * f[6], v[7] * f[7]); return __builtin_bit_cast(bf16x8, o); }

struct KP { const float* in[30]; float* out; unsigned char* ws; };

__device__ __forceinline__ void tr_item(const float* W, int N, bf16_t* WT, int ldk, int k0, int n0, int dst_row0, LAS float* scr, int lane) {
#pragma unroll 8
    for (int i = 0; i < 32; ++i) { const int kk = 2 * i + (lane >> 5); const int n = n0 + (lane & 31); scr[kk * 33 + (lane & 31)] = (n < N) ? W[(size_t)(k0 + kk) * N + n] : 0.f; }
    LDS_WAIT(); asm volatile("" ::: "memory");
    const int c = lane & 7;
#pragma unroll
    for (int j = 0; j < 4; ++j) { const int n = (lane >> 3) + 8 * j; const LAS float* s = scr + (8 * c) * 33 + n;
        u32x4 o; o.x = pk2(s[0 * 33], s[1 * 33]); o.y = pk2(s[2 * 33], s[3 * 33]); o.z = pk2(s[4 * 33], s[5 * 33]); o.w = pk2(s[6 * 33], s[7 * 33]);
        if (n0 + n < N) *(u32x4*)(WT + (size_t)(dst_row0 + n) * ldk + k0 + 8 * c) = o; }
    LDS_WAIT(); asm volatile("" ::: "memory");
}
__device__ __forceinline__ void convert_layer(const KP& p, int l, LAS unsigned char* lds, int gw, int NGW, int wave, int lane) {
    asm volatile("" : "+v"(lane)); asm volatile("" : "+v"(wave)); wave = __builtin_amdgcn_readfirstlane(wave);
    LAS float* scr = (LAS float*)(lds + wave * 8448);
    bf16_t* win_t = (bf16_t*)(p.ws + WS_WIN); bf16_t* wing_t = (bf16_t*)(p.ws + WS_WING + (size_t)(l & 1) * WING_SIZE);
    unsigned char* sm = p.ws + WS_WSM + (size_t)(l & 1) * WSM_SIZE;
    bf16_t* br_t = (bf16_t*)(sm + WSM_BR); bf16_t* out_t = (bf16_t*)(sm + WSM_OUT); bf16_t* fi_t = (bf16_t*)(sm + WSM_FI); bf16_t* fo_t = (bf16_t*)(sm + WSM_FO);
    constexpr int NB_IN = (INW + 31) / 32;
    constexpr int I_IN = 16 * NB_IN, I_BR = 4 * 16 * 32, I_OUT = 16 * 32, I_FI = 16 * (2 * FF / 32), I_FO = (FF / 64) * 32;
    constexpr int NITEMS = I_IN + I_BR + I_OUT + I_FI + I_FO;
    for (int it = gw; it < NITEMS; it += NGW) {
        int r = it;
        if (r < I_IN) { const int kb = r / NB_IN, nb = r % NB_IN; const bool gt = nb >= GT0 * 8 && nb < (GT0 + GTN) * 8;
            tr_item(p.in[4] + (size_t)l * DM * INW, INW, gt ? wing_t : win_t, DM, kb * 64, nb * 32, gt ? nb * 32 - GT0 * 256 : nb * 32, scr, lane); continue; } r -= I_IN;
        if (r < I_BR) { const int n = r / 512, rr = r % 512, kb = rr / 32, nb = rr % 32; tr_item(p.in[25] + (size_t)(l * 4 + n) * DM * DM, DM, br_t, DM, kb * 64, nb * 32, n * 1024 + nb * 32, scr, lane); continue; } r -= I_BR;
        if (r < I_OUT) { const int kb = r / 32, nb = r % 32; tr_item(p.in[26] + (size_t)l * DM * DM, DM, out_t, DM, kb * 64, nb * 32, nb * 32, scr, lane); continue; } r -= I_OUT;
        if (r < I_FI) { const int nbn = 2 * FF / 32, kb = r / nbn, nb = r % nbn; const int c0 = nb * 32, bj = c0 / FF, j = c0 % FF, pn = j / 128, rr = j % 128;
            tr_item(p.in[27] + (size_t)l * DM * 2 * FF, 2 * FF, fi_t, DM, kb * 64, c0, 256 * pn + 128 * bj + rr, scr, lane); continue; } r -= I_FI;
        { const int kb = r / 32, nb = r % 32; tr_item(p.in[28] + (size_t)l * FF * DM, DM, fo_t, FF, kb * 64, nb * 32, nb * 32, scr, lane); }
    }
    if (l >= 1) {
        const float* Wv = p.in[4] + (size_t)l * DM * INW + 2048; const float* mu = p.in[5] + (size_t)l * 3328 + 2048; const float* v1 = p.in[12] + (size_t)(l - 1) * DM * 32;
        for (int k = gw; k < DM; k += NGW) {
            float wv[16], m1[16];
#pragma unroll
            for (int m = 0; m < 16; ++m) { const int c = lane + 64 * m; wv[m] = Wv[(size_t)k * INW + c]; m1[m] = mu[c]; }
            for (int j = 0; j < 32; ++j) {
                float e1 = 0.f, e2 = 0.f;
#pragma unroll
                for (int m = 0; m < 16; ++m) { const int c = lane + 64 * m; const float vv = v1[c * 32 + j] * wv[m]; e1 += vv * (1.f - m1[m]); e2 += vv * m1[m]; }
#pragma unroll
                for (int o = 1; o < 64; o <<= 1) { e1 += __shfl_xor(e1, o); e2 += __shfl_xor(e2, o); }
                if (lane == 0) { win_t[(size_t)(OFF_VLO + j) * DM + k] = (bf16_t)f2bf(e1); win_t[(size_t)(OFF_VLO + 32 + j) * DM + k] = (bf16_t)f2bf(e2); }
            }
        }
    }
}


constexpr int XLW = 320;
__device__ __forceinline__ void rwkv_lora_inputs(const KP& p, int l, int gw, int NGW, int lane) {
    const bf16_t* P = (const bf16_t*)(p.ws + WS_P); bf16_t* XLO = (bf16_t*)(p.ws + WS_Z);
    const float* mu = p.in[5] + (size_t)l * 3328 + 3072;
    float muv[4];
#pragma unroll
    for (int j = 0; j < 4; ++j) muv[j] = mu[lane + 64 * j];
    for (int m = gw; m < MMAIN + NMETA; m += NGW) {
        int prev; if (m < MMAIN) prev = ((m & (SEQ - 1)) == 0) ? MMAIN + NMETA - 1 : m - 1; else prev = (m == MMAIN) ? -1 : m - 1;
        const bf16_t* cr = P + (size_t)m * NP; const bf16_t* pr = P + (size_t)(prev < 0 ? m : prev) * NP; const float pz = prev < 0 ? 0.f : 1.f;
        float cur[4], prv[4];
#pragma unroll
        for (int j = 0; j < 4; ++j) { cur[j] = bf2f(cr[3072 + lane + 64 * j]); prv[j] = pz * bf2f(pr[3072 + lane + 64 * j]); }
        float vl = 0.f; if (lane < 32) vl = bf2f(cr[OFF_VLO + lane]) + pz * bf2f(pr[OFF_VLO + 32 + lane]);
        bf16_t* o = XLO + (size_t)m * XLW;
#pragma unroll
        for (int j = 0; j < 4; ++j) { const float val = cur[j] + (prv[j] - cur[j]) * muv[j]; float r_;
            if (j == 0) { const float e2 = __expf(2.f * val); r_ = 1.f - 2.f * __builtin_amdgcn_rcpf(e2 + 1.f); } else if (j == 1) r_ = val; else r_ = __builtin_amdgcn_rcpf(1.f + __expf(-val));
            o[lane + 64 * j] = (bf16_t)f2bf(r_); }
        if (lane < 32) o[256 + lane] = (bf16_t)f2bf(vl);
    }
}

__device__ __forceinline__ void rwkv_unit(const KP& p, int l, int b, int h, LAS unsigned char* lds, const int WAVE_U) {
    int tid = TIDX; asm volatile("" : "+v"(tid)); const int wave = __builtin_amdgcn_readfirstlane(tid >> 6); int lane = tid & 63, r = lane & 15, q = lane >> 4;
#define RELAUNDER() do { asm volatile("" : "+v"(tid)); lane = tid & 63; r = lane & 15; q = lane >> 4; l32 = lane & 31; thalf = lane >> 5; } while (0)
    const bf16_t* P = (const bf16_t*)(p.ws + WS_P);
    bf16_t* YS = (bf16_t*)(p.ws + WS_YS);
    bf16_t* VFG = (bf16_t*)(p.ws + WS_VF); const bf16_t* XLO = (const bf16_t*)(p.ws + WS_Z);
    const float* mu = p.in[5] + (size_t)l * 3328;
    const float* vec = p.in[9] + (size_t)l * 6 * DM;
    const float* rk = p.in[10] + (size_t)l * DM;
    const float* v0 = (l >= 1) ? p.in[11] + (size_t)(l - 1) * DM : nullptr;
    LAS bf16_t* W2T = (LAS bf16_t*)(lds + 0); LAS bf16_t* A2T = (LAS bf16_t*)(lds + 9216); LAS bf16_t* G2T = (LAS bf16_t*)(lds + 18432); LAS bf16_t* V2T = (LAS bf16_t*)(lds + 35840);
    LAS float* MU = (LAS float*)(lds + 40960); LAS float* W0L = (LAS float*)(lds + 42752); LAS float* A0L = W0L + 64; LAS float* V0L = A0L + 64;
    LAS float* BON = (LAS float*)(lds + 43520); LAS float* PC = (LAS float*)(lds + 43648);
    LAS float* RM = (LAS float*)(lds + 44160); LAS float* KM = RM + 2048; LAS float* VM = KM + 2048; LAS float* WD = VM + 2048; LAS float* AG = WD + 2048; LAS float* VG = AG + 2048; LAS float* GL = VG + 2048;
    LAS float* YY = RM; LAS float* KPp = KM; LAS float* VPp = VM; LAS float* APp = AG; LAS float* BPp = VG;
    constexpr int REG = 101504; constexpr int TS = 20;
    LAS bf16_t* RAW = (LAS bf16_t*)(lds + REG);
    LAS bf16_t* XW = (LAS bf16_t*)(lds + 140048); LAS bf16_t* XA = (LAS bf16_t*)(lds + 144656); LAS bf16_t* XG = (LAS bf16_t*)(lds + 149264); LAS bf16_t* XV = (LAS bf16_t*)(lds + 157968);
    constexpr int O_AT = 0, O_RT = 2304, O_BT = 4608, O_KT = 6912, O_BH = 9216, O_KH = 12288, O_VT = 15360, O_MAB = 18432, O_TT = 19712, OPB = 20480;
    { const float* w2g = p.in[6] + (size_t)l * 64 * DM + 64 * h; const float* a2g = p.in[7] + (size_t)l * 64 * DM + 64 * h; const float* g2g = p.in[8] + (size_t)l * 128 * DM + 64 * h;
      for (int idx = tid; idx < 64 * 64; idx += 512) { const int k = idx >> 6, n = idx & 63; W2T[n * 72 + k] = (bf16_t)f2bf(w2g[k * DM + n]); A2T[n * 72 + k] = (bf16_t)f2bf(a2g[k * DM + n]); }
      for (int idx = tid; idx < 128 * 64; idx += 512) { const int k = idx >> 6, n = idx & 63; G2T[n * 136 + k] = (bf16_t)f2bf(g2g[k * DM + n]); }
      if (l >= 1) { const float* v2g = p.in[13] + (size_t)(l - 1) * 32 * DM + 64 * h; for (int idx = tid; idx < 32 * 64; idx += 512) { const int k = idx >> 6, n = idx & 63; V2T[n * 40 + k] = (bf16_t)f2bf(v2g[k * DM + n]); } } }
    if (tid < 192) MU[tid] = mu[(tid >> 6) * 1024 + 64 * h + (tid & 63)];
    if (tid < 64) { W0L[tid] = vec[64 * h + tid]; A0L[tid] = vec[DM + 64 * h + tid]; V0L[tid] = l >= 1 ? v0[64 * h + tid] : 0.f; }
    f32x4 sT[4];
#pragma unroll
    for (int i = 0; i < 4; ++i) sT[i] = (f32x4){0.f, 0.f, 0.f, 0.f};
    int l32 = lane & 31, thalf = lane >> 5; const int hc0 = 64 * h + l32, hc1 = hc0 + 32;
    const float kk_c0 = vec[2 * DM + hc0], ka_c0 = vec[3 * DM + hc0], lnw_c0 = vec[4 * DM + hc0], lnb_c0 = vec[5 * DM + hc0], rk_c0 = rk[hc0];
    const float kk_c1 = vec[2 * DM + hc1], ka_c1 = vec[3 * DM + hc1], lnw_c1 = vec[4 * DM + hc1], lnb_c1 = vec[5 * DM + hc1], rk_c1 = rk[hc1];
    auto trow = [&](int t) -> size_t { return (size_t)row_of(b, t < 0 ? 0 : (t >= TT ? TT - 1 : t)); };
    constexpr int RS = 264;
    const int ra0 = tid, ra1 = tid + 512; const int rr0 = ra0 / 24, pc0 = ra0 % 24, rr1 = ra1 / 24, pc1 = ra1 % 24;
    const int gc0 = (pc0 >> 3) * 1024 + 64 * h + 8 * (pc0 & 7), gc1 = (pc1 >> 3) * 1024 + 64 * h + 8 * (pc1 & 7);
    int xtok[3], xpc[3], xdst[3];
#pragma unroll
    for (int j = 0; j < 3; ++j) { const int xa = tid + 512 * j; xtok[j] = xa / 36; xpc[j] = xa % 36; const int pc = xpc[j], tk = xtok[j];
        xdst[j] = pc < 8 ? 140048 + (tk * 72 + 8 * pc) * 2 : (pc < 16 ? 144656 + (tk * 72 + 8 * (pc - 8)) * 2 : (pc < 32 ? 149264 + (tk * 136 + 8 * (pc - 16)) * 2 : 157968 + (tk * 40 + 8 * (pc - 32)) * 2)); }
    u32x4 pfa0, pfa1, pfv, pfx0, pfx1, pfx2;
#define RWKV_PREFETCH(pn) do { const int t0_ = 32 * (pn) - 1; \
        pfa0 = *(const u32x4*)(P + trow(t0_ + rr0) * NP + gc0); if (t0_ + rr0 < 0) pfa0 = (u32x4){0u, 0u, 0u, 0u}; \
        if (ra1 < 792) pfa1 = *(const u32x4*)(P + trow(t0_ + rr1) * NP + gc1); \
        if (tid < 256) pfv = *(const u32x4*)(VFG + trow(t0_ + 1 + (tid >> 3)) * DM + 64 * h + 8 * (tid & 7)); \
        pfx0 = *(const u32x4*)(XLO + trow(t0_ + 1 + xtok[0]) * XLW + 8 * xpc[0]); pfx1 = *(const u32x4*)(XLO + trow(t0_ + 1 + xtok[1]) * XLW + 8 * xpc[1]); \
        if (tid < 128) pfx2 = *(const u32x4*)(XLO + trow(t0_ + 1 + xtok[2]) * XLW + 8 * xpc[2]); } while (0)
    pfa1 = (u32x4){0u, 0u, 0u, 0u}; pfv = pfa1; pfx2 = pfa1;
    RWKV_PREFETCH(0);
    __syncthreads();
    for (int pp = 0; pp < 129; ++pp) {
        *(LAS u32x4*)(RAW + rr0 * RS + 8 * pc0) = pfa0;
        if (ra1 < 792) *(LAS u32x4*)(RAW + rr1 * RS + 8 * pc1) = pfa1;
        if (tid < 256) *(LAS u32x4*)(RAW + (1 + (tid >> 3)) * RS + 192 + 8 * (tid & 7)) = pfv;
        *(LAS u32x4*)(lds + xdst[0]) = pfx0; *(LAS u32x4*)(lds + xdst[1]) = pfx1; if (tid < 128) *(LAS u32x4*)(lds + xdst[2]) = pfx2;
        if (pp + 1 < 129) RWKV_PREFETCH(pp + 1);
        BAR_LDS();
        RELAUNDER();
        typedef float f32x2 __attribute__((ext_vector_type(2)));
        { unsigned cwv[6], pwv[6]; f32x2 m2v[3];
#pragma unroll
          for (int pj = 0; pj < 6; ++pj) { const int grp = pj % 3, i = 4 * wave + 2 * (pj / 3) + thalf, col = 64 * grp + 2 * l32;
              cwv[pj] = *(const LAS unsigned*)(RAW + (i + 1) * RS + col); pwv[pj] = *(const LAS unsigned*)(RAW + i * RS + col); if (pj < 3) m2v[pj] = *(const LAS f32x2*)(MU + col); }
#pragma unroll
          for (int pj = 0; pj < 6; ++pj) { const int grp = pj % 3, i = 4 * wave + 2 * (pj / 3) + thalf;
              const unsigned cw = cwv[pj], pw = pwv[pj]; const f32x2 m2 = m2v[grp];
              const float c0 = __builtin_bit_cast(float, cw << 16), c1 = __builtin_bit_cast(float, cw & 0xffff0000u), p0 = __builtin_bit_cast(float, pw << 16), p1 = __builtin_bit_cast(float, pw & 0xffff0000u);
              LAS float* dst = grp == 0 ? RM : (grp == 1 ? KM : VM); *(LAS f32x2*)(dst + i * 64 + 2 * l32) = (f32x2){c0 + (p0 - c0) * m2.x, c1 + (p1 - c1) * m2.y}; } }
        RELAUNDER();
        { auto s2_tile = [&](int which, int mt, int nt) { f32x4 acc = (f32x4){0.f, 0.f, 0.f, 0.f};
            if (which == 0) { acc = mma32(ldfrag(XW + 16 * mt * 72, 72, r, q), ldfrag(W2T + nt * 16 * 72, 72, r, q), acc); acc = mma32(ldfrag(XW + 16 * mt * 72 + 32, 72, r, q), ldfrag(W2T + nt * 16 * 72 + 32, 72, r, q), acc); }
            else if (which == 1) { acc = mma32(ldfrag(XA + 16 * mt * 72, 72, r, q), ldfrag(A2T + nt * 16 * 72, 72, r, q), acc); acc = mma32(ldfrag(XA + 16 * mt * 72 + 32, 72, r, q), ldfrag(A2T + nt * 16 * 72 + 32, 72, r, q), acc); }
            else if (which == 2) {
#pragma unroll
                for (int ks = 0; ks < 4; ++ks) acc = mma32(ldfrag(XG + 16 * mt * 136 + 32 * ks, 136, r, q), ldfrag(G2T + nt * 16 * 136 + 32 * ks, 136, r, q), acc); }
            else { acc = mma32(ldfrag(XV + 16 * mt * 40, 40, r, q), ldfrag(V2T + nt * 16 * 40, 40, r, q), acc); }
            const int cc = 16 * nt + r;
#pragma unroll
            for (int j = 0; j < 4; ++j) { const int tok = 16 * mt + 4 * q + j; const float x = acc[j];
                if (which == 0) { const float ex = __expf(-(W0L[cc] + x)); WD[tok * 64 + cc] = __expf(-0.6065306597f * __builtin_amdgcn_rcpf(1.f + ex)); }
                else if (which == 1) AG[tok * 64 + cc] = __builtin_amdgcn_rcpf(1.f + __expf(-(A0L[cc] + x)));
                else if (which == 2) GL[tok * 64 + cc] = x;
                else VG[tok * 64 + cc] = __builtin_amdgcn_rcpf(1.f + __expf(-(V0L[cc] + x))); } };
          if (wave < 4) { const int which = wave >> 1;
#pragma unroll
              for (int mt = 0; mt < 2; ++mt)
#pragma unroll
                  for (int tnt = 0; tnt < 2; ++tnt) s2_tile(which, mt, 2 * (wave & 1) + tnt); }
          else { const int mtg = (wave - 4) >> 1;
#pragma unroll
              for (int tnt = 0; tnt < 2; ++tnt) s2_tile(2, mtg, 2 * (wave & 1) + tnt);
              if (l >= 1) {
#pragma unroll
                  for (int tnt = 0; tnt < 2; ++tnt) s2_tile(3, mtg, 2 * (wave & 1) + tnt); } } }
        BAR_LDS();
        RELAUNDER();
#pragma unroll
        for (int rep = 0; rep < 2; ++rep) { const int tok = 4 * wave + 2 * rep + thalf, e0 = tok * 64 + l32, e1 = e0 + 32;
          const float k0 = KM[e0], k1 = KM[e1], a0 = AG[e0], a1 = AG[e1], vv0 = VM[e0], vv1 = VM[e1], r0 = RM[e0], r1 = RM[e1];
          float kka = k0 * kk_c0, kkb = k1 * kk_c1; float n2 = kka * kka + kkb * kkb;
          const float kp0 = k0 * (1.f + (a0 - 1.f) * ka_c0), kp1 = k1 * (1.f + (a1 - 1.f) * ka_c1);
          float bo = r0 * kp0 * rk_c0 + r1 * kp1 * rk_c1;
          n2 = half_sum32(n2); bo = half_sum32(bo);
          const float inv = rsqrtf(fmaxf(n2, 1e-24f)); kka *= inv; kkb *= inv;
          float vp0 = vv0, vp1 = vv1;
          if (l >= 1) { vp0 = vv0 + (bf2f(RAW[(tok + 1) * RS + 192 + l32]) - vv0) * VG[e0]; vp1 = vv1 + (bf2f(RAW[(tok + 1) * RS + 224 + l32]) - vv1) * VG[e1]; }
          KPp[e0] = kp0; KPp[e1] = kp1; VPp[e0] = vp0; VPp[e1] = vp1; APp[e0] = -kka; APp[e1] = -kkb; BPp[e0] = kka * a0; BPp[e1] = kkb * a1; if (l32 == 0) BON[tok] = bo;
          const int t = 32 * pp + tok;
          if (l == 0 && t < TT) { bf16_t* vf = VFG + (size_t)row_of(b, t) * DM; vf[hc0] = (bf16_t)f2bf(vv0); vf[hc1] = (bf16_t)f2bf(vv1); } }
        BAR_LDS();
        RELAUNDER();
        { const int ch = wave >> 2, i0 = 4 * (wave & 3); LAS unsigned char* ob = lds + REG + ch * OPB;
          LAS bf16_t* AT_ = (LAS bf16_t*)(ob + O_AT); LAS bf16_t* RT_ = (LAS bf16_t*)(ob + O_RT); LAS bf16_t* BTl = (LAS bf16_t*)(ob + O_BT); LAS bf16_t* KTl = (LAS bf16_t*)(ob + O_KT);
          LAS bf16_t* BHt = (LAS bf16_t*)(ob + O_BH); LAS bf16_t* KHt = (LAS bf16_t*)(ob + O_KH); LAS bf16_t* VTt = (LAS bf16_t*)(ob + O_VT);
          float Pv[5]; float run = 1.f;
          const LAS float* wdp = WD + 16 * ch * 64 + lane;
          for (int j = 0; j < i0; ++j) run *= wdp[j * 64];
          Pv[0] = run;
#pragma unroll
          for (int tt = 0; tt < 4; ++tt) { run *= wdp[(i0 + tt) * 64]; Pv[1 + tt] = run; }
          for (int j = i0 + 4; j < 16; ++j) run *= wdp[j * 64];
          const float Pall = run;
          float av[4], bv[4], kv[4], rv[4], vv[4];
#pragma unroll
          for (int tt = 0; tt < 4; ++tt) { const int e = (16 * ch + i0 + tt) * 64 + lane; av[tt] = APp[e]; bv[tt] = BPp[e]; kv[tt] = KPp[e]; rv[tt] = RM[e]; vv[tt] = VPp[e]; }
#pragma unroll
          for (int tt = 0; tt < 4; ++tt) { const int i = i0 + tt; const float Pi = Pv[1 + tt], Pp = Pv[tt]; const float ip = __builtin_amdgcn_rcpf(Pi), hp = Pall * ip;
              AT_[i * 72 + lane] = (bf16_t)f2bf(av[tt] * Pp); RT_[i * 72 + lane] = (bf16_t)f2bf(rv[tt] * Pi); BTl[i * 72 + lane] = (bf16_t)f2bf(bv[tt] * ip); KTl[i * 72 + lane] = (bf16_t)f2bf(kv[tt] * ip);
              BHt[lane * TS + i] = (bf16_t)f2bf(bv[tt] * hp); KHt[lane * TS + i] = (bf16_t)f2bf(kv[tt] * hp); VTt[lane * TS + i] = (bf16_t)f2bf(vv[tt]); }
          if ((wave & 3) == 0) PC[ch * 64 + lane] = Pall; }
        BAR_LDS();
        RELAUNDER();
        bf16x4 nrb4, rhs4, v4; f32x4 Y;
#define RWKV_PRE(ch) do { LAS unsigned char* ob = lds + REG + (ch) * OPB; \
            const LAS bf16_t* AT_ = (const LAS bf16_t*)(ob + O_AT); const LAS bf16_t* RT_ = (const LAS bf16_t*)(ob + O_RT); const LAS bf16_t* BTl = (const LAS bf16_t*)(ob + O_BT); const LAS bf16_t* KTl = (const LAS bf16_t*)(ob + O_KT); \
            const LAS bf16_t* VTt = (const LAS bf16_t*)(ob + O_VT); \
            f32x4 mk = (f32x4){0.f, 0.f, 0.f, 0.f}, nb = mk, nk = mk; \
            _Pragma("unroll") for (int ks = 0; ks < 2; ++ks) { const bf16x8 fa = ldfrag(AT_ + 32 * ks, 72, r, q), fr_ = ldfrag(RT_ + 32 * ks, 72, r, q), fb = ldfrag(BTl + 32 * ks, 72, r, q), fk = ldfrag(KTl + 32 * ks, 72, r, q); \
                mk = mma32(fk, fa, mk); nb = mma32(fb, fr_, nb); nk = mma32(fk, fr_, nk); } \
            _Pragma("unroll") for (int j = 0; j < 4; ++j) { const int s_ = 4 * q + j; if (!(s_ < r)) mk[j] = 0.f; if (!(s_ <= r)) { nb[j] = 0.f; nk[j] = 0.f; } } \
            const bf16x4 mak4 = cvt4(mk), nrk4 = cvt4(nk); nrb4 = cvt4(nb); \
            v4 = ldfrag4(VTt + 16 * wave * TS, TS, r, q); \
            bf16x4 sb[4]; \
            _Pragma("unroll") for (int kt = 0; kt < 4; ++kt) sb[kt] = cvt4(sT[kt]); \
            f32x4 RHS = (f32x4){0.f, 0.f, 0.f, 0.f}; Y = RHS; \
            RHS = mma16(mak4, v4, RHS); Y = mma16(nrk4, v4, Y); \
            _Pragma("unroll") for (int kt = 0; kt < 4; ++kt) { RHS = mma16(ldfrag4(AT_ + 16 * kt, 72, r, q), sb[kt], RHS); Y = mma16(ldfrag4(RT_ + 16 * kt, 72, r, q), sb[kt], Y); } \
            rhs4 = cvt4(RHS); } while (0)
#define RWKV_FIN(ch) do { LAS unsigned char* ob = lds + REG + (ch) * OPB; \
            const LAS bf16_t* BHt = (const LAS bf16_t*)(ob + O_BH); const LAS bf16_t* KHt = (const LAS bf16_t*)(ob + O_KH); const LAS bf16_t* TTm = (const LAS bf16_t*)(ob + O_TT); \
            f32x4 U = (f32x4){0.f, 0.f, 0.f, 0.f}; U = mma16(ldfrag4(TTm, 24, r, q), rhs4, U); \
            const bf16x4 ub = cvt4(U); \
            Y = mma16(nrb4, ub, Y); \
            _Pragma("unroll") for (int j = 0; j < 4; ++j) YY[(16 * (ch) + 4 * q + j) * 64 + 16 * wave + r] = Y[j]; \
            _Pragma("unroll") for (int kt = 0; kt < 4; ++kt) { const f32x4 pc4 = *(const LAS f32x4*)(PC + (ch) * 64 + 16 * kt + 4 * q); f32x4 s_ = sT[kt] * pc4; \
                s_ = mma16(ldfrag4(BHt + 16 * kt * TS, TS, r, q), ub, s_); s_ = mma16(ldfrag4(KHt + 16 * kt * TS, TS, r, q), v4, s_); sT[kt] = s_; } } while (0)
        if (wave == 4 || wave == 5) { LAS unsigned char* ob = lds + REG + (wave - 4) * OPB;
            const LAS bf16_t* AT_ = (const LAS bf16_t*)(ob + O_AT); const LAS bf16_t* BTl = (const LAS bf16_t*)(ob + O_BT); LAS bf16_t* TTm = (LAS bf16_t*)(ob + O_TT);
            const f32x4 z4 = (f32x4){0.f, 0.f, 0.f, 0.f}; f32x4 n = z4, nt = z4, eye;
#pragma unroll
            for (int ks = 0; ks < 2; ++ks) { const bf16x8 fa = ldfrag(AT_ + 32 * ks, 72, r, q), fb = ldfrag(BTl + 32 * ks, 72, r, q); n = mma32(fa, fb, n); nt = mma32(fb, fa, nt); }
#pragma unroll
            for (int j = 0; j < 4; ++j) { const int i_ = 4 * q + j; if (!(r < i_)) n[j] = 0.f; if (!(i_ < r)) nt[j] = 0.f; eye[j] = (i_ == r) ? 1.f : 0.f; }
            const bf16x4 nB = cvt4(n), nA = cvt4(nt);
            const f32x4 n2 = mma16(nA, nB, z4), n2t = mma16(nB, nA, z4); const bf16x4 n2B = cvt4(n2), n2A = cvt4(n2t);
            const f32x4 n4 = mma16(n2A, n2B, z4), n4t = mma16(n2B, n2A, z4); const bf16x4 n4B = cvt4(n4), n4A = cvt4(n4t);
            const f32x4 n3 = mma16(nA, n2B, z4), n3t = mma16(n2B, nA, z4);
            const f32x4 n8 = mma16(n4A, n4B, z4); const f32x4 n12 = mma16(n4A, cvt4(n8), z4);
            const f32x4 p1 = ((eye + n) + (n2 + n3)), p1t = ((eye + nt) + (n2t + n3t)), rr = (n4 + n8) + n12;
            const f32x4 tt = mma16(cvt4(p1t), cvt4(rr), p1);
#pragma unroll
            for (int j = 0; j < 4; ++j) TTm[(4 * q + j) * 24 + r] = (bf16_t)f2bf(tt[j]); }
        else if (wave < 4) RWKV_PRE(0);
        BAR_LDS();
        RELAUNDER();
        if (wave < 4) { RWKV_FIN(0); RWKV_PRE(1); RWKV_FIN(1); }
        BAR_LDS();
#undef RWKV_PRE
#undef RWKV_FIN
        RELAUNDER();
#pragma unroll
        for (int rep = 0; rep < 2; ++rep) { const int tok = 4 * wave + 2 * rep + thalf, e0 = tok * 64 + l32, e1 = e0 + 32; const float y0 = YY[e0], y1 = YY[e1];
          float s1 = y0 + y1, s2 = y0 * y0 + y1 * y1;
          s1 = half_sum32(s1); s2 = half_sum32(s2);
          const float mean = s1 * (1.f / 64.f), var = fmaxf(s2 * (1.f / 64.f) - mean * mean, 0.f), rs = rsqrtf(var + 64e-5f), bon = BON[tok];
          const float o0 = ((y0 - mean) * rs * lnw_c0 + lnb_c0 + bon * VPp[e0]) * GL[e0], o1 = ((y1 - mean) * rs * lnw_c1 + lnb_c1 + bon * VPp[e1]) * GL[e1];
          const int t = 32 * pp + tok;
          if (t < TT) { bf16_t* yo = YS + (size_t)row_of(b, t) * DM; yo[hc0] = (bf16_t)f2bf(o0); yo[hc1] = (bf16_t)f2bf(o1); } }
    }
#undef RWKV_PREFETCH
#undef RELAUNDER
    __syncthreads();
}

__device__ __forceinline__ int swz72(int row, int chunk) { return row * 72 + (((chunk ^ (row >> 3)) & 7) << 3); }
__device__ __forceinline__ void ssd_unit(const KP& p, int l, int b, int g, LAS unsigned char* lds, const int WAVE_U) {
    int tid = TIDX; asm volatile("" : "+v"(tid)); const int wave = __builtin_amdgcn_readfirstlane(tid >> 6); int lane = tid & 63, r = lane & 15, q = lane >> 4;
#define RELAUNDER() do { asm volatile("" : "+v"(tid)); lane = tid & 63; r = lane & 15; q = lane >> 4; } while (0)
    const bf16_t* P = (const bf16_t*)(p.ws + WS_P);
    bf16_t* YS1 = (bf16_t*)(p.ws + WS_YS) + (size_t)1 * MP * DM;
    const float* conv_w = p.in[14] + (size_t)l * 4 * 2048; const float* conv_b = p.in[15] + (size_t)l * 2048;
    const float* dt_bias = p.in[16] + l * 16; const float* a_log = p.in[17] + l * 16; const float* dsk = p.in[18] + l * 16; const float* normw = p.in[19] + (size_t)l * DM;
    LAS bf16_t* Cm = (LAS bf16_t*)(lds + 0); LAS bf16_t* Bm = (LAS bf16_t*)(lds + 17408); LAS bf16_t* BT = (LAS bf16_t*)(lds + 34816); LAS bf16_t* CB = (LAS bf16_t*)(lds + 53248);
    LAS bf16_t* XT = (LAS bf16_t*)(lds + 62464); LAS float* ACU = (LAS float*)(lds + 99328); LAS float* DTV = (LAS float*)(lds + 100352); LAS float* RED = (LAS float*)(lds + 101376); LAS bf16_t* YL = (LAS bf16_t*)(lds + 103424); (void)RED;
    const int e = wave >> 1, ptb = 2 * (wave & 1);
    f32x4 st[8][2];
#pragma unroll
    for (int i = 0; i < 8; ++i) { st[i][0] = (f32x4){0.f, 0.f, 0.f, 0.f}; st[i][1] = (f32x4){0.f, 0.f, 0.f, 0.f}; }
    const float De = dsk[4 * g + e];
    unsigned short dtraw = 0;
#define SSD_DT_PREFETCH(cn) do { if (tid < 256) { const int t = 64 * (cn) - 48 + (tid & 63); dtraw = P[(size_t)row_of(b, t >= 0 ? t : 0) * NP + OFF_SSM + 3072 + 4 * g + (tid >> 6)]; } } while (0)
    SSD_DT_PREFETCH(0);
    for (int c = 0; c < 65; ++c) {
        RELAUNDER();
        if (tid < 256) { const int ee = wave, t = 64 * c - 48 + lane; float dtv = 0.f;
            if (t >= 0) dtv = softplusf_(bf2f(dtraw) + dt_bias[4 * g + ee]);
            float a = -dtv * __expf(a_log[4 * g + ee]);
#pragma unroll
            for (int off = 1; off < 64; off <<= 1) { const float v = __shfl_up(a, off); if (lane >= off) a += v; }
            ACU[ee * 64 + lane] = a; DTV[ee * 64 + lane] = dtv; }
        { const int cgp = tid & 63, tg = tid >> 6;
          const int xbc_idx = cgp < 32 ? 256 * g + 8 * cgp : (cgp < 48 ? 1024 + 128 * g + 8 * (cgp - 32) : 1536 + 128 * g + 8 * (cgp - 48));
          const int pcol = OFF_SSM + 1024 + xbc_idx;
          typedef float f32x2 __attribute__((ext_vector_type(2)));
          f32x2 cw0[4], cw1[4], cw2[4], cw3[4], cb[4]; u32x4 raw[11]; unsigned pk[8][4];
          const int i0 = 8 * tg, t0 = 64 * c - 48 + i0;
#pragma unroll
          for (int j = 0; j < 11; ++j) { const int t = t0 - 3 + j; raw[j] = *(const u32x4*)(P + (size_t)row_of(b, t >= 0 ? t : 0) * NP + pcol); if (t < 0) raw[j] = (u32x4){0u, 0u, 0u, 0u}; }
#pragma unroll
          for (int m = 0; m < 4; ++m) { cw0[m] = *(const f32x2*)(conv_w + xbc_idx + 2 * m); cw1[m] = *(const f32x2*)(conv_w + 2048 + xbc_idx + 2 * m); cw2[m] = *(const f32x2*)(conv_w + 4096 + xbc_idx + 2 * m);
              cw3[m] = *(const f32x2*)(conv_w + 6144 + xbc_idx + 2 * m); cb[m] = *(const f32x2*)(conv_b + xbc_idx + 2 * m); }
#define UNPK2(RW, VV) do { const u32x4 rw_ = (RW); VV[0] = (f32x2){__builtin_bit_cast(float, rw_[0] << 16), __builtin_bit_cast(float, rw_[0] & 0xffff0000u)}; VV[1] = (f32x2){__builtin_bit_cast(float, rw_[1] << 16), __builtin_bit_cast(float, rw_[1] & 0xffff0000u)}; \
                           VV[2] = (f32x2){__builtin_bit_cast(float, rw_[2] << 16), __builtin_bit_cast(float, rw_[2] & 0xffff0000u)}; VV[3] = (f32x2){__builtin_bit_cast(float, rw_[3] << 16), __builtin_bit_cast(float, rw_[3] & 0xffff0000u)}; } while (0)
          f32x2 x0[4], x1[4], x2[4];
          UNPK2(raw[0], x0); UNPK2(raw[1], x1); UNPK2(raw[2], x2);
#pragma unroll
          for (int i2 = 0; i2 < 4; ++i2) { f32x2 oa[4], ob[4];
#pragma unroll
              for (int hh = 0; hh < 2; ++hh) { const int ii = 2 * i2 + hh, t = t0 + ii; f32x2 x3[4];
                  UNPK2(raw[ii + 3], x3);
#pragma unroll
                  for (int m = 0; m < 4; ++m) { const f32x2 z = cb[m] + cw0[m] * x0[m] + cw1[m] * x1[m] + cw2[m] * x2[m] + cw3[m] * x3[m]; f32x2 o;
                      o.x = z.x * __builtin_amdgcn_rcpf(1.f + __expf(-z.x)); o.y = z.y * __builtin_amdgcn_rcpf(1.f + __expf(-z.y)); if (t < 0) o = (f32x2){0.f, 0.f};
                      if (hh == 0) oa[m] = o; else ob[m] = o;
                      x0[m] = x1[m]; x1[m] = x2[m]; x2[m] = x3[m]; }
                  if (cgp >= 32) { const f32x2* o = hh == 0 ? oa : ob; u32x4 w; w.x = pk2(o[0].x, o[0].y); w.y = pk2(o[1].x, o[1].y); w.z = pk2(o[2].x, o[2].y); w.w = pk2(o[3].x, o[3].y);
                      if (cgp < 48) *(LAS u32x4*)(Bm + (i0 + ii) * 136 + 8 * (cgp - 32)) = w; else *(LAS u32x4*)(Cm + (i0 + ii) * 136 + 8 * (cgp - 48)) = w; } }
#pragma unroll
              for (int m = 0; m < 4; ++m) { pk[2 * m][i2] = pk2(oa[m].x, ob[m].x); pk[2 * m + 1][i2] = pk2(oa[m].y, ob[m].y); } }
#undef UNPK2
          if (cgp < 48) { LAS bf16_t* dstT = cgp < 32 ? XT : BT; const int rb = cgp < 32 ? 8 * cgp : 8 * (cgp - 32);
#pragma unroll
              for (int k = 0; k < 8; ++k) *(LAS u32x4*)(dstT + swz72(rb + k, tg)) = (u32x4){pk[k][0], pk[k][1], pk[k][2], pk[k][3]}; } }
        BAR_LDS();
        RELAUNDER();
        { const int mt = wave & 3;
#pragma unroll
          for (int tn = 0; tn < 2; ++tn) { const int nt = 2 * (wave >> 2) + tn; f32x4 acc = (f32x4){0.f, 0.f, 0.f, 0.f};
#pragma unroll
              for (int ks = 0; ks < 4; ++ks) acc = mma32(ldfrag(Cm + 16 * mt * 136 + 32 * ks, 136, r, q), ldfrag(Bm + 16 * nt * 136 + 32 * ks, 136, r, q), acc);
#pragma unroll
              for (int j = 0; j < 4; ++j) CB[(16 * mt + 4 * q + j) * 72 + 16 * nt + r] = (bf16_t)f2bf(acc[j]); } }
        BAR_LDS();
        RELAUNDER();
        SSD_DT_PREFETCH(c + 1 < 65 ? c + 1 : 64);
        f32x4 acc1[4][2];
#pragma unroll
        for (int lt = 0; lt < 4; ++lt) { acc1[lt][0] = (f32x4){0.f, 0.f, 0.f, 0.f}; acc1[lt][1] = acc1[lt][0]; }
        const LAS float* acu = ACU + e * 64; const LAS float* dtv = DTV + e * 64;
#pragma unroll
        for (int nt = 0; nt < 8; ++nt) { const bf16x4 sb0 = cvt4(st[nt][0]), sb1 = cvt4(st[nt][1]);
#pragma unroll
            for (int lt = 0; lt < 4; ++lt) { const bf16x4 a4 = ldfrag4(Cm + 16 * lt * 136 + 16 * nt, 136, r, q); acc1[lt][0] = mma16(a4, sb0, acc1[lt][0]); acc1[lt][1] = mma16(a4, sb1, acc1[lt][1]); }
            __builtin_amdgcn_sched_barrier(0); }
#pragma unroll
        for (int lt = 0; lt < 4; ++lt)
#pragma unroll
            for (int j = 0; j < 4; ++j) { const float ea = __expf(acu[16 * lt + 4 * q + j]); acc1[lt][0][j] *= ea; acc1[lt][1][j] *= ea; }
#pragma unroll
        for (int lt = 0; lt < 4; ++lt)
#pragma unroll
            for (int ks = 0; ks < 2; ++ks) { if (ks == 1 && lt < 2) continue;
                const bf16x8 fr0 = ldfrag(CB + 16 * lt * 72 + 32 * ks, 72, r, q); const int ll = 16 * lt + r; const float al = acu[ll]; float f[8];
                const f32x4 ac0 = *(const LAS f32x4*)(acu + 32 * ks + 8 * q), ac1 = *(const LAS f32x4*)(acu + 32 * ks + 8 * q + 4), dt0 = *(const LAS f32x4*)(dtv + 32 * ks + 8 * q), dt1 = *(const LAS f32x4*)(dtv + 32 * ks + 8 * q + 4);
#pragma unroll
                for (int i = 0; i < 8; ++i) { const int s = 32 * ks + 8 * q + i; const float as_ = i < 4 ? ac0[i & 3] : ac1[i & 3], ds_ = i < 4 ? dt0[i & 3] : dt1[i & 3]; f[i] = (s <= ll) ? __expf(al - as_) * ds_ : 0.f; }
                const bf16x8 fm = scale8(fr0, f);
#pragma unroll
                for (int pt = 0; pt < 2; ++pt) acc1[lt][pt] = mma32(fm, *(const LAS bf16x8*)(XT + swz72(64 * e + 16 * (ptb + pt) + r, 4 * ks + q)), acc1[lt][pt]);
                __builtin_amdgcn_sched_barrier(0); }
#pragma unroll
        for (int lt = 0; lt < 4; ++lt)
#pragma unroll
            for (int j = 0; j < 4; ++j) { const int ll = 16 * lt + 4 * q + j;
#pragma unroll
                for (int pt = 0; pt < 2; ++pt) { const int pp = 16 * (ptb + pt) + r; YL[ll * 264 + 64 * e + pp] = (bf16_t)f2bf(acc1[lt][pt][j] + De * bf2f(XT[swz72(64 * e + pp, ll >> 3) + (ll & 7)])); } }
        u32x4 zreg[4];
#pragma unroll
        for (int rep = 0; rep < 4; ++rep) { const int idx = tid + 512 * rep, ll = idx >> 5, grp = idx & 31, t = 64 * c - 48 + ll;
            zreg[rep] = *(const u32x4*)(P + (size_t)row_of(b, t >= 0 ? t : 0) * NP + OFF_SSM + 256 * g + 8 * grp); }
        { const float a63 = acu[63], sc = __expf(a63); bf16x8 fx[2][2];
#pragma unroll
          for (int pt = 0; pt < 2; ++pt)
#pragma unroll
              for (int ks = 0; ks < 2; ++ks) { float f[8];
                  const f32x4 ac0 = *(const LAS f32x4*)(acu + 32 * ks + 8 * q), ac1 = *(const LAS f32x4*)(acu + 32 * ks + 8 * q + 4), dt0 = *(const LAS f32x4*)(dtv + 32 * ks + 8 * q), dt1 = *(const LAS f32x4*)(dtv + 32 * ks + 8 * q + 4);
#pragma unroll
                  for (int i = 0; i < 8; ++i) { const float as_ = i < 4 ? ac0[i & 3] : ac1[i & 3], ds_ = i < 4 ? dt0[i & 3] : dt1[i & 3]; f[i] = __expf(a63 - as_) * ds_; }
                  fx[pt][ks] = scale8(*(const LAS bf16x8*)(XT + swz72(64 * e + 16 * (ptb + pt) + r, 4 * ks + q)), f); }
#pragma unroll
          for (int nt = 0; nt < 8; ++nt) { const bf16x8 b0 = *(const LAS bf16x8*)(BT + swz72(16 * nt + r, q)), b1 = *(const LAS bf16x8*)(BT + swz72(16 * nt + r, 4 + q));
#pragma unroll
              for (int pt = 0; pt < 2; ++pt) { f32x4 s_ = st[nt][pt] * sc; s_ = mma32(b0, fx[pt][0], s_); s_ = mma32(b1, fx[pt][1], s_); st[nt][pt] = s_; }
              __builtin_amdgcn_sched_barrier(0); } }
        BAR_LDS();
        RELAUNDER();
#pragma unroll
        for (int rep = 0; rep < 4; ++rep) { const int idx = tid + 512 * rep, ll = idx >> 5, grp = idx & 31, t = 64 * c - 48 + ll; float y[8], zz[8];
            unpack8(*(const LAS u32x4*)(YL + ll * 264 + 8 * grp), y);
            const size_t row = (size_t)row_of(b, t >= 0 ? t : 0);
            unpack8(zreg[rep], zz);
            float ss = 0.f;
#pragma unroll
            for (int k = 0; k < 8; ++k) { y[k] *= siluf_(zz[k]); ss += y[k] * y[k]; }
            ss += __shfl_xor(ss, 1); ss += __shfl_xor(ss, 2); ss += __shfl_xor(ss, 4); ss += __shfl_xor(ss, 8); ss += __shfl_xor(ss, 16);
            const float rs = rsqrtf(ss * (1.f / 256.f) + 1e-5f); const float* nwp = normw + 256 * g + 8 * grp;
            u32x4 w; w.x = pk2(y[0] * rs * nwp[0], y[1] * rs * nwp[1]); w.y = pk2(y[2] * rs * nwp[2], y[3] * rs * nwp[3]); w.z = pk2(y[4] * rs * nwp[4], y[5] * rs * nwp[5]); w.w = pk2(y[6] * rs * nwp[6], y[7] * rs * nwp[7]);
            if (t >= 0) *(u32x4*)(YS1 + row * DM + 256 * g + 8 * grp) = w; }
        BAR_LDS();
    }
}
#undef RELAUNDER
#undef SSD_DT_PREFETCH

__device__ __forceinline__ void ret_unit(const KP& p, int b, int h, LAS unsigned char* lds, const int WAVE_U) {
    int tid_ = TIDX; asm volatile("" : "+v"(tid_)); const int tid = tid_, wave = __builtin_amdgcn_readfirstlane(tid >> 6), lane = tid & 63, r = lane & 15, q = lane >> 4;
    const bf16_t* P = (const bf16_t*)(p.ws + WS_P);
    bf16_t* YS2 = (bf16_t*)(p.ws + WS_YS) + (size_t)2 * MP * DM;
    LAS bf16_t* Q = (LAS bf16_t*)(lds + 0); LAS bf16_t* K = (LAS bf16_t*)(lds + 9216); LAS bf16_t* KT = (LAS bf16_t*)(lds + 18432); LAS bf16_t* VT = (LAS bf16_t*)(lds + 27648);
    LAS bf16_t* CB = (LAS bf16_t*)(lds + 46080); LAS bf16_t* YL = (LAS bf16_t*)(lds + 57344);
    const float lg0 = log2f(1.f - exp2f(-5.f - (float)h));
    f32x4 st[4];
#pragma unroll
    for (int i = 0; i < 4; ++i) st[i] = (f32x4){0.f, 0.f, 0.f, 0.f};
    const int f_ = tid & 31, it = tid >> 5; const float freq = powf(10000.f, -(float)f_ / 32.f);
    float lg = lg0;
    for (int c = 0; c < 65; ++c) {
        asm volatile("" : "+v"(lg));
        u32x4 greg[2];
#pragma unroll
        for (int rep = 0; rep < 2; ++rep) { const int idx = tid + 512 * rep, ll = idx >> 4, grp = idx & 15, t = 64 * c - 48 + ll;
            greg[rep] = *(const u32x4*)(P + (size_t)row_of(b, t >= 0 ? t : 0) * NP + OFF_RET + 2048 + 128 * h + 8 * grp); }
#pragma unroll
        for (int rep = 0; rep < 4; ++rep) { const int i = it + 16 * rep, t = 64 * c - 48 + i; float qa = 0.f, qb = 0.f, ka = 0.f, kb = 0.f;
            { const bf16_t* pr = P + (size_t)row_of(b, t >= 0 ? t : 0) * NP + OFF_RET + 64 * h + f_; const float vz = t >= 0 ? 1.f : 0.f; const float q1 = vz * bf2f(pr[0]), q2 = vz * bf2f(pr[32]), k1 = vz * bf2f(pr[512]), k2 = vz * bf2f(pr[544]);
                double rv = (double)((float)t * freq) * 0.15915494309189535; rv -= __builtin_rint(rv); const float rf = (float)rv; const float sn = __builtin_amdgcn_sinf(rf), cs = __builtin_amdgcn_cosf(rf); qa = q1 * cs - q2 * sn; qb = q2 * cs + q1 * sn; ka = (k1 * cs - k2 * sn) * 0.125f; kb = (k2 * cs + k1 * sn) * 0.125f; }
            Q[i * 72 + f_] = (bf16_t)f2bf(qa); Q[i * 72 + 32 + f_] = (bf16_t)f2bf(qb); const bf16_t kab = (bf16_t)f2bf(ka), kbb = (bf16_t)f2bf(kb);
            K[i * 72 + f_] = kab; K[i * 72 + 32 + f_] = kbb; KT[f_ * 72 + i] = kab; KT[(f_ + 32) * 72 + i] = kbb; }
#pragma unroll
        for (int rep = 0; rep < 2; ++rep) { const int idx = tid + 512 * rep, i = idx >> 4, grp = idx & 15, t = 64 * c - 48 + i; u32x4 w = (u32x4){0u, 0u, 0u, 0u};
            w = *(const u32x4*)(P + (size_t)row_of(b, t >= 0 ? t : 0) * NP + OFF_RET + 1024 + 128 * h + 8 * grp); if (t < 0) w = (u32x4){0u, 0u, 0u, 0u};
            LAS bf16_t* d = VT + (8 * grp) * 72 + i;
            d[0] = (bf16_t)(w.x & 0xffffu); d[72] = (bf16_t)(w.x >> 16); d[144] = (bf16_t)(w.y & 0xffffu); d[216] = (bf16_t)(w.y >> 16);
            d[288] = (bf16_t)(w.z & 0xffffu); d[360] = (bf16_t)(w.z >> 16); d[432] = (bf16_t)(w.w & 0xffffu); d[504] = (bf16_t)(w.w >> 16); }
        BAR_LDS();
        { const int mt = wave & 3;
#pragma unroll
          for (int tn = 0; tn < 2; ++tn) { const int nt = 2 * (wave >> 2) + tn; f32x4 acc = (f32x4){0.f, 0.f, 0.f, 0.f};
#pragma unroll
              for (int ks = 0; ks < 2; ++ks) acc = mma32(ldfrag(Q + 16 * mt * 72 + 32 * ks, 72, r, q), ldfrag(K + 16 * nt * 72 + 32 * ks, 72, r, q), acc);
#pragma unroll
              for (int j = 0; j < 4; ++j) CB[(16 * mt + 4 * q + j) * 72 + 16 * nt + r] = (bf16_t)f2bf(acc[j]); } }
        BAR_LDS();
        f32x4 acc1[4];
#pragma unroll
        for (int lt = 0; lt < 4; ++lt) acc1[lt] = (f32x4){0.f, 0.f, 0.f, 0.f};
#pragma unroll
        for (int dt = 0; dt < 4; ++dt) { const bf16x4 sb = cvt4(st[dt]);
#pragma unroll
            for (int lt = 0; lt < 4; ++lt) acc1[lt] = mma16(ldfrag4(Q + 16 * lt * 72 + 16 * dt, 72, r, q), sb, acc1[lt]); }
#pragma unroll
        for (int lt = 0; lt < 4; ++lt)
#pragma unroll
            for (int j = 0; j < 4; ++j) acc1[lt][j] *= __builtin_amdgcn_exp2f((float)(16 * lt + 4 * q + j + 1) * lg);
#pragma unroll
        for (int lt = 0; lt < 4; ++lt)
#pragma unroll
            for (int ks = 0; ks < 2; ++ks) { if (ks == 1 && lt < 2) continue;
                const int ll = 16 * lt + r; float f[8];
#pragma unroll
                for (int i = 0; i < 8; ++i) { const int s = 32 * ks + 8 * q + i; f[i] = (s <= ll) ? __builtin_amdgcn_exp2f((float)(ll - s) * lg) : 0.f; }
                acc1[lt] = mma32(scale8(ldfrag(CB + 16 * lt * 72 + 32 * ks, 72, r, q), f), ldfrag(VT + 16 * wave * 72 + 32 * ks, 72, r, q), acc1[lt]); }
#pragma unroll
        for (int lt = 0; lt < 4; ++lt)
#pragma unroll
            for (int j = 0; j < 4; ++j) YL[(16 * lt + 4 * q + j) * 136 + 16 * wave + r] = (bf16_t)f2bf(acc1[lt][j]);
        { const float sc = __builtin_amdgcn_exp2f(64.f * lg); bf16x8 fv[2];
#pragma unroll
          for (int ks = 0; ks < 2; ++ks) { float f[8];
#pragma unroll
              for (int i = 0; i < 8; ++i) f[i] = __builtin_amdgcn_exp2f((float)(63 - (32 * ks + 8 * q + i)) * lg);
              fv[ks] = scale8(ldfrag(VT + 16 * wave * 72 + 32 * ks, 72, r, q), f); }
#pragma unroll
          for (int dt = 0; dt < 4; ++dt) { f32x4 s_ = st[dt] * sc; s_ = mma32(ldfrag(KT + 16 * dt * 72, 72, r, q), fv[0], s_); s_ = mma32(ldfrag(KT + 16 * dt * 72 + 32, 72, r, q), fv[1], s_); st[dt] = s_; } }
        BAR_LDS();
#pragma unroll
        for (int rep = 0; rep < 2; ++rep) { const int idx = tid + 512 * rep, ll = idx >> 4, grp = idx & 15, t = 64 * c - 48 + ll; float y[8], gg[8];
            unpack8(*(const LAS u32x4*)(YL + ll * 136 + 8 * grp), y);
            const size_t row = (size_t)row_of(b, t >= 0 ? t : 0);
            unpack8(greg[rep], gg);
            float ss = 0.f;
#pragma unroll
            for (int k = 0; k < 8; ++k) ss += y[k] * y[k];
            ss += __shfl_xor(ss, 1); ss += __shfl_xor(ss, 2); ss += __shfl_xor(ss, 4); ss += __shfl_xor(ss, 8);
            const float rs = rsqrtf(ss * (1.f / 128.f) + 1e-6f);
            u32x4 w; w.x = pk2(siluf_(gg[0]) * y[0] * rs, siluf_(gg[1]) * y[1] * rs); w.y = pk2(siluf_(gg[2]) * y[2] * rs, siluf_(gg[3]) * y[3] * rs);
            w.z = pk2(siluf_(gg[4]) * y[4] * rs, siluf_(gg[5]) * y[5] * rs); w.w = pk2(siluf_(gg[6]) * y[6] * rs, siluf_(gg[7]) * y[7] * rs);
            if (t >= 0) *(u32x4*)(YS2 + row * DM + 128 * h + 8 * grp) = w; }
        BAR_LDS();
    }
}

__device__ __forceinline__ void lru_unit(const KP& p, int l, int b, int n, int hf, LAS unsigned char* lds, const int WAVE_U) {
    int tid_ = TIDX; asm volatile("" : "+v"(tid_)); const int tid = tid_, wave = __builtin_amdgcn_readfirstlane(tid >> 6), lane = tid & 63, r = lane & 15, q = lane >> 4;
    const bf16_t* P = (const bf16_t*)(p.ws + WS_P);
    bf16_t* YS3 = (bf16_t*)(p.ws + WS_YS) + (size_t)3 * MP * DM;
    const float* conv_w = p.in[20] + (size_t)l * 4 * DM; const float* conv_b = p.in[21] + (size_t)l * DM;
    const float* wg = p.in[22] + (size_t)l * 2 * 8 * 128 * 128; const float* bg = p.in[23] + (size_t)l * 2 * DM; const float* lam = p.in[24] + (size_t)l * DM;
    LAS bf16_t* WGT = (LAS bf16_t*)(lds + 0); LAS bf16_t* XC = (LAS bf16_t*)(lds + 34816); LAS float* AA = (LAS float*)(lds + 52224); LAS float* UU = (LAS float*)(lds + 68608);
    LAS float* SEG = (LAS float*)(lds + 84992); LAS float* CAR = (LAS float*)(lds + 89088);
    for (int idx = tid; idx < 2 * 64 * 128; idx += 512) { const int k = idx >> 13, rem = idx & 8191, cc = rem >> 6, e = rem & 63;
        WGT[(k * 64 + e) * 136 + cc] = (bf16_t)f2bf(wg[((size_t)(k * 8 + n) * 128 + cc) * 128 + 64 * hf + e]); }
    if (tid < 64) CAR[tid] = 0.f;
    const int cgp = tid & 15, tg = tid >> 4, cb8 = 128 * n + 8 * cgp, pcol = OFF_LRU + 1024 + cb8;
    const int chs = 128 * n + 64 * hf + (tid & 63), seg = tid >> 6;
    __syncthreads();
    for (int c = 0; c < 65; ++c) {
        unsigned short yin[8];
#pragma unroll
        for (int i = 0; i < 8; ++i) { const int t = 64 * c - 48 + 8 * seg + i; yin[i] = P[(size_t)row_of(b, t >= 0 ? t : 0) * NP + OFF_LRU + chs]; }
        { float cw0[8], cw1[8], cw2[8], cw3[8], cb[8]; u32x4 raw[5];
          const int i0 = 2 * tg, t0 = 64 * c - 48 + i0;
#pragma unroll
          for (int j = 0; j < 5; ++j) { const int t = t0 - 3 + j; raw[j] = *(const u32x4*)(P + (size_t)row_of(b, t >= 0 ? t : 0) * NP + pcol); if (t < 0) raw[j] = (u32x4){0u, 0u, 0u, 0u}; }
#pragma unroll
          for (int k = 0; k < 8; ++k) { cw0[k] = conv_w[cb8 + k]; cw1[k] = conv_w[DM + cb8 + k]; cw2[k] = conv_w[2 * DM + cb8 + k]; cw3[k] = conv_w[3 * DM + cb8 + k]; cb[k] = conv_b[cb8 + k]; }
#pragma unroll
          for (int ii = 0; ii < 2; ++ii) { const int t = t0 + ii, i = i0 + ii; float x0[8], x1[8], x2[8], x3[8], o[8];
              unpack8(raw[ii], x0); unpack8(raw[ii + 1], x1); unpack8(raw[ii + 2], x2); unpack8(raw[ii + 3], x3);
#pragma unroll
              for (int k = 0; k < 8; ++k) { const float z = cb[k] + cw0[k] * x0[k] + cw1[k] * x1[k] + cw2[k] * x2[k] + cw3[k] * x3[k]; o[k] = t >= 0 ? z : 0.f; }
              u32x4 w; w.x = pk2(o[0], o[1]); w.y = pk2(o[2], o[3]); w.z = pk2(o[4], o[5]); w.w = pk2(o[6], o[7]);
              *(LAS u32x4*)(XC + i * 136 + 8 * cgp) = w; } }
        BAR_LDS();
        { const int lt = wave & 3;
#pragma unroll
          for (int te = 0; te < 2; ++te) { const int et = 2 * (wave >> 2) + te; f32x4 a0 = (f32x4){0.f, 0.f, 0.f, 0.f}, a1 = a0;
#pragma unroll
              for (int ks = 0; ks < 4; ++ks) { const bf16x8 xa = ldfrag(XC + 16 * lt * 136 + 32 * ks, 136, r, q);
                  a0 = mma32(xa, ldfrag(WGT + (16 * et) * 136 + 32 * ks, 136, r, q), a0); a1 = mma32(xa, ldfrag(WGT + (64 + 16 * et) * 136 + 32 * ks, 136, r, q), a1); }
              const int e = 16 * et + r, chn = 128 * n + 64 * hf + e; const float b0 = bg[chn], b1 = bg[DM + chn], spl = softplusf_(-lam[chn]);
#pragma unroll
              for (int j = 0; j < 4; ++j) { const int tok = 16 * lt + 4 * q + j, t = 64 * c - 48 + tok;
                  const float rg = sigmoidf_(a0[j] + b0), ig = sigmoidf_(a1[j] + b1), la = -8.f * rg * spl; float a = __expf(la), u = __builtin_amdgcn_sqrtf(fmaxf(1.f - __expf(2.f * la), 0.f)) * ig * bf2f(XC[tok * 136 + 64 * hf + e]);
                  if (t < 0) { a = 1.f; u = 0.f; }
                  AA[tok * 64 + e] = a; UU[tok * 64 + e] = u; } } }
        BAR_LDS();
        { const int ch = tid & 63; float A = 1.f, H = 0.f;
#pragma unroll
          for (int i = 0; i < 8; ++i) { const float a = AA[(8 * seg + i) * 64 + ch], u = UU[(8 * seg + i) * 64 + ch]; H = a * H + u; A *= a; }
          SEG[(seg * 64 + ch) * 2] = A; SEG[(seg * 64 + ch) * 2 + 1] = H;
          BAR_LDS();
          float hcar = CAR[ch];
          for (int s2 = 0; s2 < seg; ++s2) hcar = SEG[(s2 * 64 + ch) * 2] * hcar + SEG[(s2 * 64 + ch) * 2 + 1];
#pragma unroll
          for (int i = 0; i < 8; ++i) { const int tok = 8 * seg + i, t = 64 * c - 48 + tok; hcar = AA[tok * 64 + ch] * hcar + UU[tok * 64 + ch];
              if (t >= 0) { const size_t row = (size_t)row_of(b, t); const float x = bf2f(yin[i]);
                  const float tu = 0.7978845608f * (x + 0.044715f * x * x * x); const float ge = 0.5f * x * (2.f - 2.f * __builtin_amdgcn_rcpf(1.f + __expf(2.f * tu)));
                  YS3[row * DM + chs] = (bf16_t)f2bf(hcar * ge); } }
          BAR_LDS();
          if (seg == 7) CAR[ch] = hcar; }
        BAR_LDS();
    }
}


__device__ __forceinline__ f32x4 skinny_tile(const bf16_t* A, const bf16_t* Bt, int K, int j, LAS unsigned char* lds, int wave, int lane) {
    const int r = lane & 15, q = lane >> 4; f32x4 acc[4];
#pragma unroll
    for (int nt = 0; nt < 4; ++nt) acc[nt] = (f32x4){0.f, 0.f, 0.f, 0.f};
    const bf16_t* ap = A + (size_t)(MMAIN + r) * K + 8 * q; const bf16_t* bp = Bt + (size_t)(64 * j + r) * K + 8 * q;
    const int nks = K / 32;
    for (int ks = wave; ks < nks; ks += 8) { const bf16x8 a = *(const bf16x8*)(ap + 32 * ks);
#pragma unroll
        for (int nt = 0; nt < 4; ++nt) acc[nt] = mma32(a, *(const bf16x8*)(bp + (size_t)16 * nt * K + 32 * ks), acc[nt]); }
    LAS f32x4* red = (LAS f32x4*)lds;
#pragma unroll
    for (int nt = 0; nt < 4; ++nt) red[(wave * 4 + nt) * 64 + lane] = acc[nt];
    __syncthreads();
    f32x4 tot = (f32x4){0.f, 0.f, 0.f, 0.f};
    if (wave < 4) {
#pragma unroll
        for (int w = 0; w < 8; ++w) tot += red[(w * 4 + wave) * 64 + lane]; }
    __syncthreads();
    return tot;
}
__device__ __forceinline__ void skinny_branch(const bf16_t* YS, const bf16_t* br_t, const bf16_t* P, float* Z, bf16_t* ZB, int j, LAS unsigned char* lds, const int WAVE_U) {
    int tid = TIDX; asm volatile("" : "+v"(tid)); const int wave = __builtin_amdgcn_readfirstlane(tid >> 6), lane = tid & 63, r = lane & 15, q = lane >> 4;
    for (int n = 0; n < 4; ++n) {
        const f32x4 acc = skinny_tile(YS + (size_t)n * MP * DM, br_t + (size_t)n * 1024 * DM, DM, j, lds, wave, lane);
        if (wave < 4) { const int col = 64 * j + 16 * wave + r;
#pragma unroll
            for (int jj = 0; jj < 4; ++jj) { const size_t row = MMAIN + 4 * q + jj; float v = sigmoidf_(bf2f(P[row * NP + OFF_GATE + n * 1024 + col])) * acc[jj];
                if (n != 0) v += Z[row * DM + col];
                if (n != 3) Z[row * DM + col] = v; else ZB[row * DM + col] = (bf16_t)f2bf(v); } }
    }
}
__device__ __forceinline__ void skinny_resid(const bf16_t* A, const bf16_t* Bt, int K, float* S, bf16_t* HN, const float* nw, float* ssq, int j, LAS unsigned char* lds, const int WAVE_U) {
    int tid = TIDX; asm volatile("" : "+v"(tid)); const int wave = __builtin_amdgcn_readfirstlane(tid >> 6), lane = tid & 63, r = lane & 15, q = lane >> 4;
    const f32x4 acc = skinny_tile(A, Bt, K, j, lds, wave, lane);
    LAS float* part = (LAS float*)lds;
    if (wave < 4) { const int col = 64 * j + 16 * wave + r; const float w = nw[col];
#pragma unroll
        for (int jj = 0; jj < 4; ++jj) { const size_t row = MMAIN + 4 * q + jj; const float sn = S[row * DM + col] + acc[jj]; S[row * DM + col] = sn; HN[row * DM + col] = (bf16_t)f2bf(sn * w);
            float ss = sn * sn; ss = DPP_ADD(ss, 0xB1); ss = DPP_ADD(ss, 0x4E); ss = DPP_ADD(ss, 0x141); ss = DPP_ADD(ss, 0x140);
            if (r == 0) part[wave * 16 + 4 * q + jj] = ss; } }
    __syncthreads();
    if (tid < 16) ssq[(size_t)(MMAIN + tid) * 16 + j] = (part[tid] + part[16 + tid]) + (part[32 + tid] + part[48 + tid]);
    __syncthreads();
}


#define XB_TMO      128
#define XB_XCNT(j)  (256  + 64 * (j))
#define XB_XSUB(j)  (1280 + 64 * (j))
#define XB_XGEN(j)  (2304 + 64 * (j))
#define XB_TOP      3328
#define XB_TOPGEN   3392
#define XCD_BAR_WORDS 3456
#define XB_SPIN_CAP (1u << 20)
__device__ __forceinline__ unsigned xb_ld(unsigned* p)              { return __hip_atomic_load(p, __ATOMIC_RELAXED, __HIP_MEMORY_SCOPE_AGENT); }
__device__ __forceinline__ unsigned xb_add(unsigned* p, unsigned v) { return __hip_atomic_fetch_add(p, v, __ATOMIC_RELAXED, __HIP_MEMORY_SCOPE_AGENT); }
__device__ __forceinline__ unsigned xb_xcc_id() { return (unsigned)__builtin_amdgcn_s_getreg((3 << 11) | 20) & 0xFu; }
#define XB_SPIN(cond, bar) do { unsigned _sp = 0; while (cond) { __builtin_amdgcn_s_sleep(1); \
    if ((++_sp & 255u) == 0u) { if (xb_ld(&(bar)[XB_TMO])) break; if (_sp > XB_SPIN_CAP) { atomicAdd(&(bar)[XB_TMO], 1u); break; } } } } while (0)
struct XcdBarrier { unsigned* bar; unsigned x; volatile LAS unsigned* st; };
__device__ __forceinline__ XcdBarrier xcd_barrier_post(unsigned* bar, volatile LAS unsigned* st, const int WAVE_U) {
    XcdBarrier b; b.bar = bar; b.x = (unsigned)__builtin_amdgcn_readfirstlane((int)xb_xcc_id()); b.st = st;
    if (TIDX == 0) (void)xb_add(&bar[XB_XCNT(b.x)], 1u);
    return b;
}
__device__ __forceinline__ void xcd_barrier_complete(unsigned* bar, unsigned x, unsigned& nloc, unsigned& nx) {
    const unsigned G = gridDim.x * gridDim.y * gridDim.z;
    unsigned sum, cnt, mine, sp = 0u;
    for (;;) {
        sum = 0u; cnt = 0u; mine = 0u;
#pragma unroll
        for (unsigned j = 0; j < 16; ++j) { const unsigned c = xb_ld(&bar[XB_XCNT(j)]); sum += c; cnt += (c > 0u) ? 1u : 0u; mine = (j == x) ? c : mine; }
        if (sum == G) break;
        __builtin_amdgcn_s_sleep(1);
        if ((++sp & 255u) == 0u) { if (xb_ld(&bar[XB_TMO])) break; if (sp > XB_SPIN_CAP) { atomicAdd(&bar[XB_TMO], 1u); break; } }
    }
    nloc = mine > 0u ? mine : 1u; nx = cnt > 0u ? cnt : 1u;
}
__device__ __forceinline__ void xcd_barrier(const XcdBarrier& b, const int WAVE_U) {
    asm volatile("s_waitcnt vmcnt(0)" ::: "memory");
    __syncthreads();
    if (TIDX == 0) {
        unsigned* bar = b.bar;
        __builtin_amdgcn_s_waitcnt(0);
        unsigned nloc = b.st[0], nx = b.st[1];
        if (nloc == 0u) { xcd_barrier_complete(bar, b.x, nloc, nx); b.st[0] = nloc; b.st[1] = nx; }
        const unsigned old = xb_add(&bar[XB_XSUB(b.x)], 1u);
        const unsigned gen = old / nloc;
        if (old + 1u == (gen + 1u) * nloc) {
            __builtin_amdgcn_fence(__ATOMIC_RELEASE, "agent");
            asm volatile("s_waitcnt vmcnt(0)" ::: "memory");
            const unsigned og = xb_add(&bar[XB_TOP], 1u);
            const unsigned tg = og / nx;
            if (og + 1u == (tg + 1u) * nx) xb_add(&bar[XB_TOPGEN], 1u);
            else XB_SPIN(xb_ld(&bar[XB_TOPGEN]) == tg, bar);
            __builtin_amdgcn_fence(__ATOMIC_ACQUIRE, "agent");
            xb_add(&bar[XB_XGEN(b.x)], 1u);
            asm volatile("s_waitcnt vmcnt(0)" ::: "memory");
        } else {
            XB_SPIN(xb_ld(&bar[XB_XGEN(b.x)]) == gen, bar);
            __builtin_amdgcn_fence(__ATOMIC_ACQUIRE, "agent");
            asm volatile("s_waitcnt vmcnt(0)" ::: "memory");
        }
    }
    __syncthreads();
}


__device__ __forceinline__ void subgrid_arrive(unsigned* word, const int WAVE_U) {
    asm volatile("s_waitcnt vmcnt(0)" ::: "memory");
    __syncthreads();
    if (TIDX == 0) { __builtin_amdgcn_fence(__ATOMIC_RELEASE, "agent"); asm volatile("s_waitcnt vmcnt(0)" ::: "memory"); (void)xb_add(word, 1u); }
}
__device__ __forceinline__ void subgrid_wait(unsigned* word, unsigned nblocks, const int WAVE_U) {
    if (TIDX == 0) { unsigned sp = 0u; while (xb_ld(word) < nblocks) { __builtin_amdgcn_s_sleep(1); if (++sp > (1u << 22)) break; }
        __builtin_amdgcn_fence(__ATOMIC_ACQUIRE, "agent"); asm volatile("s_waitcnt vmcnt(0)" ::: "memory"); }
    __syncthreads();
}
__device__ __forceinline__ void subgrid_barrier(unsigned* word, unsigned nblocks, const int WAVE_U) {
    asm volatile("s_waitcnt vmcnt(0)" ::: "memory");
    __syncthreads();
    if (TIDX == 0) {
        __builtin_amdgcn_fence(__ATOMIC_RELEASE, "agent");
        asm volatile("s_waitcnt vmcnt(0)" ::: "memory");
        (void)xb_add(word, 1u);
        unsigned sp = 0u;
        while (xb_ld(word) < nblocks) { __builtin_amdgcn_s_sleep(1); if (++sp > (1u << 22)) break; }
        __builtin_amdgcn_fence(__ATOMIC_ACQUIRE, "agent");
        asm volatile("s_waitcnt vmcnt(0)" ::: "memory");
    }
    __syncthreads();
}

#ifndef REP_P1
#define REP_P1 1
#endif
#ifndef REP_RWKV
#define REP_RWKV 1
#endif
#ifndef REP_SSD
#define REP_SSD 1
#endif
#ifndef REP_RET
#define REP_RET 1
#endif
#ifndef REP_LRU
#define REP_LRU 1
#endif
#ifndef PH_MASK
#define PH_MASK 1023
#endif
constexpr int LDS_BYTES = 160768;
constexpr int NUNITS = 176;

__global__ void __launch_bounds__(512, 2) fwd_megakernel(KP p) {
    extern __shared__ __attribute__((aligned(16))) unsigned char lds_raw[];
    LAS unsigned char* lds = (LAS unsigned char*)lds_raw;
    cg::grid_group grid = cg::this_grid();
    const int WAVE_U = __builtin_amdgcn_readfirstlane((int)(threadIdx.x >> 6));
    constexpr int G = 256; int bx = blockIdx.x; constexpr int NGW = G * 8;
#define FRESH_TID() int tid_ = TIDX; asm volatile("" : "+v"(tid_)); const int tid = tid_, wave = tid >> 6, lane = tid & 63, gw = bx * 8 + wave; (void)gw; (void)lane
    float* ssq = (float*)(p.ws + WS_SSQ); float* S = (float*)(p.ws + WS_S); bf16_t* HN = (bf16_t*)(p.ws + WS_HN); bf16_t* P = (bf16_t*)(p.ws + WS_P);
    bf16_t* YS = (bf16_t*)(p.ws + WS_YS); float* Z = (float*)(p.ws + WS_Z); bf16_t* ZB = (bf16_t*)(p.ws + WS_ZB); bf16_t* WIN = (bf16_t*)(p.ws + WS_WIN);
    bf16_t* H = (bf16_t*)(p.ws + WS_P);
    {
        FRESH_TID();
        const float* nw0 = p.in[2];
        for (int m = gw; m < MP; m += NGW) {
            const float* src = m < MMAIN ? p.in[0] + (size_t)m * DM : (m < MMAIN + NMETA ? p.in[1] + (size_t)(m - MMAIN) * DM : nullptr);
            float ss = 0.f;
#pragma unroll
            for (int j = 0; j < 4; ++j) { const int col = 4 * lane + 256 * j; f32x4 v = (f32x4){0.f, 0.f, 0.f, 0.f}; if (src) v = *(const f32x4*)(src + col);
                *(f32x4*)(S + (size_t)m * DM + col) = v; const f32x4 w = *(const f32x4*)(nw0 + col);
                u32x2 o; o.x = pk2(v[0] * w[0], v[1] * w[1]); o.y = pk2(v[2] * w[2], v[3] * w[3]); *(u32x2*)(HN + (size_t)m * DM + col) = o;
                ss += (v[0] * v[0] + v[1] * v[1]) + (v[2] * v[2] + v[3] * v[3]); }
#pragma unroll
            for (int o = 1; o < 64; o <<= 1) ss += __shfl_xor(ss, o);
            if (lane < 16) ssq[(size_t)m * 16 + lane] = lane == 0 ? ss : 0.f;
        }
        for (int i = bx * 512 + tid; i < (NP - INW) * DM / 8; i += G * 512) ((u32x4*)(WIN + (size_t)INW * DM))[i] = (u32x4){0u, 0u, 0u, 0u};
        convert_layer(p, 0, lds, gw, NGW, wave, lane);
        if (bx == 0) for (int i = tid; i < XCD_BAR_WORDS + 512; i += 512) ((unsigned*)(p.ws + WS_XBAR))[i] = 0u;
        if (tid == 0) { ((volatile LAS unsigned*)(lds + LDS_BYTES - 16))[0] = 0u; ((volatile LAS unsigned*)(lds + LDS_BYTES - 16))[1] = 0u; }
    }
    grid.sync();
    XcdBarrier xbar = xcd_barrier_post((unsigned*)(p.ws + WS_XBAR), (volatile LAS unsigned*)(lds + LDS_BYTES - 16), WAVE_U);
    for (int l_ = 0; l_ < NLAYER; ++l_) {
        int l = l_; asm volatile("" : "+s"(l)); asm volatile("" : "+s"(bx));
        unsigned char* sm = p.ws + WS_WSM + (size_t)(l & 1) * WSM_SIZE;
        const bf16_t* br_t = (const bf16_t*)(sm + WSM_BR); const bf16_t* out_t = (const bf16_t*)(sm + WSM_OUT); const bf16_t* fi_t = (const bf16_t*)(sm + WSM_FI); const bf16_t* fo_t = (const bf16_t*)(sm + WSM_FO);
        if (PH_MASK & 1) for (int rp = 0; rp < REP_P1; ++rp) { pg8::Gemm g{HN, WIN, DM}; pg8::RemapOrder So; So.b.init(NTM, PT_A + 1, G, bx); So.from = PT_A; So.to = NP / 256 - 1; pg8::EpiInProj E{P, ssq + (size_t)(2 * l) * MP * 16, 0}; pg8::gemm_phase(lds, g, So, E, WAVE_U); }
        xcd_barrier(xbar, WAVE_U);
        asm volatile("" : "+s"(bx));
        { FRESH_TID(); rwkv_lora_inputs(p, l, gw, NGW, lane); }
        xcd_barrier(xbar, WAVE_U);
        asm volatile("" : "+s"(bx));
        {
            int l = l_; asm volatile("" : "+s"(l));
            if (bx < 64) rwkv_unit(p, l, bx >> 4, bx & 15, lds, WAVE_U);
            else if (bx < 80) ssd_unit(p, l, (bx - 64) >> 2, (bx - 64) & 3, lds, WAVE_U);
            else {
                { pg8::Gemm g{HN, WIN + (size_t)PT_A * 256 * DM, DM}; pg8::StaticOrder So; So.init(NTM, GT0 - PT_A, G - 80, bx - 80);
                  pg8::EpiInProj E{P, ssq + (size_t)(2 * l) * MP * 16, PT_A}; pg8::gemm_phase(lds, g, So, E, WAVE_U); }
                unsigned* sbw = (unsigned*)(p.ws + WS_XBAR) + XCD_BAR_WORDS + 64 + 64 * l;
                subgrid_arrive(sbw, WAVE_U);
                if (bx < 176) subgrid_wait(sbw, (unsigned)(G - 80), WAVE_U);
                if (bx < 112) ret_unit(p, (bx - 80) >> 3, (bx - 80) & 7, lds, WAVE_U);
                else if (bx < 176) { const int v = bx - 112; lru_unit(p, l, v >> 4, (v >> 1) & 7, v & 1, lds, WAVE_U); }
                else { { pg8::Gemm g{HN, (const bf16_t*)(p.ws + WS_WING + (size_t)(l & 1) * WING_SIZE), DM}; pg8::StaticOrder So; So.init(NTM, GTN, G - 176, bx - 176);
                         pg8::EpiInProj E{P, ssq + (size_t)(2 * l) * MP * 16, GT0}; pg8::gemm_phase(lds, g, So, E, WAVE_U); }
                       subgrid_wait(sbw, (unsigned)(G - 80), WAVE_U);
                       if (l_ + 1 < NLAYER) { FRESH_TID(); convert_layer(p, l + 1, lds, (bx - 176) * 8 + wave, (G - 176) * 8, wave, lane); } }
            }
        }
        xcd_barrier(xbar, WAVE_U);
        asm volatile("" : "+s"(bx));
        if (PH_MASK & 32) { pg8::Gemm g{YS, br_t, DM}; pg8::BranchOrder So{G, bx}; pg8::EpiBranch E{P, Z, ZB}; pg8::gemm_phase(lds, g, So, E, WAVE_U);
          if (bx < 16) skinny_branch(YS, br_t, P, Z, ZB, bx, lds, WAVE_U); }
        xcd_barrier(xbar, WAVE_U);
        asm volatile("" : "+s"(bx));
        if (PH_MASK & 64) { pg8::Gemm g{ZB, out_t, DM}; pg8::StaticOrder So; So.init(NTM - 1, 4, G, bx); pg8::EpiResid E{S, HN, p.in[3] + (size_t)l * DM, ssq + (size_t)(2 * l + 1) * MP * 16}; pg8::gemm_phase(lds, g, So, E, WAVE_U);
          if (bx < 16) skinny_resid(ZB, out_t, DM, S, HN, p.in[3] + (size_t)l * DM, ssq + (size_t)(2 * l + 1) * MP * 16, bx, lds, WAVE_U); }
        xcd_barrier(xbar, WAVE_U);
        asm volatile("" : "+s"(bx));
        if (PH_MASK & 128) { pg8::Gemm g{HN, fi_t, DM}; pg8::StaticOrder So; So.init(NTM, 2 * FF / 256, G, bx); pg8::EpiSwiglu E{H, ssq + (size_t)(2 * l + 1) * MP * 16}; pg8::gemm_phase(lds, g, So, E, WAVE_U); }
        xcd_barrier(xbar, WAVE_U);
        asm volatile("" : "+s"(bx));
        if (PH_MASK & 256) { pg8::Gemm g{H, fo_t, FF}; pg8::StaticOrder So; So.init(NTM - 1, 4, G, bx); const float* nwn = (l + 1 < NLAYER) ? p.in[2] + (size_t)(l + 1) * DM : p.in[29];
          pg8::EpiResid E{S, HN, nwn, ssq + (size_t)(2 * l + 2) * MP * 16}; pg8::gemm_phase(lds, g, So, E, WAVE_U);
          if (bx < 16) skinny_resid(H, fo_t, FF, S, HN, nwn, ssq + (size_t)(2 * l + 2) * MP * 16, bx, lds, WAVE_U); }
        xcd_barrier(xbar, WAVE_U);
        asm volatile("" : "+s"(bx));
    }
    { FRESH_TID(); const float* fw = p.in[29]; const float* sq = ssq + (size_t)8 * MP * 16;
      for (int m = gw; m < MMAIN; m += NGW) { const float rs = rsqrtf(ssq_total(sq, m) * (1.f / 1024.f) + 1e-6f);
#pragma unroll
          for (int j = 0; j < 4; ++j) { const int col = 4 * lane + 256 * j; const f32x4 v = *(const f32x4*)(S + (size_t)m * DM + col), w = *(const f32x4*)(fw + col);
              *(f32x4*)(p.out + (size_t)m * DM + col) = v * rs * w; } } }
}

extern "C" void kernel_launch(void* const* d_in, const int* in_sizes, int n_in, void* d_out, int out_size, void* d_ws, size_t ws_size, hipStream_t stream) {
    static int grid = 0;
    if (grid == 0) {
        if (n_in != 30 || ws_size < WS_END) { fprintf(stderr, "kernel_launch: unexpected n_in %d / ws %zu (need %zu)\n", n_in, ws_size, (size_t)WS_END); grid = -1; return; }
        int dev = 0, cus = 0, per_cu = 0;
        hipGetDevice(&dev); hipDeviceGetAttribute(&cus, hipDeviceAttributeMultiprocessorCount, dev);
        hipFuncSetAttribute((const void*)fwd_megakernel, hipFuncAttributeMaxDynamicSharedMemorySize, LDS_BYTES);
        hipOccupancyMaxActiveBlocksPerMultiprocessor(&per_cu, (const void*)fwd_megakernel, 512, LDS_BYTES);
        if (per_cu < 1) { fprintf(stderr, "kernel_launch: occupancy query says %d blocks/CU\n", per_cu); per_cu = 1; }
        (void)hipGetLastError();
        grid = 256;
        if (cus < 256) { fprintf(stderr, "kernel_launch: this kernel needs 256 CUs (got %d)\n", cus); grid = -1; return; }
    }
    if (grid < 0) return;
    KP p{};
    for (int i = 0; i < 30; ++i) p.in[i] = (const float*)d_in[i];
    p.out = (float*)d_out; p.ws = (unsigned char*)d_ws;
    void* args[] = {&p};
    hipError_t e = hipLaunchCooperativeKernel((const void*)fwd_megakernel, dim3(grid), dim3(512), args, LDS_BYTES, stream);
    if (e != hipSuccess) fprintf(stderr, "cooperative launch failed: %s (grid %d)\n", hipGetErrorString(e), grid);
}
```

```cpp
#include <hip/hip_runtime.h>
#include <hip/hip_cooperative_groups.h>
#include <cstdio>
#include <cstdint>
namespace cg = cooperative_groups;

#define LAS __attribute__((address_space(3)))
typedef unsigned short bf16_t;
typedef short bf16x8 __attribute__((ext_vector_type(8)));
typedef short bf16x4 __attribute__((ext_vector_type(4)));
typedef float f32x4 __attribute__((ext_vector_type(4)));
typedef unsigned u32x4 __attribute__((ext_vector_type(4)));
typedef unsigned u32x2 __attribute__((ext_vector_type(2)));

constexpr int DM = 1024, NB = 4, SEQ = 4096, NMETA = 16, TT = SEQ + NMETA;
constexpr int MMAIN = NB * SEQ;
constexpr int MP = 16640, NTM = MP / 256;
constexpr int INW = 15632, NP = 15872;
constexpr int OFF_SSM = 3328, OFF_RET = 6416, OFF_LRU = 9488, OFF_GATE = 11536, OFF_VLO = 15632;
constexpr int FF = 2816;
constexpr int NLAYER = 4;

constexpr size_t WS_SSQ = 0;
constexpr size_t WS_XBAR = 12u << 20;
constexpr size_t WS_S = 16u << 20;
constexpr size_t WS_HN = WS_S + (size_t)MP * DM * 4;
constexpr size_t WS_P = WS_HN + (size_t)MP * DM * 2;
constexpr size_t WS_YS = WS_P + (size_t)MP * NP * 2;
constexpr size_t WS_VF = WS_YS + (size_t)4 * MP * DM * 2;
constexpr size_t WS_Z = WS_VF + (size_t)MP * DM * 2;
constexpr size_t WS_ZB = WS_Z + (size_t)MP * DM * 4;
constexpr size_t WS_WIN = WS_ZB + (size_t)MP * DM * 2;
constexpr size_t WSM_BR = 0, WSM_OUT = (size_t)4096 * 1024 * 2, WSM_FI = WSM_OUT + (size_t)1024 * 1024 * 2,
                 WSM_FO = WSM_FI + (size_t)2 * FF * 1024 * 2, WSM_SIZE = WSM_FO + (size_t)1024 * FF * 2;
constexpr size_t WS_WSM = WS_WIN + (size_t)NP * DM * 2;
constexpr int PT_A = 26;
constexpr int GT0 = 46, GTN = 15;
constexpr size_t WS_WING = WS_WSM + 2 * WSM_SIZE, WING_SIZE = (size_t)GTN * 256 * DM * 2;
constexpr size_t WS_END = WS_WING + 2 * WING_SIZE;
static_assert(WS_END <= 1024458752ull, "workspace map exceeds 4 x w_in bytes");

typedef float f32x2_t __attribute__((ext_vector_type(2))); typedef __bf16 bf16x2_t __attribute__((ext_vector_type(2)));
__device__ __forceinline__ unsigned pk2(float lo, float hi) { f32x2_t v = {lo, hi}; bf16x2_t b = __builtin_convertvector(v, bf16x2_t); return __builtin_bit_cast(unsigned, b); }
__device__ __forceinline__ unsigned f2bf(float f) { return pk2(f, f); }
__device__ __forceinline__ float bf2f(unsigned h) { return __builtin_bit_cast(float, h << 16); }
__device__ __forceinline__ float sigmoidf_(float x) { return __builtin_amdgcn_rcpf(1.f + __expf(-x)); }
__device__ __forceinline__ float softplusf_(float x) { return x > 20.f ? x : log1pf(__expf(x)); }
__device__ __forceinline__ float siluf_(float x) { return x * __builtin_amdgcn_rcpf(1.f + __expf(-x)); }
__device__ __forceinline__ int row_of(int b, int t) { return t < NMETA ? MMAIN + t : b * SEQ + (t - NMETA); }
__device__ __forceinline__ void unpack8(u32x4 w, float* f) {
    f[0] = bf2f(w.x & 0xffffu); f[1] = bf2f(w.x >> 16); f[2] = bf2f(w.y & 0xffffu); f[3] = bf2f(w.y >> 16);
    f[4] = bf2f(w.z & 0xffffu); f[5] = bf2f(w.z >> 16); f[6] = bf2f(w.w & 0xffffu); f[7] = bf2f(w.w >> 16);
}
__device__ __forceinline__ float dpp_f(float x, const int ctrl_is_const_only) { return x; }
#define DPP_ADD(x, ctrl) ((x) + __builtin_bit_cast(float, __builtin_amdgcn_update_dpp(0, __builtin_bit_cast(int, (x)), (ctrl), 0xf, 0xf, true)))
__device__ __forceinline__ float half_sum32(float x) { x = DPP_ADD(x, 0xB1); x = DPP_ADD(x, 0x4E); x = DPP_ADD(x, 0x141); x = DPP_ADD(x, 0x140); x += __shfl_xor(x, 16); return x; }
#define TIDX ((void)WAVE_U, (int)threadIdx.x)
__device__ __forceinline__ float ssq_total_q(const float* ssq, int row, int fq) {
    const f32x4 a = *(const f32x4*)(ssq + (size_t)row * 16 + 4 * fq); float t = (a[0] + a[1]) + (a[2] + a[3]);
    t += __shfl_xor(t, 16); t += __shfl_xor(t, 32); return t;
}
#define LDS_WAIT() asm volatile("s_waitcnt lgkmcnt(0)" ::: "memory")
#ifndef REP_A
#define REP_A 1
#endif
#ifndef REP_B
#define REP_B 1
#endif
#define BAR_LDS() asm volatile("s_waitcnt lgkmcnt(0)\n\ts_barrier" ::: "memory")
__device__ __forceinline__ float ssq_total(const float* ssq, int row) {
    const f32x4 a = *(const f32x4*)(ssq + (size_t)row * 16), b = *(const f32x4*)(ssq + (size_t)row * 16 + 4), c = *(const f32x4*)(ssq + (size_t)row * 16 + 8), d = *(const f32x4*)(ssq + (size_t)row * 16 + 12);
    return (((a[0] + a[1]) + (a[2] + a[3])) + ((b[0] + b[1]) + (b[2] + b[3]))) + (((c[0] + c[1]) + (c[2] + c[3])) + ((d[0] + d[1]) + (d[2] + d[3])));
}

namespace pg8 {
constexpr int BM = 256, BK = 64, HALF = 128, HTB = HALF * BK * 2, STAGE_BYTES = 8 * HTB, NXCD = 8, WGM = 8;
__host__ __device__ __forceinline__ int lds_byte(int r, int c) { const int st = (r >> 4) * 2 + (c >> 5), rr = r & 15, cc = c & 31, ob = rr * 64 + cc * 2; return st * 1024 + (ob ^ (((ob >> 9) & 1) << 5)); }
__host__ __device__ __forceinline__ void stage_rc(int b, int& R, int& C) { const int st = b / 1024, sb = b % 1024, swz = sb ^ (((sb >> 9) & 1) << 5); R = (st >> 1) * 16 + swz / 64; C = (st & 1) * 32 + (swz % 64) / 2; }
__host__ __device__ __forceinline__ int perm32(int rho) { const int n = rho >> 4, i = rho & 15; return 8 * (i >> 2) + 4 * n + (i & 3); }
struct Unit { int pm, pn; };
struct Gemm { const bf16_t* A; const bf16_t* Bt; int K; };
struct StaticOrder {
    int nM, nN, nwg, G, c;
    __device__ void init(int nM_, int nN_, int G_, int c_) { nM = nM_; nN = nN_; nwg = nM * nN; G = G_; c = c_; }
    __device__ bool next(int i, Unit& u) const {
        const long L = (long)i * G + c; if (L >= nwg) return false;
        int wgid = (int)L; { const int q = nwg / NXCD, r = nwg % NXCD, xcd = wgid % NXCD, off = wgid / NXCD; wgid = (xcd < r ? xcd * (q + 1) : r * (q + 1) + (xcd - r) * q) + off; }
        const int nig = WGM * nN, gid = wgid / nig, fm = gid * WGM, gsz = (nM - fm) < WGM ? (nM - fm) : WGM;
        u.pm = fm + ((wgid % nig) % gsz); u.pn = (wgid % nig) / gsz; return true;
    }
};
struct RemapOrder { StaticOrder b; int from, to;
    __device__ bool next(int i, Unit& u) const { if (!b.next(i, u)) return false; if (u.pn == from) u.pn = to; return true; } };
struct BranchOrder {
    int G, c;
    __device__ bool next(int i, Unit& u) const {
        const int su = (i >> 2) * G + c, n = i & 3; if (su >= (NTM - 1) * 4) return false;
        u.pm = n * NTM + (su >> 2); u.pn = n * 4 + (su & 3); return true;
    }
};

template <class Epi, class Sched>
__device__ __forceinline__ void gemm_phase(LAS unsigned char* lds, const Gemm g, const Sched& S, const Epi& E, const int WAVE_U) {
    int tid_ = TIDX; asm volatile("" : "+v"(tid_)); const int tid = tid_, wid = __builtin_amdgcn_readfirstlane(tid >> 6), lane = tid & 63, wr = wid >> 2, wc = wid & 3, fr = lane & 15, fq = lane >> 4;
    const int K = g.K, nt = K / BK;
    unsigned voffA[2], voffB[2];
#pragma unroll
    for (int i = 0; i < 2; ++i) { int R, C; stage_rc(tid * 16 + i * 8192, R, C); const int Rb = (R & ~31) + perm32(R & 31);
        voffA[i] = (unsigned)(R * K + C) * 2u; voffB[i] = (unsigned)(Rb * K + C) * 2u; }
    const size_t kstep = (size_t)(BK * 2);
    const size_t hstep = (size_t)HALF * K * 2;
    const size_t tstep = 2 * hstep;
    const unsigned ldsw = (unsigned)wid * 1024u;
    const int aoff = lds_byte(wr * 64 + fr, fq * 8), boff = lds_byte(wc * 32 + fr, fq * 8);
#define PG8_SA(b, h) (((b) * 2 + (h)) * HTB)
#define PG8_SB(b, h) ((4 + (b) * 2 + (h)) * HTB)
#define PG8_STAGE(bufoff, gbase, voff) do { _Pragma("unroll") for (int _i = 0; _i < 2; ++_i) \
        __builtin_amdgcn_global_load_lds((const unsigned*)((const char*)(gbase) + (voff)[_i]), (LAS unsigned*)(lds + (bufoff) + ldsw + _i * 8192), 16, 0, 0); } while (0)
#define PG8_LDA(dst, b, h) do { _Pragma("unroll") for (int m = 0; m < 4; ++m) _Pragma("unroll") for (int k = 0; k < 2; ++k) dst[m][k] = *(const LAS bf16x8*)(lds + PG8_SA(b, h) + aoff + m * 2048 + k * 1024); } while (0)
#define PG8_LDB(dst, b, h) do { _Pragma("unroll") for (int n = 0; n < 2; ++n) _Pragma("unroll") for (int k = 0; k < 2; ++k) dst[n][k] = *(const LAS bf16x8*)(lds + PG8_SB(b, h) + boff + n * 2048 + k * 1024); } while (0)
#define PG8_MMA(ai, bj, At, Bt) do { __builtin_amdgcn_s_setprio(1); _Pragma("unroll") for (int m = 0; m < 4; ++m) _Pragma("unroll") for (int n = 0; n < 2; ++n) _Pragma("unroll") for (int k = 0; k < 2; ++k) \
        acc[ai][bj][m][n] = __builtin_amdgcn_mfma_f32_16x16x32_bf16(Bt[n][k], At[m][k], acc[ai][bj][m][n], 0, 0, 0); __builtin_amdgcn_s_setprio(0); } while (0)
#define PG8_WAIT_V(n) asm volatile("s_waitcnt vmcnt(" #n ")" ::: "memory")
#define PG8_WAIT_L(n) asm volatile("s_waitcnt lgkmcnt(" #n ")" ::: "memory")
#define PG8_BAR __builtin_amdgcn_s_barrier()
#define PG8_SCHED __builtin_amdgcn_sched_barrier(0)
    Unit cur, nxt; int ui = 0;
    if (!S.next(0, cur)) return;
    f32x4 acc[2][2][4][2];
#pragma unroll
    for (int a = 0; a < 2; ++a)
#pragma unroll
        for (int b = 0; b < 2; ++b)
#pragma unroll
            for (int m = 0; m < 4; ++m)
#pragma unroll
                for (int n = 0; n < 2; ++n) acc[a][b][m][n] = (f32x4){0.f, 0.f, 0.f, 0.f};
    bf16x8 At[4][2], B0[2][2], B1[2][2];
    const char* cA = (const char*)g.A + (size_t)cur.pm * tstep; const char* cB = (const char*)g.Bt + (size_t)cur.pn * tstep;
    PG8_STAGE(PG8_SB(0, 0), cB, voffB); PG8_STAGE(PG8_SB(0, 1), cB + hstep, voffB); PG8_STAGE(PG8_SA(0, 0), cA, voffA); PG8_STAGE(PG8_SA(0, 1), cA + hstep, voffA);
    if (wr == 1) PG8_BAR;
    PG8_WAIT_V(2); PG8_BAR;
    PG8_STAGE(PG8_SB(1, 0), cB + kstep, voffB); PG8_STAGE(PG8_SA(1, 0), cA + kstep, voffA); PG8_STAGE(PG8_SB(1, 1), cB + hstep + kstep, voffB);
    PG8_WAIT_V(6); PG8_BAR;
    for (;;) {
        const bool has_next = S.next(ui + 1, nxt);
        const char* nA = has_next ? (const char*)g.A + (size_t)nxt.pm * tstep : cA; const char* nB = has_next ? (const char*)g.Bt + (size_t)nxt.pn * tstep : cB;
        for (int t = 0; t < nt; t += 2) {
            const bool last = (t == nt - 2);
            const char* a1 = cA + (size_t)(t + 1) * kstep;
            const char* a2 = last ? nA : cA + (size_t)(t + 2) * kstep; const char* b2 = last ? nB : cB + (size_t)(t + 2) * kstep;
            const char* a3 = a2 + kstep; const char* b3 = b2 + kstep;
            PG8_LDB(B0, 0, 0); PG8_LDB(B1, 0, 1); PG8_SCHED; PG8_LDA(At, 0, 0); PG8_STAGE(PG8_SA(1, 1), a1 + hstep, voffA);
            PG8_WAIT_V(8); PG8_WAIT_L(0); PG8_BAR; PG8_MMA(0, 0, At, B0); PG8_MMA(0, 1, At, B1); PG8_BAR; PG8_SCHED;
            PG8_LDA(At, 0, 1); PG8_STAGE(PG8_SB(0, 0), b2, voffB); PG8_STAGE(PG8_SB(0, 1), b2 + hstep, voffB); PG8_STAGE(PG8_SA(0, 0), a2, voffA);
            PG8_WAIT_V(8); PG8_WAIT_L(0); PG8_BAR; PG8_MMA(1, 0, At, B0); PG8_MMA(1, 1, At, B1); PG8_BAR; PG8_SCHED;
            PG8_LDB(B0, 1, 0); PG8_LDB(B1, 1, 1); PG8_SCHED; PG8_LDA(At, 1, 0); PG8_STAGE(PG8_SA(0, 1), a2 + hstep, voffA);
            PG8_WAIT_V(8); PG8_WAIT_L(0); PG8_BAR; PG8_MMA(0, 0, At, B0); PG8_MMA(0, 1, At, B1); PG8_BAR; PG8_SCHED;
            PG8_LDA(At, 1, 1); PG8_STAGE(PG8_SB(1, 0), b3, voffB); PG8_STAGE(PG8_SB(1, 1), b3 + hstep, voffB); PG8_STAGE(PG8_SA(1, 0), a3, voffA);
            PG8_WAIT_V(8); PG8_WAIT_L(0); PG8_BAR; PG8_MMA(1, 0, At, B0); PG8_MMA(1, 1, At, B1); PG8_BAR; PG8_SCHED;
        }
        if (wr == 0) PG8_BAR;
        E(acc, cur, wr, wc, fr, fq);
        if (!has_next) break;
#pragma unroll
        for (int a = 0; a < 2; ++a)
#pragma unroll
            for (int b = 0; b < 2; ++b)
#pragma unroll
                for (int m = 0; m < 4; ++m)
#pragma unroll
                    for (int n = 0; n < 2; ++n) acc[a][b][m][n] = (f32x4){0.f, 0.f, 0.f, 0.f};
        cur = nxt; cA = nA; cB = nB; ++ui;
        if (wr == 1) PG8_BAR;
    }
    PG8_WAIT_V(0);
    PG8_BAR;
#undef PG8_SA
#undef PG8_SB
#undef PG8_STAGE
#undef PG8_LDA
#undef PG8_LDB
#undef PG8_MMA
#undef PG8_WAIT_V
#undef PG8_WAIT_L
#undef PG8_BAR
#undef PG8_SCHED
}

struct EpiInProj {
    bf16_t* P; const float* ssq; int pn_off;
    __device__ __forceinline__ void operator()(const f32x4 (&acc)[2][2][4][2], const Unit& u, int wr, int wc, int fr, int fq) const {
#pragma unroll
        for (int ai = 0; ai < 2; ++ai)
#pragma unroll
            for (int m = 0; m < 4; ++m) {
                const int row = u.pm * 256 + ai * 128 + wr * 64 + m * 16 + fr;
                const float rs = rsqrtf(ssq_total_q(ssq, row, fq) * (1.f / 1024.f) + 1e-6f);
#pragma unroll
                for (int bj = 0; bj < 2; ++bj) {
                    const int col = (u.pn + pn_off) * 256 + bj * 128 + wc * 32 + 8 * fq;
                    const f32x4 v0 = acc[ai][bj][m][0] * rs, v1 = acc[ai][bj][m][1] * rs;
                    u32x4 w; w.x = pk2(v0[0], v0[1]); w.y = pk2(v0[2], v0[3]); w.z = pk2(v1[0], v1[1]); w.w = pk2(v1[2], v1[3]);
                    *(u32x4*)(P + (size_t)row * NP + col) = w;
                }
            }
    }
};
struct EpiBranch {
    const bf16_t* P; float* Z; bf16_t* ZB;
    __device__ __forceinline__ void operator()(const f32x4 (&acc)[2][2][4][2], const Unit& u, int wr, int wc, int fr, int fq) const {
        const int n = u.pn >> 2, pn = u.pn & 3, pm = u.pm - n * NTM; (void)Z;
#pragma unroll
        for (int ai = 0; ai < 2; ++ai) {
            u32x4 gw[4][2], zo[4][2];
#pragma unroll
            for (int m = 0; m < 4; ++m)
#pragma unroll
                for (int bj = 0; bj < 2; ++bj) { const int row = pm * 256 + ai * 128 + wr * 64 + m * 16 + fr, col = pn * 256 + bj * 128 + wc * 32 + 8 * fq;
                    gw[m][bj] = *(const u32x4*)(P + (size_t)row * NP + OFF_GATE + n * 1024 + col);
                    if (n != 0) zo[m][bj] = *(const u32x4*)(ZB + (size_t)row * DM + col); }
#pragma unroll
            for (int m = 0; m < 4; ++m)
#pragma unroll
                for (int bj = 0; bj < 2; ++bj) { const int row = pm * 256 + ai * 128 + wr * 64 + m * 16 + fr, col = pn * 256 + bj * 128 + wc * 32 + 8 * fq;
                    float gt[8], v[8]; unpack8(gw[m][bj], gt);
#pragma unroll
                    for (int j = 0; j < 4; ++j) { v[j] = sigmoidf_(gt[j]) * acc[ai][bj][m][0][j]; v[4 + j] = sigmoidf_(gt[4 + j]) * acc[ai][bj][m][1][j]; }
                    if (n != 0) { float zf[8]; unpack8(zo[m][bj], zf);
#pragma unroll
                        for (int j = 0; j < 8; ++j) v[j] += zf[j]; }
                    u32x4 w; w.x = pk2(v[0], v[1]); w.y = pk2(v[2], v[3]); w.z = pk2(v[4], v[5]); w.w = pk2(v[6], v[7]); *(u32x4*)(ZB + (size_t)row * DM + col) = w; }
        }
    }
};
struct EpiResid {
    float* S; bf16_t* HN; const float* nw; float* ssq;
    __device__ __forceinline__ void operator()(const f32x4 (&acc)[2][2][4][2], const Unit& u, int wr, int wc, int fr, int fq) const {
#pragma unroll
        for (int ai = 0; ai < 2; ++ai)
#pragma unroll
            for (int m = 0; m < 4; ++m) {
                const int row = u.pm * 256 + ai * 128 + wr * 64 + m * 16 + fr;
                float ss = 0.f;
#pragma unroll
                for (int bj = 0; bj < 2; ++bj) {
                    const int col = u.pn * 256 + bj * 128 + wc * 32 + 8 * fq;
                    float* sp = S + (size_t)row * DM + col;
                    f32x4 s0 = *(const f32x4*)sp, s1 = *(const f32x4*)(sp + 4);
                    s0 += acc[ai][bj][m][0]; s1 += acc[ai][bj][m][1];
                    *(f32x4*)sp = s0; *(f32x4*)(sp + 4) = s1;
                    const f32x4 w0 = *(const f32x4*)(nw + col), w1 = *(const f32x4*)(nw + col + 4);
                    u32x4 w; w.x = pk2(s0[0] * w0[0], s0[1] * w0[1]); w.y = pk2(s0[2] * w0[2], s0[3] * w0[3]); w.z = pk2(s1[0] * w1[0], s1[1] * w1[1]); w.w = pk2(s1[2] * w1[2], s1[3] * w1[3]);
                    *(u32x4*)(HN + (size_t)row * DM + col) = w;
                    ss += (s0[0] * s0[0] + s0[1] * s0[1]) + (s0[2] * s0[2] + s0[3] * s0[3]) + (s1[0] * s1[0] + s1[1] * s1[1]) + (s1[2] * s1[2] + s1[3] * s1[3]);
                }
                ss += __shfl_xor(ss, 16); ss += __shfl_xor(ss, 32);
                if (fq == 0) ssq[(size_t)row * 16 + u.pn * 4 + wc] = ss;
            }
    }
};
struct EpiSwiglu {
    bf16_t* H; const float* ssq;
    __device__ __forceinline__ void operator()(const f32x4 (&acc)[2][2][4][2], const Unit& u, int wr, int wc, int fr, int fq) const {
#pragma unroll
        for (int ai = 0; ai < 2; ++ai)
#pragma unroll
            for (int m = 0; m < 4; ++m) {
                const int row = u.pm * 256 + ai * 128 + wr * 64 + m * 16 + fr;
                const float rs = rsqrtf(ssq_total_q(ssq, row, fq) * (1.f / 1024.f) + 1e-6f);
                float v[8];
#pragma unroll
                for (int n = 0; n < 2; ++n)
#pragma unroll
                    for (int j = 0; j < 4; ++j) { const float gg = acc[ai][0][m][n][j] * rs, uu = acc[ai][1][m][n][j] * rs; v[4 * n + j] = siluf_(gg) * uu; }
                u32x4 w; w.x = pk2(v[0], v[1]); w.y = pk2(v[2], v[3]); w.z = pk2(v[4], v[5]); w.w = pk2(v[6], v[7]);
                *(u32x4*)(H + (size_t)row * FF + u.pn * 128 + wc * 32 + 8 * fq) = w;
            }
    }
};
}

__device__ __forceinline__ bf16x8 ldfrag(const LAS bf16_t* p, int ld, int r, int q) { return *(const LAS bf16x8*)(p + r * ld + q * 8); }
__device__ __forceinline__ bf16x4 ldfrag4(const LAS bf16_t* p, int ld, int r, int q) { return *(const LAS bf16x4*)(p + r * ld + q * 4); }
__device__ __forceinline__ f32x4 mma32(bf16x8 a, bf16x8 b, f32x4 c) { return __builtin_amdgcn_mfma_f32_16x16x32_bf16(a, b, c, 0, 0, 0); }
__device__ __forceinline__ f32x4 mma16(bf16x4 a, bf16x4 b, f32x4 c) { return __builtin_amdgcn_mfma_f32_16x16x16bf16_1k(a, b, c, 0, 0, 0); }
__device__ __forceinline__ bf16x4 cvt4(f32x4 v) { u32x2 w; w.x = pk2(v[0], v[1]); w.y = pk2(v[2], v[3]); return __builtin_bit_cast(bf16x4, w); }
__device__ __forceinline__ bf16x8 scale8(bf16x8 x, const float* f) { const u32x4 w = __builtin_bit_cast(u32x4, x); float v[8]; unpack8(w, v); u32x4 o;
    o.x = pk2(v[0] * f[0], v[1] * f[1]); o.y = pk2(v[2] * f[2], v[3] * f[3]); o.z = pk2(v[4] * f[4], v[5] * f[5]); o.w = pk2(v[6] * f[6], v[7] * f[7]); return __builtin_bit_cast(bf16x8, o); }

struct KP { const float* in[30]; float* out; unsigned char* ws; };

__device__ __forceinline__ void tr_item(const float* W, int N, bf16_t* WT, int ldk, int k0, int n0, int dst_row0, LAS float* scr, int lane) {
#pragma unroll 8
    for (int i = 0; i < 32; ++i) { const int kk = 2 * i + (lane >> 5); const int n = n0 + (lane & 31); scr[kk * 33 + (lane & 31)] = (n < N) ? W[(size_t)(k0 + kk) * N + n] : 0.f; }
    LDS_WAIT(); asm volatile("" ::: "memory");
    const int c = lane & 7;
#pragma unroll
    for (int j = 0; j < 4; ++j) { const int n = (lane >> 3) + 8 * j; const LAS float* s = scr + (8 * c) * 33 + n;
        u32x4 o; o.x = pk2(s[0 * 33], s[1 * 33]); o.y = pk2(s[2 * 33], s[3 * 33]); o.z = pk2(s[4 * 33], s[5 * 33]); o.w = pk2(s[6 * 33], s[7 * 33]);
        if (n0 + n < N) *(u32x4*)(WT + (size_t)(dst_row0 + n) * ldk + k0 + 8 * c) = o; }
    LDS_WAIT(); asm volatile("" ::: "memory");
}
__device__ __forceinline__ void convert_layer(const KP& p, int l, LAS unsigned char* lds, int gw, int NGW, int wave, int lane) {
    asm volatile("" : "+v"(lane)); asm volatile("" : "+v"(wave)); wave = __builtin_amdgcn_readfirstlane(wave);
    LAS float* scr = (LAS float*)(lds + wave * 8448);
    bf16_t* win_t = (bf16_t*)(p.ws + WS_WIN); bf16_t* wing_t = (bf16_t*)(p.ws + WS_WING + (size_t)(l & 1) * WING_SIZE);
    unsigned char* sm = p.ws + WS_WSM + (size_t)(l & 1) * WSM_SIZE;
    bf16_t* br_t = (bf16_t*)(sm + WSM_BR); bf16_t* out_t = (bf16_t*)(sm + WSM_OUT); bf16_t* fi_t = (bf16_t*)(sm + WSM_FI); bf16_t* fo_t = (bf16_t*)(sm + WSM_FO);
    constexpr int NB_IN = (INW + 31) / 32;
    constexpr int I_IN = 16 * NB_IN, I_BR = 4 * 16 * 32, I_OUT = 16 * 32, I_FI = 16 * (2 * FF / 32), I_FO = (FF / 64) * 32;
    constexpr int NITEMS = I_IN + I_BR + I_OUT + I_FI + I_FO;
    for (int it = gw; it < NITEMS; it += NGW) {
        int r = it;
        if (r < I_IN) { const int kb = r / NB_IN, nb = r % NB_IN; const bool gt = nb >= GT0 * 8 && nb < (GT0 + GTN) * 8;
            tr_item(p.in[4] + (size_t)l * DM * INW, INW, gt ? wing_t : win_t, DM, kb * 64, nb * 32, gt ? nb * 32 - GT0 * 256 : nb * 32, scr, lane); continue; } r -= I_IN;
        if (r < I_BR) { const int n = r / 512, rr = r % 512, kb = rr / 32, nb = rr % 32; tr_item(p.in[25] + (size_t)(l * 4 + n) * DM * DM, DM, br_t, DM, kb * 64, nb * 32, n * 1024 + nb * 32, scr, lane); continue; } r -= I_BR;
        if (r < I_OUT) { const int kb = r / 32, nb = r % 32; tr_item(p.in[26] + (size_t)l * DM * DM, DM, out_t, DM, kb * 64, nb * 32, nb * 32, scr, lane); continue; } r -= I_OUT;
        if (r < I_FI) { const int nbn = 2 * FF / 32, kb = r / nbn, nb = r % nbn; const int c0 = nb * 32, bj = c0 / FF, j = c0 % FF, pn = j / 128, rr = j % 128;
            tr_item(p.in[27] + (size_t)l * DM * 2 * FF, 2 * FF, fi_t, DM, kb * 64, c0, 256 * pn + 128 * bj + rr, scr, lane); continue; } r -= I_FI;
        { const int kb = r / 32, nb = r % 32; tr_item(p.in[28] + (size_t)l * FF * DM, DM, fo_t, FF, kb * 64, nb * 32, nb * 32, scr, lane); }
    }
    if (l >= 1) {
        const float* Wv = p.in[4] + (size_t)l * DM * INW + 2048; const float* mu = p.in[5] + (size_t)l * 3328 + 2048; const float* v1 = p.in[12] + (size_t)(l - 1) * DM * 32;
        for (int k = gw; k < DM; k += NGW) {
            float wv[16], m1[16];
#pragma unroll
            for (int m = 0; m < 16; ++m) { const int c = lane + 64 * m; wv[m] = Wv[(size_t)k * INW + c]; m1[m] = mu[c]; }
            for (int j = 0; j < 32; ++j) {
                float e1 = 0.f, e2 = 0.f;
#pragma unroll
                for (int m = 0; m < 16; ++m) { const int c = lane + 64 * m; const float vv = v1[c * 32 + j] * wv[m]; e1 += vv * (1.f - m1[m]); e2 += vv * m1[m]; }
#pragma unroll
                for (int o = 1; o < 64; o <<= 1) { e1 += __shfl_xor(e1, o); e2 += __shfl_xor(e2, o); }
                if (lane == 0) { win_t[(size_t)(OFF_VLO + j) * DM + k] = (bf16_t)f2bf(e1); win_t[(size_t)(OFF_VLO + 32 + j) * DM + k] = (bf16_t)f2bf(e2); }
            }
        }
    }
}


constexpr int XLW = 320;
__device__ __forceinline__ void rwkv_lora_inputs(const KP& p, int l, int gw, int NGW, int lane) {
    const bf16_t* P = (const bf16_t*)(p.ws + WS_P); bf16_t* XLO = (bf16_t*)(p.ws + WS_Z);
    const float* mu = p.in[5] + (size_t)l * 3328 + 3072;
    float muv[4];
#pragma unroll
    for (int j = 0; j < 4; ++j) muv[j] = mu[lane + 64 * j];
    for (int m = gw; m < MMAIN + NMETA; m += NGW) {
        int prev; if (m < MMAIN) prev = ((m & (SEQ - 1)) == 0) ? MMAIN + NMETA - 1 : m - 1; else prev = (m == MMAIN) ? -1 : m - 1;
        const bf16_t* cr = P + (size_t)m * NP; const bf16_t* pr = P + (size_t)(prev < 0 ? m : prev) * NP; const float pz = prev < 0 ? 0.f : 1.f;
        float cur[4], prv[4];
#pragma unroll
        for (int j = 0; j < 4; ++j) { cur[j] = bf2f(cr[3072 + lane + 64 * j]); prv[j] = pz * bf2f(pr[3072 + lane + 64 * j]); }
        float vl = 0.f; if (lane < 32) vl = bf2f(cr[OFF_VLO + lane]) + pz * bf2f(pr[OFF_VLO + 32 + lane]);
        bf16_t* o = XLO + (size_t)m * XLW;
#pragma unroll
        for (int j = 0; j < 4; ++j) { const float val = cur[j] + (prv[j] - cur[j]) * muv[j]; float r_;
            if (j == 0) { const float e2 = __expf(2.f * val); r_ = 1.f - 2.f * __builtin_amdgcn_rcpf(e2 + 1.f); } else if (j == 1) r_ = val; else r_ = __builtin_amdgcn_rcpf(1.f + __expf(-val));
            o[lane + 64 * j] = (bf16_t)f2bf(r_); }
        if (lane < 32) o[256 + lane] = (bf16_t)f2bf(vl);
    }
}

__device__ __forceinline__ void rwkv_unit(const KP& p, int l, int b, int h, LAS unsigned char* lds, const int WAVE_U) {
    int tid = TIDX; asm volatile("" : "+v"(tid)); const int wave = __builtin_amdgcn_readfirstlane(tid >> 6); int lane = tid & 63, r = lane & 15, q = lane >> 4;
#define RELAUNDER() do { asm volatile("" : "+v"(tid)); lane = tid & 63; r = lane & 15; q = lane >> 4; l32 = lane & 31; thalf = lane >> 5; } while (0)
    const bf16_t* P = (const bf16_t*)(p.ws + WS_P);
    bf16_t* YS = (bf16_t*)(p.ws + WS_YS);
    bf16_t* VFG = (bf16_t*)(p.ws + WS_VF); const bf16_t* XLO = (const bf16_t*)(p.ws + WS_Z);
    const float* mu = p.in[5] + (size_t)l * 3328;
    const float* vec = p.in[9] + (size_t)l * 6 * DM;
    const float* rk = p.in[10] + (size_t)l * DM;
    const float* v0 = (l >= 1) ? p.in[11] + (size_t)(l - 1) * DM : nullptr;
    LAS bf16_t* W2T = (LAS bf16_t*)(lds + 0); LAS bf16_t* A2T = (LAS bf16_t*)(lds + 9216); LAS bf16_t* G2T = (LAS bf16_t*)(lds + 18432); LAS bf16_t* V2T = (LAS bf16_t*)(lds + 35840);
    LAS float* MU = (LAS float*)(lds + 40960); LAS float* W0L = (LAS float*)(lds + 42752); LAS float* A0L = W0L + 64; LAS float* V0L = A0L + 64;
    LAS float* BON = (LAS float*)(lds + 43520); LAS float* PC = (LAS float*)(lds + 43648);
    LAS float* RM = (LAS float*)(lds + 44160); LAS float* KM = RM + 2048; LAS float* VM = KM + 2048; LAS float* WD = VM + 2048; LAS float* AG = WD + 2048; LAS float* VG = AG + 2048; LAS float* GL = VG + 2048;
    LAS float* YY = RM; LAS float* KPp = KM; LAS float* VPp = VM; LAS float* APp = AG; LAS float* BPp = VG;
    constexpr int REG = 101504; constexpr int TS = 20;
    LAS bf16_t* RAW = (LAS bf16_t*)(lds + REG);
    LAS bf16_t* XW = (LAS bf16_t*)(lds + 140048); LAS bf16_t* XA = (LAS bf16_t*)(lds + 144656); LAS bf16_t* XG = (LAS bf16_t*)(lds + 149264); LAS bf16_t* XV = (LAS bf16_t*)(lds + 157968);
    constexpr int O_AT = 0, O_RT = 2304, O_BT = 4608, O_KT = 6912, O_BH = 9216, O_KH = 12288, O_VT = 15360, O_MAB = 18432, O_TT = 19712, OPB = 20480;
    { const float* w2g = p.in[6] + (size_t)l * 64 * DM + 64 * h; const float* a2g = p.in[7] + (size_t)l * 64 * DM + 64 * h; const float* g2g = p.in[8] + (size_t)l * 128 * DM + 64 * h;
      for (int idx = tid; idx < 64 * 64; idx += 512) { const int k = idx >> 6, n = idx & 63; W2T[n * 72 + k] = (bf16_t)f2bf(w2g[k * DM + n]); A2T[n * 72 + k] = (bf16_t)f2bf(a2g[k * DM + n]); }
      for (int idx = tid; idx < 128 * 64; idx += 512) { const int k = idx >> 6, n = idx & 63; G2T[n * 136 + k] = (bf16_t)f2bf(g2g[k * DM + n]); }
      if (l >= 1) { const float* v2g = p.in[13] + (size_t)(l - 1) * 32 * DM + 64 * h; for (int idx = tid; idx < 32 * 64; idx += 512) { const int k = idx >> 6, n = idx & 63; V2T[n * 40 + k] = (bf16_t)f2bf(v2g[k * DM + n]); } } }
    if (tid < 192) MU[tid] = mu[(tid >> 6) * 1024 + 64 * h + (tid & 63)];
    if (tid < 64) { W0L[tid] = vec[64 * h + tid]; A0L[tid] = vec[DM + 64 * h + tid]; V0L[tid] = l >= 1 ? v0[64 * h + tid] : 0.f; }
    f32x4 sT[4];
#pragma unroll
    for (int i = 0; i < 4; ++i) sT[i] = (f32x4){0.f, 0.f, 0.f, 0.f};
    int l32 = lane & 31, thalf = lane >> 5; const int hc0 = 64 * h + l32, hc1 = hc0 + 32;
    const float kk_c0 = vec[2 * DM + hc0], ka_c0 = vec[3 * DM + hc0], lnw_c0 = vec[4 * DM + hc0], lnb_c0 = vec[5 * DM + hc0], rk_c0 = rk[hc0];
    const float kk_c1 = vec[2 * DM + hc1], ka_c1 = vec[3 * DM + hc1], lnw_c1 = vec[4 * DM + hc1], lnb_c1 = vec[5 * DM + hc1], rk_c1 = rk[hc1];
    auto trow = [&](int t) -> size_t { return (size_t)row_of(b, t < 0 ? 0 : (t >= TT ? TT - 1 : t)); };
    constexpr int RS = 264;
    const int ra0 = tid, ra1 = tid + 512; const int rr0 = ra0 / 24, pc0 = ra0 % 24, rr1 = ra1 / 24, pc1 = ra1 % 24;
    const int gc0 = (pc0 >> 3) * 1024 + 64 * h + 8 * (pc0 & 7), gc1 = (pc1 >> 3) * 1024 + 64 * h + 8 * (pc1 & 7);
    int xtok[3], xpc[3], xdst[3];
#pragma unroll
    for (int j = 0; j < 3; ++j) { const int xa = tid + 512 * j; xtok[j] = xa / 36; xpc[j] = xa % 36; const int pc = xpc[j], tk = xtok[j];
        xdst[j] = pc < 8 ? 140048 + (tk * 72 + 8 * pc) * 2 : (pc < 16 ? 144656 + (tk * 72 + 8 * (pc - 8)) * 2 : (pc < 32 ? 149264 + (tk * 136 + 8 * (pc - 16)) * 2 : 157968 + (tk * 40 + 8 * (pc - 32)) * 2)); }
    u32x4 pfa0, pfa1, pfv, pfx0, pfx1, pfx2;
#define RWKV_PREFETCH(pn) do { const int t0_ = 32 * (pn) - 1; \
        pfa0 = *(const u32x4*)(P + trow(t0_ + rr0) * NP + gc0); if (t0_ + rr0 < 0) pfa0 = (u32x4){0u, 0u, 0u, 0u}; \
        if (ra1 < 792) pfa1 = *(const u32x4*)(P + trow(t0_ + rr1) * NP + gc1); \
        if (tid < 256) pfv = *(const u32x4*)(VFG + trow(t0_ + 1 + (tid >> 3)) * DM + 64 * h + 8 * (tid & 7)); \
        pfx0 = *(const u32x4*)(XLO + trow(t0_ + 1 + xtok[0]) * XLW + 8 * xpc[0]); pfx1 = *(const u32x4*)(XLO + trow(t0_ + 1 + xtok[1]) * XLW + 8 * xpc[1]); \
        if (tid < 128) pfx2 = *(const u32x4*)(XLO + trow(t0_ + 1 + xtok[2]) * XLW + 8 * xpc[2]); } while (0)
    pfa1 = (u32x4){0u, 0u, 0u, 0u}; pfv = pfa1; pfx2 = pfa1;
    RWKV_PREFETCH(0);
    __syncthreads();
    for (int pp = 0; pp < 129; ++pp) {
        *(LAS u32x4*)(RAW + rr0 * RS + 8 * pc0) = pfa0;
        if (ra1 < 792) *(LAS u32x4*)(RAW + rr1 * RS + 8 * pc1) = pfa1;
        if (tid < 256) *(LAS u32x4*)(RAW + (1 + (tid >> 3)) * RS + 192 + 8 * (tid & 7)) = pfv;
        *(LAS u32x4*)(lds + xdst[0]) = pfx0; *(LAS u32x4*)(lds + xdst[1]) = pfx1; if (tid < 128) *(LAS u32x4*)(lds + xdst[2]) = pfx2;
        if (pp + 1 < 129) RWKV_PREFETCH(pp + 1);
        BAR_LDS();
        RELAUNDER();
        typedef float f32x2 __attribute__((ext_vector_type(2)));
        { unsigned cwv[6], pwv[6]; f32x2 m2v[3];
#pragma unroll
          for (int pj = 0; pj < 6; ++pj) { const int grp = pj % 3, i = 4 * wave + 2 * (pj / 3) + thalf, col = 64 * grp + 2 * l32;
              cwv[pj] = *(const LAS unsigned*)(RAW + (i + 1) * RS + col); pwv[pj] = *(const LAS unsigned*)(RAW + i * RS + col); if (pj < 3) m2v[pj] = *(const LAS f32x2*)(MU + col); }
#pragma unroll
          for (int pj = 0; pj < 6; ++pj) { const int grp = pj % 3, i = 4 * wave + 2 * (pj / 3) + thalf;
              const unsigned cw = cwv[pj], pw = pwv[pj]; const f32x2 m2 = m2v[grp];
              const float c0 = __builtin_bit_cast(float, cw << 16), c1 = __builtin_bit_cast(float, cw & 0xffff0000u), p0 = __builtin_bit_cast(float, pw << 16), p1 = __builtin_bit_cast(float, pw & 0xffff0000u);
              LAS float* dst = grp == 0 ? RM : (grp == 1 ? KM : VM); *(LAS f32x2*)(dst + i * 64 + 2 * l32) = (f32x2){c0 + (p0 - c0) * m2.x, c1 + (p1 - c1) * m2.y}; } }
        RELAUNDER();
        { auto s2_tile = [&](int which, int mt, int nt) { f32x4 acc = (f32x4){0.f, 0.f, 0.f, 0.f};
            if (which == 0) { acc = mma32(ldfrag(XW + 16 * mt * 72, 72, r, q), ldfrag(W2T + nt * 16 * 72, 72, r, q), acc); acc = mma32(ldfrag(XW + 16 * mt * 72 + 32, 72, r, q), ldfrag(W2T + nt * 16 * 72 + 32, 72, r, q), acc); }
            else if (which == 1) { acc = mma32(ldfrag(XA + 16 * mt * 72, 72, r, q), ldfrag(A2T + nt * 16 * 72, 72, r, q), acc); acc = mma32(ldfrag(XA + 16 * mt * 72 + 32, 72, r, q), ldfrag(A2T + nt * 16 * 72 + 32, 72, r, q), acc); }
            else if (which == 2) {
#pragma unroll
                for (int ks = 0; ks < 4; ++ks) acc = mma32(ldfrag(XG + 16 * mt * 136 + 32 * ks, 136, r, q), ldfrag(G2T + nt * 16 * 136 + 32 * ks, 136, r, q), acc); }
            else { acc = mma32(ldfrag(XV + 16 * mt * 40, 40, r, q), ldfrag(V2T + nt * 16 * 40, 40, r, q), acc); }
            const int cc = 16 * nt + r;
#pragma unroll
            for (int j = 0; j < 4; ++j) { const int tok = 16 * mt + 4 * q + j; const float x = acc[j];
                if (which == 0) { const float ex = __expf(-(W0L[cc] + x)); WD[tok * 64 + cc] = __expf(-0.6065306597f * __builtin_amdgcn_rcpf(1.f + ex)); }
                else if (which == 1) AG[tok * 64 + cc] = __builtin_amdgcn_rcpf(1.f + __expf(-(A0L[cc] + x)));
                else if (which == 2) GL[tok * 64 + cc] = x;
                else VG[tok * 64 + cc] = __builtin_amdgcn_rcpf(1.f + __expf(-(V0L[cc] + x))); } };
          if (wave < 4) { const int which = wave >> 1;
#pragma unroll
              for (int mt = 0; mt < 2; ++mt)
#pragma unroll
                  for (int tnt = 0; tnt < 2; ++tnt) s2_tile(which, mt, 2 * (wave & 1) + tnt); }
          else { const int mtg = (wave - 4) >> 1;
#pragma unroll
              for (int tnt = 0; tnt < 2; ++tnt) s2_tile(2, mtg, 2 * (wave & 1) + tnt);
              if (l >= 1) {
#pragma unroll
                  for (int tnt = 0; tnt < 2; ++tnt) s2_tile(3, mtg, 2 * (wave & 1) + tnt); } } }
        BAR_LDS();
        RELAUNDER();
#pragma unroll
        for (int rep = 0; rep < 2; ++rep) { const int tok = 4 * wave + 2 * rep + thalf, e0 = tok * 64 + l32, e1 = e0 + 32;
          const float k0 = KM[e0], k1 = KM[e1], a0 = AG[e0], a1 = AG[e1], vv0 = VM[e0], vv1 = VM[e1], r0 = RM[e0], r1 = RM[e1];
          float kka = k0 * kk_c0, kkb = k1 * kk_c1; float n2 = kka * kka + kkb * kkb;
          const float kp0 = k0 * (1.f + (a0 - 1.f) * ka_c0), kp1 = k1 * (1.f + (a1 - 1.f) * ka_c1);
          float bo = r0 * kp0 * rk_c0 + r1 * kp1 * rk_c1;
          n2 = half_sum32(n2); bo = half_sum32(bo);
          const float inv = rsqrtf(fmaxf(n2, 1e-24f)); kka *= inv; kkb *= inv;
          float vp0 = vv0, vp1 = vv1;
          if (l >= 1) { vp0 = vv0 + (bf2f(RAW[(tok + 1) * RS + 192 + l32]) - vv0) * VG[e0]; vp1 = vv1 + (bf2f(RAW[(tok + 1) * RS + 224 + l32]) - vv1) * VG[e1]; }
          KPp[e0] = kp0; KPp[e1] = kp1; VPp[e0] = vp0; VPp[e1] = vp1; APp[e0] = -kka; APp[e1] = -kkb; BPp[e0] = kka * a0; BPp[e1] = kkb * a1; if (l32 == 0) BON[tok] = bo;
          const int t = 32 * pp + tok;
          if (l == 0 && t < TT) { bf16_t* vf = VFG + (size_t)row_of(b, t) * DM; vf[hc0] = (bf16_t)f2bf(vv0); vf[hc1] = (bf16_t)f2bf(vv1); } }
        BAR_LDS();
        RELAUNDER();
        { const int ch = wave >> 2, i0 = 4 * (wave & 3); LAS unsigned char* ob = lds + REG + ch * OPB;
          LAS bf16_t* AT_ = (LAS bf16_t*)(ob + O_AT); LAS bf16_t* RT_ = (LAS bf16_t*)(ob + O_RT); LAS bf16_t* BTl = (LAS bf16_t*)(ob + O_BT); LAS bf16_t* KTl = (LAS bf16_t*)(ob + O_KT);
          LAS bf16_t* BHt = (LAS bf16_t*)(ob + O_BH); LAS bf16_t* KHt = (LAS bf16_t*)(ob + O_KH); LAS bf16_t* VTt = (LAS bf16_t*)(ob + O_VT);
          float Pv[5]; float run = 1.f;
          const LAS float* wdp = WD + 16 * ch * 64 + lane;
          for (int j = 0; j < i0; ++j) run *= wdp[j * 64];
          Pv[0] = run;
#pragma unroll
          for (int tt = 0; tt < 4; ++tt) { run *= wdp[(i0 + tt) * 64]; Pv[1 + tt] = run; }
          for (int j = i0 + 4; j < 16; ++j) run *= wdp[j * 64];
          const float Pall = run;
          float av[4], bv[4], kv[4], rv[4], vv[4];
#pragma unroll
          for (int tt = 0; tt < 4; ++tt) { const int e = (16 * ch + i0 + tt) * 64 + lane; av[tt] = APp[e]; bv[tt] = BPp[e]; kv[tt] = KPp[e]; rv[tt] = RM[e]; vv[tt] = VPp[e]; }
#pragma unroll
          for (int tt = 0; tt < 4; ++tt) { const int i = i0 + tt; const float Pi = Pv[1 + tt], Pp = Pv[tt]; const float ip = __builtin_amdgcn_rcpf(Pi), hp = Pall * ip;
              AT_[i * 72 + lane] = (bf16_t)f2bf(av[tt] * Pp); RT_[i * 72 + lane] = (bf16_t)f2bf(rv[tt] * Pi); BTl[i * 72 + lane] = (bf16_t)f2bf(bv[tt] * ip); KTl[i * 72 + lane] = (bf16_t)f2bf(kv[tt] * ip);
              BHt[lane * TS + i] = (bf16_t)f2bf(bv[tt] * hp); KHt[lane * TS + i] = (bf16_t)f2bf(kv[tt] * hp); VTt[lane * TS + i] = (bf16_t)f2bf(vv[tt]); }
          if ((wave & 3) == 0) PC[ch * 64 + lane] = Pall; }
        BAR_LDS();
        RELAUNDER();
        bf16x4 nrb4, rhs4, v4; f32x4 Y;
#define RWKV_PRE(ch) do { LAS unsigned char* ob = lds + REG + (ch) * OPB; \
            const LAS bf16_t* AT_ = (const LAS bf16_t*)(ob + O_AT); const LAS bf16_t* RT_ = (const LAS bf16_t*)(ob + O_RT); const LAS bf16_t* BTl = (const LAS bf16_t*)(ob + O_BT); const LAS bf16_t* KTl = (const LAS bf16_t*)(ob + O_KT); \
            const LAS bf16_t* VTt = (const LAS bf16_t*)(ob + O_VT); \
            f32x4 mk = (f32x4){0.f, 0.f, 0.f, 0.f}, nb = mk, nk = mk; \
            _Pragma("unroll") for (int ks = 0; ks < 2; ++ks) { const bf16x8 fa = ldfrag(AT_ + 32 * ks, 72, r, q), fr_ = ldfrag(RT_ + 32 * ks, 72, r, q), fb = ldfrag(BTl + 32 * ks, 72, r, q), fk = ldfrag(KTl + 32 * ks, 72, r, q); \
                mk = mma32(fk, fa, mk); nb = mma32(fb, fr_, nb); nk = mma32(fk, fr_, nk); } \
            _Pragma("unroll") for (int j = 0; j < 4; ++j) { const int s_ = 4 * q + j; if (!(s_ < r)) mk[j] = 0.f; if (!(s_ <= r)) { nb[j] = 0.f; nk[j] = 0.f; } } \
            const bf16x4 mak4 = cvt4(mk), nrk4 = cvt4(nk); nrb4 = cvt4(nb); \
            v4 = ldfrag4(VTt + 16 * wave * TS, TS, r, q); \
            bf16x4 sb[4]; \
            _Pragma("unroll") for (int kt = 0; kt < 4; ++kt) sb[kt] = cvt4(sT[kt]); \
            f32x4 RHS = (f32x4){0.f, 0.f, 0.f, 0.f}; Y = RHS; \
            RHS = mma16(mak4, v4, RHS); Y = mma16(nrk4, v4, Y); \
            _Pragma("unroll") for (int kt = 0; kt < 4; ++kt) { RHS = mma16(ldfrag4(AT_ + 16 * kt, 72, r, q), sb[kt], RHS); Y = mma16(ldfrag4(RT_ + 16 * kt, 72, r, q), sb[kt], Y); } \
            rhs4 = cvt4(RHS); } while (0)
#define RWKV_FIN(ch) do { LAS unsigned char* ob = lds + REG + (ch) * OPB; \
            const LAS bf16_t* BHt = (const LAS bf16_t*)(ob + O_BH); const LAS bf16_t* KHt = (const LAS bf16_t*)(ob + O_KH); const LAS bf16_t* TTm = (const LAS bf16_t*)(ob + O_TT); \
            f32x4 U = (f32x4){0.f, 0.f, 0.f, 0.f}; U = mma16(ldfrag4(TTm, 24, r, q), rhs4, U); \
            const bf16x4 ub = cvt4(U); \
            Y = mma16(nrb4, ub, Y); \
            _Pragma("unroll") for (int j = 0; j < 4; ++j) YY[(16 * (ch) + 4 * q + j) * 64 + 16 * wave + r] = Y[j]; \
            _Pragma("unroll") for (int kt = 0; kt < 4; ++kt) { const f32x4 pc4 = *(const LAS f32x4*)(PC + (ch) * 64 + 16 * kt + 4 * q); f32x4 s_ = sT[kt] * pc4; \
                s_ = mma16(ldfrag4(BHt + 16 * kt * TS, TS, r, q), ub, s_); s_ = mma16(ldfrag4(KHt + 16 * kt * TS, TS, r, q), v4, s_); sT[kt] = s_; } } while (0)
        if (wave == 4 || wave == 5) { LAS unsigned char* ob = lds + REG + (wave - 4) * OPB;
            const LAS bf16_t* AT_ = (const LAS bf16_t*)(ob + O_AT); const LAS bf16_t* BTl = (const LAS bf16_t*)(ob + O_BT); LAS bf16_t* TTm = (LAS bf16_t*)(ob + O_TT);
            const f32x4 z4 = (f32x4){0.f, 0.f, 0.f, 0.f}; f32x4 n = z4, nt = z4, eye;
#pragma unroll
            for (int ks = 0; ks < 2; ++ks) { const bf16x8 fa = ldfrag(AT_ + 32 * ks, 72, r, q), fb = ldfrag(BTl + 32 * ks, 72, r, q); n = mma32(fa, fb, n); nt = mma32(fb, fa, nt); }
#pragma unroll
            for (int j = 0; j < 4; ++j) { const int i_ = 4 * q + j; if (!(r < i_)) n[j] = 0.f; if (!(i_ < r)) nt[j] = 0.f; eye[j] = (i_ == r) ? 1.f : 0.f; }
            const bf16x4 nB = cvt4(n), nA = cvt4(nt);
            const f32x4 n2 = mma16(nA, nB, z4), n2t = mma16(nB, nA, z4); const bf16x4 n2B = cvt4(n2), n2A = cvt4(n2t);
            const f32x4 n4 = mma16(n2A, n2B, z4), n4t = mma16(n2B, n2A, z4); const bf16x4 n4B = cvt4(n4), n4A = cvt4(n4t);
            const f32x4 n3 = mma16(nA, n2B, z4), n3t = mma16(n2B, nA, z4);
            const f32x4 n8 = mma16(n4A, n4B, z4); const f32x4 n12 = mma16(n4A, cvt4(n8), z4);
            const f32x4 p1 = ((eye + n) + (n2 + n3)), p1t = ((eye + nt) + (n2t + n3t)), rr = (n4 + n8) + n12;
            const f32x4 tt = mma16(cvt4(p1t), cvt4(rr), p1);
#pragma unroll
            for (int j = 0; j < 4; ++j) TTm[(4 * q + j) * 24 + r] = (bf16_t)f2bf(tt[j]); }
        else if (wave < 4) RWKV_PRE(0);
        BAR_LDS();
        RELAUNDER();
        if (wave < 4) { RWKV_FIN(0); RWKV_PRE(1); RWKV_FIN(1); }
        BAR_LDS();
#undef RWKV_PRE
#undef RWKV_FIN
        RELAUNDER();
#pragma unroll
        for (int rep = 0; rep < 2; ++rep) { const int tok = 4 * wave + 2 * rep + thalf, e0 = tok * 64 + l32, e1 = e0 + 32; const float y0 = YY[e0], y1 = YY[e1];
          float s1 = y0 + y1, s2 = y0 * y0 + y1 * y1;
          s1 = half_sum32(s1); s2 = half_sum32(s2);
          const float mean = s1 * (1.f / 64.f), var = fmaxf(s2 * (1.f / 64.f) - mean * mean, 0.f), rs = rsqrtf(var + 64e-5f), bon = BON[tok];
          const float o0 = ((y0 - mean) * rs * lnw_c0 + lnb_c0 + bon * VPp[e0]) * GL[e0], o1 = ((y1 - mean) * rs * lnw_c1 + lnb_c1 + bon * VPp[e1]) * GL[e1];
          const int t = 32 * pp + tok;
          if (t < TT) { bf16_t* yo = YS + (size_t)row_of(b, t) * DM; yo[hc0] = (bf16_t)f2bf(o0); yo[hc1] = (bf16_t)f2bf(o1); } }
    }
#undef RWKV_PREFETCH
#undef RELAUNDER
    __syncthreads();
}

__device__ __forceinline__ int swz72(int row, int chunk) { return row * 72 + (((chunk ^ (row >> 3)) & 7) << 3); }
__device__ __forceinline__ void ssd_unit(const KP& p, int l, int b, int g, LAS unsigned char* lds, const int WAVE_U) {
    int tid = TIDX; asm volatile("" : "+v"(tid)); const int wave = __builtin_amdgcn_readfirstlane(tid >> 6); int lane = tid & 63, r = lane & 15, q = lane >> 4;
#define RELAUNDER() do { asm volatile("" : "+v"(tid)); lane = tid & 63; r = lane & 15; q = lane >> 4; } while (0)
    const bf16_t* P = (const bf16_t*)(p.ws + WS_P);
    bf16_t* YS1 = (bf16_t*)(p.ws + WS_YS) + (size_t)1 * MP * DM;
    const float* conv_w = p.in[14] + (size_t)l * 4 * 2048; const float* conv_b = p.in[15] + (size_t)l * 2048;
    const float* dt_bias = p.in[16] + l * 16; const float* a_log = p.in[17] + l * 16; const float* dsk = p.in[18] + l * 16; const float* normw = p.in[19] + (size_t)l * DM;
    LAS bf16_t* Cm = (LAS bf16_t*)(lds + 0); LAS bf16_t* Bm = (LAS bf16_t*)(lds + 17408); LAS bf16_t* BT = (LAS bf16_t*)(lds + 34816); LAS bf16_t* CB = (LAS bf16_t*)(lds + 53248);
    LAS bf16_t* XT = (LAS bf16_t*)(lds + 62464); LAS float* ACU = (LAS float*)(lds + 99328); LAS float* DTV = (LAS float*)(lds + 100352); LAS float* RED = (LAS float*)(lds + 101376); LAS bf16_t* YL = (LAS bf16_t*)(lds + 103424); (void)RED;
    const int e = wave >> 1, ptb = 2 * (wave & 1);
    f32x4 st[8][2];
#pragma unroll
    for (int i = 0; i < 8; ++i) { st[i][0] = (f32x4){0.f, 0.f, 0.f, 0.f}; st[i][1] = (f32x4){0.f, 0.f, 0.f, 0.f}; }
    const float De = dsk[4 * g + e];
    unsigned short dtraw = 0;
#define SSD_DT_PREFETCH(cn) do { if (tid < 256) { const int t = 64 * (cn) - 48 + (tid & 63); dtraw = P[(size_t)row_of(b, t >= 0 ? t : 0) * NP + OFF_SSM + 3072 + 4 * g + (tid >> 6)]; } } while (0)
    SSD_DT_PREFETCH(0);
    for (int c = 0; c < 65; ++c) {
        RELAUNDER();
        if (tid < 256) { const int ee = wave, t = 64 * c - 48 + lane; float dtv = 0.f;
            if (t >= 0) dtv = softplusf_(bf2f(dtraw) + dt_bias[4 * g + ee]);
            float a = -dtv * __expf(a_log[4 * g + ee]);
#pragma unroll
            for (int off = 1; off < 64; off <<= 1) { const float v = __shfl_up(a, off); if (lane >= off) a += v; }
            ACU[ee * 64 + lane] = a; DTV[ee * 64 + lane] = dtv; }
        { const int cgp = tid & 63, tg = tid >> 6;
          const int xbc_idx = cgp < 32 ? 256 * g + 8 * cgp : (cgp < 48 ? 1024 + 128 * g + 8 * (cgp - 32) : 1536 + 128 * g + 8 * (cgp - 48));
          const int pcol = OFF_SSM + 1024 + xbc_idx;
          typedef float f32x2 __attribute__((ext_vector_type(2)));
          f32x2 cw0[4], cw1[4], cw2[4], cw3[4], cb[4]; u32x4 raw[11]; unsigned pk[8][4];
          const int i0 = 8 * tg, t0 = 64 * c - 48 + i0;
#pragma unroll
          for (int j = 0; j < 11; ++j) { const int t = t0 - 3 + j; raw[j] = *(const u32x4*)(P + (size_t)row_of(b, t >= 0 ? t : 0) * NP + pcol); if (t < 0) raw[j] = (u32x4){0u, 0u, 0u, 0u}; }
#pragma unroll
          for (int m = 0; m < 4; ++m) { cw0[m] = *(const f32x2*)(conv_w + xbc_idx + 2 * m); cw1[m] = *(const f32x2*)(conv_w + 2048 + xbc_idx + 2 * m); cw2[m] = *(const f32x2*)(conv_w + 4096 + xbc_idx + 2 * m);
              cw3[m] = *(const f32x2*)(conv_w + 6144 + xbc_idx + 2 * m); cb[m] = *(const f32x2*)(conv_b + xbc_idx + 2 * m); }
#define UNPK2(RW, VV) do { const u32x4 rw_ = (RW); VV[0] = (f32x2){__builtin_bit_cast(float, rw_[0] << 16), __builtin_bit_cast(float, rw_[0] & 0xffff0000u)}; VV[1] = (f32x2){__builtin_bit_cast(float, rw_[1] << 16), __builtin_bit_cast(float, rw_[1] & 0xffff0000u)}; \
                           VV[2] = (f32x2){__builtin_bit_cast(float, rw_[2] << 16), __builtin_bit_cast(float, rw_[2] & 0xffff0000u)}; VV[3] = (f32x2){__builtin_bit_cast(float, rw_[3] << 16), __builtin_bit_cast(float, rw_[3] & 0xffff0000u)}; } while (0)
          f32x2 x0[4], x1[4], x2[4];
          UNPK2(raw[0], x0); UNPK2(raw[1], x1); UNPK2(raw[2], x2);
#pragma unroll
          for (int i2 = 0; i2 < 4; ++i2) { f32x2 oa[4], ob[4];
#pragma unroll
              for (int hh = 0; hh < 2; ++hh) { const int ii = 2 * i2 + hh, t = t0 + ii; f32x2 x3[4];
                  UNPK2(raw[ii + 3], x3);
#pragma unroll
                  for (int m = 0; m < 4; ++m) { const f32x2 z = cb[m] + cw0[m] * x0[m] + cw1[m] * x1[m] + cw2[m] * x2[m] + cw3[m] * x3[m]; f32x2 o;
                      o.x = z.x * __builtin_amdgcn_rcpf(1.f + __expf(-z.x)); o.y = z.y * __builtin_amdgcn_rcpf(1.f + __expf(-z.y)); if (t < 0) o = (f32x2){0.f, 0.f};
                      if (hh == 0) oa[m] = o; else ob[m] = o;
                      x0[m] = x1[m]; x1[m] = x2[m]; x2[m] = x3[m]; }
                  if (cgp >= 32) { const f32x2* o = hh == 0 ? oa : ob; u32x4 w; w.x = pk2(o[0].x, o[0].y); w.y = pk2(o[1].x, o[1].y); w.z = pk2(o[2].x, o[2].y); w.w = pk2(o[3].x, o[3].y);
                      if (cgp < 48) *(LAS u32x4*)(Bm + (i0 + ii) * 136 + 8 * (cgp - 32)) = w; else *(LAS u32x4*)(Cm + (i0 + ii) * 136 + 8 * (cgp - 48)) = w; } }
#pragma unroll
              for (int m = 0; m < 4; ++m) { pk[2 * m][i2] = pk2(oa[m].x, ob[m].x); pk[2 * m + 1][i2] = pk2(oa[m].y, ob[m].y); } }
#undef UNPK2
          if (cgp < 48) { LAS bf16_t* dstT = cgp < 32 ? XT : BT; const int rb = cgp < 32 ? 8 * cgp : 8 * (cgp - 32);
#pragma unroll
              for (int k = 0; k < 8; ++k) *(LAS u32x4*)(dstT + swz72(rb + k, tg)) = (u32x4){pk[k][0], pk[k][1], pk[k][2], pk[k][3]}; } }
        BAR_LDS();
        RELAUNDER();
        { const int mt = wave & 3;
#pragma unroll
          for (int tn = 0; tn < 2; ++tn) { const int nt = 2 * (wave >> 2) + tn; f32x4 acc = (f32x4){0.f, 0.f, 0.f, 0.f};
#pragma unroll
              for (int ks = 0; ks < 4; ++ks) acc = mma32(ldfrag(Cm + 16 * mt * 136 + 32 * ks, 136, r, q), ldfrag(Bm + 16 * nt * 136 + 32 * ks, 136, r, q), acc);
#pragma unroll
              for (int j = 0; j < 4; ++j) CB[(16 * mt + 4 * q + j) * 72 + 16 * nt + r] = (bf16_t)f2bf(acc[j]); } }
        BAR_LDS();
        RELAUNDER();
        SSD_DT_PREFETCH(c + 1 < 65 ? c + 1 : 64);
        f32x4 acc1[4][2];
#pragma unroll
        for (int lt = 0; lt < 4; ++lt) { acc1[lt][0] = (f32x4){0.f, 0.f, 0.f, 0.f}; acc1[lt][1] = acc1[lt][0]; }
        const LAS float* acu = ACU + e * 64; const LAS float* dtv = DTV + e * 64;
#pragma unroll
        for (int nt = 0; nt < 8; ++nt) { const bf16x4 sb0 = cvt4(st[nt][0]), sb1 = cvt4(st[nt][1]);
#pragma unroll
            for (int lt = 0; lt < 4; ++lt) { const bf16x4 a4 = ldfrag4(Cm + 16 * lt * 136 + 16 * nt, 136, r, q); acc1[lt][0] = mma16(a4, sb0, acc1[lt][0]); acc1[lt][1] = mma16(a4, sb1, acc1[lt][1]); }
            __builtin_amdgcn_sched_barrier(0); }
#pragma unroll
        for (int lt = 0; lt < 4; ++lt)
#pragma unroll
            for (int j = 0; j < 4; ++j) { const float ea = __expf(acu[16 * lt + 4 * q + j]); acc1[lt][0][j] *= ea; acc1[lt][1][j] *= ea; }
#pragma unroll
        for (int lt = 0; lt < 4; ++lt)
#pragma unroll
            for (int ks = 0; ks < 2; ++ks) { if (ks == 1 && lt < 2) continue;
                const bf16x8 fr0 = ldfrag(CB + 16 * lt * 72 + 32 * ks, 72, r, q); const int ll = 16 * lt + r; const float al = acu[ll]; float f[8];
                const f32x4 ac0 = *(const LAS f32x4*)(acu + 32 * ks + 8 * q), ac1 = *(const LAS f32x4*)(acu + 32 * ks + 8 * q + 4), dt0 = *(const LAS f32x4*)(dtv + 32 * ks + 8 * q), dt1 = *(const LAS f32x4*)(dtv + 32 * ks + 8 * q + 4);
#pragma unroll
                for (int i = 0; i < 8; ++i) { const int s = 32 * ks + 8 * q + i; const float as_ = i < 4 ? ac0[i & 3] : ac1[i & 3], ds_ = i < 4 ? dt0[i & 3] : dt1[i & 3]; f[i] = (s <= ll) ? __expf(al - as_) * ds_ : 0.f; }
                const bf16x8 fm = scale8(fr0, f);
#pragma unroll
                for (int pt = 0; pt < 2; ++pt) acc1[lt][pt] = mma32(fm, *(const LAS bf16x8*)(XT + swz72(64 * e + 16 * (ptb + pt) + r, 4 * ks + q)), acc1[lt][pt]);
                __builtin_amdgcn_sched_barrier(0); }
#pragma unroll
        for (int lt = 0; lt < 4; ++lt)
#pragma unroll
            for (int j = 0; j < 4; ++j) { const int ll = 16 * lt + 4 * q + j;
#pragma unroll
                for (int pt = 0; pt < 2; ++pt) { const int pp = 16 * (ptb + pt) + r; YL[ll * 264 + 64 * e + pp] = (bf16_t)f2bf(acc1[lt][pt][j] + De * bf2f(XT[swz72(64 * e + pp, ll >> 3) + (ll & 7)])); } }
        u32x4 zreg[4];
#pragma unroll
        for (int rep = 0; rep < 4; ++rep) { const int idx = tid + 512 * rep, ll = idx >> 5, grp = idx & 31, t = 64 * c - 48 + ll;
            zreg[rep] = *(const u32x4*)(P + (size_t)row_of(b, t >= 0 ? t : 0) * NP + OFF_SSM + 256 * g + 8 * grp); }
        { const float a63 = acu[63], sc = __expf(a63); bf16x8 fx[2][2];
#pragma unroll
          for (int pt = 0; pt < 2; ++pt)
#pragma unroll
              for (int ks = 0; ks < 2; ++ks) { float f[8];
                  const f32x4 ac0 = *(const LAS f32x4*)(acu + 32 * ks + 8 * q), ac1 = *(const LAS f32x4*)(acu + 32 * ks + 8 * q + 4), dt0 = *(const LAS f32x4*)(dtv + 32 * ks + 8 * q), dt1 = *(const LAS f32x4*)(dtv + 32 * ks + 8 * q + 4);
#pragma unroll
                  for (int i = 0; i < 8; ++i) { const float as_ = i < 4 ? ac0[i & 3] : ac1[i & 3], ds_ = i < 4 ? dt0[i & 3] : dt1[i & 3]; f[i] = __expf(a63 - as_) * ds_; }
                  fx[pt][ks] = scale8(*(const LAS bf16x8*)(XT + swz72(64 * e + 16 * (ptb + pt) + r, 4 * ks + q)), f); }
#pragma unroll
          for (int nt = 0; nt < 8; ++nt) { const bf16x8 b0 = *(const LAS bf16x8*)(BT + swz72(16 * nt + r, q)), b1 = *(const LAS bf16x8*)(BT + swz72(16 * nt + r, 4 + q));
#pragma unroll
              for (int pt = 0; pt < 2; ++pt) { f32x4 s_ = st[nt][pt] * sc; s_ = mma32(b0, fx[pt][0], s_); s_ = mma32(b1, fx[pt][1], s_); st[nt][pt] = s_; }
              __builtin_amdgcn_sched_barrier(0); } }
        BAR_LDS();
        RELAUNDER();
#pragma unroll
        for (int rep = 0; rep < 4; ++rep) { const int idx = tid + 512 * rep, ll = idx >> 5, grp = idx & 31, t = 64 * c - 48 + ll; float y[8], zz[8];
            unpack8(*(const LAS u32x4*)(YL + ll * 264 + 8 * grp), y);
            const size_t row = (size_t)row_of(b, t >= 0 ? t : 0);
            unpack8(zreg[rep], zz);
            float ss = 0.f;
#pragma unroll
            for (int k = 0; k < 8; ++k) { y[k] *= siluf_(zz[k]); ss += y[k] * y[k]; }
            ss += __shfl_xor(ss, 1); ss += __shfl_xor(ss, 2); ss += __shfl_xor(ss, 4); ss += __shfl_xor(ss, 8); ss += __shfl_xor(ss, 16);
            const float rs = rsqrtf(ss * (1.f / 256.f) + 1e-5f); const float* nwp = normw + 256 * g + 8 * grp;
            u32x4 w; w.x = pk2(y[0] * rs * nwp[0], y[1] * rs * nwp[1]); w.y = pk2(y[2] * rs * nwp[2], y[3] * rs * nwp[3]); w.z = pk2(y[4] * rs * nwp[4], y[5] * rs * nwp[5]); w.w = pk2(y[6] * rs * nwp[6], y[7] * rs * nwp[7]);
            if (t >= 0) *(u32x4*)(YS1 + row * DM + 256 * g + 8 * grp) = w; }
        BAR_LDS();
    }
}
#undef RELAUNDER
#undef SSD_DT_PREFETCH

__device__ __forceinline__ void ret_unit(const KP& p, int b, int h, LAS unsigned char* lds, const int WAVE_U) {
    int tid_ = TIDX; asm volatile("" : "+v"(tid_)); const int tid = tid_, wave = __builtin_amdgcn_readfirstlane(tid >> 6), lane = tid & 63, r = lane & 15, q = lane >> 4;
    const bf16_t* P = (const bf16_t*)(p.ws + WS_P);
    bf16_t* YS2 = (bf16_t*)(p.ws + WS_YS) + (size_t)2 * MP * DM;
    LAS bf16_t* Q = (LAS bf16_t*)(lds + 0); LAS bf16_t* K = (LAS bf16_t*)(lds + 9216); LAS bf16_t* KT = (LAS bf16_t*)(lds + 18432); LAS bf16_t* VT = (LAS bf16_t*)(lds + 27648);
    LAS bf16_t* CB = (LAS bf16_t*)(lds + 46080); LAS bf16_t* YL = (LAS bf16_t*)(lds + 57344);
    const float lg0 = log2f(1.f - exp2f(-5.f - (float)h));
    f32x4 st[4];
#pragma unroll
    for (int i = 0; i < 4; ++i) st[i] = (f32x4){0.f, 0.f, 0.f, 0.f};
    const int f_ = tid & 31, it = tid >> 5; const float freq = powf(10000.f, -(float)f_ / 32.f);
    float lg = lg0;
    for (int c = 0; c < 65; ++c) {
        asm volatile("" : "+v"(lg));
        u32x4 greg[2];
#pragma unroll
        for (int rep = 0; rep < 2; ++rep) { const int idx = tid + 512 * rep, ll = idx >> 4, grp = idx & 15, t = 64 * c - 48 + ll;
            greg[rep] = *(const u32x4*)(P + (size_t)row_of(b, t >= 0 ? t : 0) * NP + OFF_RET + 2048 + 128 * h + 8 * grp); }
#pragma unroll
        for (int rep = 0; rep < 4; ++rep) { const int i = it + 16 * rep, t = 64 * c - 48 + i; float qa = 0.f, qb = 0.f, ka = 0.f, kb = 0.f;
            { const bf16_t* pr = P + (size_t)row_of(b, t >= 0 ? t : 0) * NP + OFF_RET + 64 * h + f_; const float vz = t >= 0 ? 1.f : 0.f; const float q1 = vz * bf2f(pr[0]), q2 = vz * bf2f(pr[32]), k1 = vz * bf2f(pr[512]), k2 = vz * bf2f(pr[544]);
                double rv = (double)((float)t * freq) * 0.15915494309189535; rv -= __builtin_rint(rv); const float rf = (float)rv; const float sn = __builtin_amdgcn_sinf(rf), cs = __builtin_amdgcn_cosf(rf); qa = q1 * cs - q2 * sn; qb = q2 * cs + q1 * sn; ka = (k1 * cs - k2 * sn) * 0.125f; kb = (k2 * cs + k1 * sn) * 0.125f; }
            Q[i * 72 + f_] = (bf16_t)f2bf(qa); Q[i * 72 + 32 + f_] = (bf16_t)f2bf(qb); const bf16_t kab = (bf16_t)f2bf(ka), kbb = (bf16_t)f2bf(kb);
            K[i * 72 + f_] = kab; K[i * 72 + 32 + f_] = kbb; KT[f_ * 72 + i] = kab; KT[(f_ + 32) * 72 + i] = kbb; }
#pragma unroll
        for (int rep = 0; rep < 2; ++rep) { const int idx = tid + 512 * rep, i = idx >> 4, grp = idx & 15, t = 64 * c - 48 + i; u32x4 w = (u32x4){0u, 0u, 0u, 0u};
            w = *(const u32x4*)(P + (size_t)row_of(b, t >= 0 ? t : 0) * NP + OFF_RET + 1024 + 128 * h + 8 * grp); if (t < 0) w = (u32x4){0u, 0u, 0u, 0u};
            LAS bf16_t* d = VT + (8 * grp) * 72 + i;
            d[0] = (bf16_t)(w.x & 0xffffu); d[72] = (bf16_t)(w.x >> 16); d[144] = (bf16_t)(w.y & 0xffffu); d[216] = (bf16_t)(w.y >> 16);
            d[288] = (bf16_t)(w.z & 0xffffu); d[360] = (bf16_t)(w.z >> 16); d[432] = (bf16_t)(w.w & 0xffffu); d[504] = (bf16_t)(w.w >> 16); }
        BAR_LDS();
        { const int mt = wave & 3;
#pragma unroll
          for (int tn = 0; tn < 2; ++tn) { const int nt = 2 * (wave >> 2) + tn; f32x4 acc = (f32x4){0.f, 0.f, 0.f, 0.f};
#pragma unroll
              for (int ks = 0; ks < 2; ++ks) acc = mma32(ldfrag(Q + 16 * mt * 72 + 32 * ks, 72, r, q), ldfrag(K + 16 * nt * 72 + 32 * ks, 72, r, q), acc);
#pragma unroll
              for (int j = 0; j < 4; ++j) CB[(16 * mt + 4 * q + j) * 72 + 16 * nt + r] = (bf16_t)f2bf(acc[j]); } }
        BAR_LDS();
        f32x4 acc1[4];
#pragma unroll
        for (int lt = 0; lt < 4; ++lt) acc1[lt] = (f32x4){0.f, 0.f, 0.f, 0.f};
#pragma unroll
        for (int dt = 0; dt < 4; ++dt) { const bf16x4 sb = cvt4(st[dt]);
#pragma unroll
            for (int lt = 0; lt < 4; ++lt) acc1[lt] = mma16(ldfrag4(Q + 16 * lt * 72 + 16 * dt, 72, r, q), sb, acc1[lt]); }
#pragma unroll
        for (int lt = 0; lt < 4; ++lt)
#pragma unroll
            for (int j = 0; j < 4; ++j) acc1[lt][j] *= __builtin_amdgcn_exp2f((float)(16 * lt + 4 * q + j + 1) * lg);
#pragma unroll
        for (int lt = 0; lt < 4; ++lt)
#pragma unroll
            for (int ks = 0; ks < 2; ++ks) { if (ks == 1 && lt < 2) continue;
                const int ll = 16 * lt + r; float f[8];
#pragma unroll
                for (int i = 0; i < 8; ++i) { const int s = 32 * ks + 8 * q + i; f[i] = (s <= ll) ? __builtin_amdgcn_exp2f((float)(ll - s) * lg) : 0.f; }
                acc1[lt] = mma32(scale8(ldfrag(CB + 16 * lt * 72 + 32 * ks, 72, r, q), f), ldfrag(VT + 16 * wave * 72 + 32 * ks, 72, r, q), acc1[lt]); }
#pragma unroll
        for (int lt = 0; lt < 4; ++lt)
#pragma unroll
            for (int j = 0; j < 4; ++j) YL[(16 * lt + 4 * q + j) * 136 + 16 * wave + r] = (bf16_t)f2bf(acc1[lt][j]);
        { const float sc = __builtin_amdgcn_exp2f(64.f * lg); bf16x8 fv[2];
#pragma unroll
          for (int ks = 0; ks < 2; ++ks) { float f[8];
#pragma unroll
              for (int i = 0; i < 8; ++i) f[i] = __builtin_amdgcn_exp2f((float)(63 - (32 * ks + 8 * q + i)) * lg);
              fv[ks] = scale8(ldfrag(VT + 16 * wave * 72 + 32 * ks, 72, r, q), f); }
#pragma unroll
          for (int dt = 0; dt < 4; ++dt) { f32x4 s_ = st[dt] * sc; s_ = mma32(ldfrag(KT + 16 * dt * 72, 72, r, q), fv[0], s_); s_ = mma32(ldfrag(KT + 16 * dt * 72 + 32, 72, r, q), fv[1], s_); st[dt] = s_; } }
        BAR_LDS();
#pragma unroll
        for (int rep = 0; rep < 2; ++rep) { const int idx = tid + 512 * rep, ll = idx >> 4, grp = idx & 15, t = 64 * c - 48 + ll; float y[8], gg[8];
            unpack8(*(const LAS u32x4*)(YL + ll * 136 + 8 * grp), y);
            const size_t row = (size_t)row_of(b, t >= 0 ? t : 0);
            unpack8(greg[rep], gg);
            float ss = 0.f;
#pragma unroll
            for (int k = 0; k < 8; ++k) ss += y[k] * y[k];
            ss += __shfl_xor(ss, 1); ss += __shfl_xor(ss, 2); ss += __shfl_xor(ss, 4); ss += __shfl_xor(ss, 8);
            const float rs = rsqrtf(ss * (1.f / 128.f) + 1e-6f);
            u32x4 w; w.x = pk2(siluf_(gg[0]) * y[0] * rs, siluf_(gg[1]) * y[1] * rs); w.y = pk2(siluf_(gg[2]) * y[2] * rs, siluf_(gg[3]) * y[3] * rs);
            w.z = pk2(siluf_(gg[4]) * y[4] * rs, siluf_(gg[5]) * y[5] * rs); w.w = pk2(siluf_(gg[6]) * y[6] * rs, siluf_(gg[7]) * y[7] * rs);
            if (t >= 0) *(u32x4*)(YS2 + row * DM + 128 * h + 8 * grp) = w; }
        BAR_LDS();
    }
}

__device__ __forceinline__ void lru_unit(const KP& p, int l, int b, int n, int hf, LAS unsigned char* lds, const int WAVE_U) {
    int tid_ = TIDX; asm volatile("" : "+v"(tid_)); const int tid = tid_, wave = __builtin_amdgcn_readfirstlane(tid >> 6), lane = tid & 63, r = lane & 15, q = lane >> 4;
    const bf16_t* P = (const bf16_t*)(p.ws + WS_P);
    bf16_t* YS3 = (bf16_t*)(p.ws + WS_YS) + (size_t)3 * MP * DM;
    const float* conv_w = p.in[20] + (size_t)l * 4 * DM; const float* conv_b = p.in[21] + (size_t)l * DM;
    const float* wg = p.in[22] + (size_t)l * 2 * 8 * 128 * 128; const float* bg = p.in[23] + (size_t)l * 2 * DM; const float* lam = p.in[24] + (size_t)l * DM;
    LAS bf16_t* WGT = (LAS bf16_t*)(lds + 0); LAS bf16_t* XC = (LAS bf16_t*)(lds + 34816); LAS float* AA = (LAS float*)(lds + 52224); LAS float* UU = (LAS float*)(lds + 68608);
    LAS float* SEG = (LAS float*)(lds + 84992); LAS float* CAR = (LAS float*)(lds + 89088);
    for (int idx = tid; idx < 2 * 64 * 128; idx += 512) { const int k = idx >> 13, rem = idx & 8191, cc = rem >> 6, e = rem & 63;
        WGT[(k * 64 + e) * 136 + cc] = (bf16_t)f2bf(wg[((size_t)(k * 8 + n) * 128 + cc) * 128 + 64 * hf + e]); }
    if (tid < 64) CAR[tid] = 0.f;
    const int cgp = tid & 15, tg = tid >> 4, cb8 = 128 * n + 8 * cgp, pcol = OFF_LRU + 1024 + cb8;
    const int chs = 128 * n + 64 * hf + (tid & 63), seg = tid >> 6;
    __syncthreads();
    for (int c = 0; c < 65; ++c) {
        unsigned short yin[8];
#pragma unroll
        for (int i = 0; i < 8; ++i) { const int t = 64 * c - 48 + 8 * seg + i; yin[i] = P[(size_t)row_of(b, t >= 0 ? t : 0) * NP + OFF_LRU + chs]; }
        { float cw0[8], cw1[8], cw2[8], cw3[8], cb[8]; u32x4 raw[5];
          const int i0 = 2 * tg, t0 = 64 * c - 48 + i0;
#pragma unroll
          for (int j = 0; j < 5; ++j) { const int t = t0 - 3 + j; raw[j] = *(const u32x4*)(P + (size_t)row_of(b, t >= 0 ? t : 0) * NP + pcol); if (t < 0) raw[j] = (u32x4){0u, 0u, 0u, 0u}; }
#pragma unroll
          for (int k = 0; k < 8; ++k) { cw0[k] = conv_w[cb8 + k]; cw1[k] = conv_w[DM + cb8 + k]; cw2[k] = conv_w[2 * DM + cb8 + k]; cw3[k] = conv_w[3 * DM + cb8 + k]; cb[k] = conv_b[cb8 + k]; }
#pragma unroll
          for (int ii = 0; ii < 2; ++ii) { const int t = t0 + ii, i = i0 + ii; float x0[8], x1[8], x2[8], x3[8], o[8];
              unpack8(raw[ii], x0); unpack8(raw[ii + 1], x1); unpack8(raw[ii + 2], x2); unpack8(raw[ii + 3], x3);
#pragma unroll
              for (int k = 0; k < 8; ++k) { const float z = cb[k] + cw0[k] * x0[k] + cw1[k] * x1[k] + cw2[k] * x2[k] + cw3[k] * x3[k]; o[k] = t >= 0 ? z : 0.f; }
              u32x4 w; w.x = pk2(o[0], o[1]); w.y = pk2(o[2], o[3]); w.z = pk2(o[4], o[5]); w.w = pk2(o[6], o[7]);
              *(LAS u32x4*)(XC + i * 136 + 8 * cgp) = w; } }
        BAR_LDS();
        { const int lt = wave & 3;
#pragma unroll
          for (int te = 0; te < 2; ++te) { const int et = 2 * (wave >> 2) + te; f32x4 a0 = (f32x4){0.f, 0.f, 0.f, 0.f}, a1 = a0;
#pragma unroll
              for (int ks = 0; ks < 4; ++ks) { const bf16x8 xa = ldfrag(XC + 16 * lt * 136 + 32 * ks, 136, r, q);
                  a0 = mma32(xa, ldfrag(WGT + (16 * et) * 136 + 32 * ks, 136, r, q), a0); a1 = mma32(xa, ldfrag(WGT + (64 + 16 * et) * 136 + 32 * ks, 136, r, q), a1); }
              const int e = 16 * et + r, chn = 128 * n + 64 * hf + e; const float b0 = bg[chn], b1 = bg[DM + chn], spl = softplusf_(-lam[chn]);
#pragma unroll
              for (int j = 0; j < 4; ++j) { const int tok = 16 * lt + 4 * q + j, t = 64 * c - 48 + tok;
                  const float rg = sigmoidf_(a0[j] + b0), ig = sigmoidf_(a1[j] + b1), la = -8.f * rg * spl; float a = __expf(la), u = __builtin_amdgcn_sqrtf(fmaxf(1.f - __expf(2.f * la), 0.f)) * ig * bf2f(XC[tok * 136 + 64 * hf + e]);
                  if (t < 0) { a = 1.f; u = 0.f; }
                  AA[tok * 64 + e] = a; UU[tok * 64 + e] = u; } } }
        BAR_LDS();
        { const int ch = tid & 63; float A = 1.f, H = 0.f;
#pragma unroll
          for (int i = 0; i < 8; ++i) { const float a = AA[(8 * seg + i) * 64 + ch], u = UU[(8 * seg + i) * 64 + ch]; H = a * H + u; A *= a; }
          SEG[(seg * 64 + ch) * 2] = A; SEG[(seg * 64 + ch) * 2 + 1] = H;
          BAR_LDS();
          float hcar = CAR[ch];
          for (int s2 = 0; s2 < seg; ++s2) hcar = SEG[(s2 * 64 + ch) * 2] * hcar + SEG[(s2 * 64 + ch) * 2 + 1];
#pragma unroll
          for (int i = 0; i < 8; ++i) { const int tok = 8 * seg + i, t = 64 * c - 48 + tok; hcar = AA[tok * 64 + ch] * hcar + UU[tok * 64 + ch];
              if (t >= 0) { const size_t row = (size_t)row_of(b, t); const float x = bf2f(yin[i]);
                  const float tu = 0.7978845608f * (x + 0.044715f * x * x * x); const float ge = 0.5f * x * (2.f - 2.f * __builtin_amdgcn_rcpf(1.f + __expf(2.f * tu)));
                  YS3[row * DM + chs] = (bf16_t)f2bf(hcar * ge); } }
          BAR_LDS();
          if (seg == 7) CAR[ch] = hcar; }
        BAR_LDS();
    }
}


__device__ __forceinline__ f32x4 skinny_tile(const bf16_t* A, const bf16_t* Bt, int K, int j, LAS unsigned char* lds, int wave, int lane) {
    const int r = lane & 15, q = lane >> 4; f32x4 acc[4];
#pragma unroll
    for (int nt = 0; nt < 4; ++nt) acc[nt] = (f32x4){0.f, 0.f, 0.f, 0.f};
    const bf16_t* ap = A + (size_t)(MMAIN + r) * K + 8 * q; const bf16_t* bp = Bt + (size_t)(64 * j + r) * K + 8 * q;
    const int nks = K / 32;
    for (int ks = wave; ks < nks; ks += 8) { const bf16x8 a = *(const bf16x8*)(ap + 32 * ks);
#pragma unroll
        for (int nt = 0; nt < 4; ++nt) acc[nt] = mma32(a, *(const bf16x8*)(bp + (size_t)16 * nt * K + 32 * ks), acc[nt]); }
    LAS f32x4* red = (LAS f32x4*)lds;
#pragma unroll
    for (int nt = 0; nt < 4; ++nt) red[(wave * 4 + nt) * 64 + lane] = acc[nt];
    __syncthreads();
    f32x4 tot = (f32x4){0.f, 0.f, 0.f, 0.f};
    if (wave < 4) {
#pragma unroll
        for (int w = 0; w < 8; ++w) tot += red[(w * 4 + wave) * 64 + lane]; }
    __syncthreads();
    return tot;
}
__device__ __forceinline__ void skinny_branch(const bf16_t* YS, const bf16_t* br_t, const bf16_t* P, float* Z, bf16_t* ZB, int j, LAS unsigned char* lds, const int WAVE_U) {
    int tid = TIDX; asm volatile("" : "+v"(tid)); const int wave = __builtin_amdgcn_readfirstlane(tid >> 6), lane = tid & 63, r = lane & 15, q = lane >> 4;
    for (int n = 0; n < 4; ++n) {
        const f32x4 acc = skinny_tile(YS + (size_t)n * MP * DM, br_t + (size_t)n * 1024 * DM, DM, j, lds, wave, lane);
        if (wave < 4) { const int col = 64 * j + 16 * wave + r;
#pragma unroll
            for (int jj = 0; jj < 4; ++jj) { const size_t row = MMAIN + 4 * q + jj; float v = sigmoidf_(bf2f(P[row * NP + OFF_GATE + n * 1024 + col])) * acc[jj];
                if (n != 0) v += Z[row * DM + col];
                if (n != 3) Z[row * DM + col] = v; else ZB[row * DM + col] = (bf16_t)f2bf(v); } }
    }
}
__device__ __forceinline__ void skinny_resid(const bf16_t* A, const bf16_t* Bt, int K, float* S, bf16_t* HN, const float* nw, float* ssq, int j, LAS unsigned char* lds, const int WAVE_U) {
    int tid = TIDX; asm volatile("" : "+v"(tid)); const int wave = __builtin_amdgcn_readfirstlane(tid >> 6), lane = tid & 63, r = lane & 15, q = lane >> 4;
    const f32x4 acc = skinny_tile(A, Bt, K, j, lds, wave, lane);
    LAS float* part = (LAS float*)lds;
    if (wave < 4) { const int col = 64 * j + 16 * wave + r; const float w = nw[col];
#pragma unroll
        for (int jj = 0; jj < 4; ++jj) { const size_t row = MMAIN + 4 * q + jj; const float sn = S[row * DM + col] + acc[jj]; S[row * DM + col] = sn; HN[row * DM + col] = (bf16_t)f2bf(sn * w);
            float ss = sn * sn; ss = DPP_ADD(ss, 0xB1); ss = DPP_ADD(ss, 0x4E); ss = DPP_ADD(ss, 0x141); ss = DPP_ADD(ss, 0x140);
            if (r == 0) part[wave * 16 + 4 * q + jj] = ss; } }
    __syncthreads();
    if (tid < 16) ssq[(size_t)(MMAIN + tid) * 16 + j] = (part[tid] + part[16 + tid]) + (part[32 + tid] + part[48 + tid]);
    __syncthreads();
}


#define XB_TMO      128
#define XB_XCNT(j)  (256  + 64 * (j))
#define XB_XSUB(j)  (1280 + 64 * (j))
#define XB_XGEN(j)  (2304 + 64 * (j))
#define XB_TOP      3328
#define XB_TOPGEN   3392
#define XCD_BAR_WORDS 3456
#define XB_SPIN_CAP (1u << 20)
__device__ __forceinline__ unsigned xb_ld(unsigned* p)              { return __hip_atomic_load(p, __ATOMIC_RELAXED, __HIP_MEMORY_SCOPE_AGENT); }
__device__ __forceinline__ unsigned xb_add(unsigned* p, unsigned v) { return __hip_atomic_fetch_add(p, v, __ATOMIC_RELAXED, __HIP_MEMORY_SCOPE_AGENT); }
__device__ __forceinline__ unsigned xb_xcc_id() { return (unsigned)__builtin_amdgcn_s_getreg((3 << 11) | 20) & 0xFu; }
#define XB_SPIN(cond, bar) do { unsigned _sp = 0; while (cond) { __builtin_amdgcn_s_sleep(1); \
    if ((++_sp & 255u) == 0u) { if (xb_ld(&(bar)[XB_TMO])) break; if (_sp > XB_SPIN_CAP) { atomicAdd(&(bar)[XB_TMO], 1u); break; } } } } while (0)
struct XcdBarrier { unsigned* bar; unsigned x; volatile LAS unsigned* st; };
__device__ __forceinline__ XcdBarrier xcd_barrier_post(unsigned* bar, volatile LAS unsigned* st, const int WAVE_U) {
    XcdBarrier b; b.bar = bar; b.x = (unsigned)__builtin_amdgcn_readfirstlane((int)xb_xcc_id()); b.st = st;
    if (TIDX == 0) (void)xb_add(&bar[XB_XCNT(b.x)], 1u);
    return b;
}
__device__ __forceinline__ void xcd_barrier_complete(unsigned* bar, unsigned x, unsigned& nloc, unsigned& nx) {
    const unsigned G = gridDim.x * gridDim.y * gridDim.z;
    unsigned sum, cnt, mine, sp = 0u;
    for (;;) {
        sum = 0u; cnt = 0u; mine = 0u;
#pragma unroll
        for (unsigned j = 0; j < 16; ++j) { const unsigned c = xb_ld(&bar[XB_XCNT(j)]); sum += c; cnt += (c > 0u) ? 1u : 0u; mine = (j == x) ? c : mine; }
        if (sum == G) break;
        __builtin_amdgcn_s_sleep(1);
        if ((++sp & 255u) == 0u) { if (xb_ld(&bar[XB_TMO])) break; if (sp > XB_SPIN_CAP) { atomicAdd(&bar[XB_TMO], 1u); break; } }
    }
    nloc = mine > 0u ? mine : 1u; nx = cnt > 0u ? cnt : 1u;
}
__device__ __forceinline__ void xcd_barrier(const XcdBarrier& b, const int WAVE_U) {
    asm volatile("s_waitcnt vmcnt(0)" ::: "memory");
    __syncthreads();
    if (TIDX == 0) {
        unsigned* bar = b.bar;
        __builtin_amdgcn_s_waitcnt(0);
        unsigned nloc = b.st[0], nx = b.st[1];
        if (nloc == 0u) { xcd_barrier_complete(bar, b.x, nloc, nx); b.st[0] = nloc; b.st[1] = nx; }
        const unsigned old = xb_add(&bar[XB_XSUB(b.x)], 1u);
        const unsigned gen = old / nloc;
        if (old + 1u == (gen + 1u) * nloc) {
            __builtin_amdgcn_fence(__ATOMIC_RELEASE, "agent");
            asm volatile("s_waitcnt vmcnt(0)" ::: "memory");
            const unsigned og = xb_add(&bar[XB_TOP], 1u);
            const unsigned tg = og / nx;
            if (og + 1u == (tg + 1u) * nx) xb_add(&bar[XB_TOPGEN], 1u);
            else XB_SPIN(xb_ld(&bar[XB_TOPGEN]) == tg, bar);
            __builtin_amdgcn_fence(__ATOMIC_ACQUIRE, "agent");
            xb_add(&bar[XB_XGEN(b.x)], 1u);
            asm volatile("s_waitcnt vmcnt(0)" ::: "memory");
        } else {
            XB_SPIN(xb_ld(&bar[XB_XGEN(b.x)]) == gen, bar);
            __builtin_amdgcn_fence(__ATOMIC_ACQUIRE, "agent");
            asm volatile("s_waitcnt vmcnt(0)" ::: "memory");
        }
    }
    __syncthreads();
}


__device__ __forceinline__ void subgrid_arrive(unsigned* word, const int WAVE_U) {
    asm volatile("s_waitcnt vmcnt(0)" ::: "memory");
    __syncthreads();
    if (TIDX == 0) { __builtin_amdgcn_fence(__ATOMIC_RELEASE, "agent"); asm volatile("s_waitcnt vmcnt(0)" ::: "memory"); (void)xb_add(word, 1u); }
}
__device__ __forceinline__ void subgrid_wait(unsigned* word, unsigned nblocks, const int WAVE_U) {
    if (TIDX == 0) { unsigned sp = 0u; while (xb_ld(word) < nblocks) { __builtin_amdgcn_s_sleep(1); if (++sp > (1u << 22)) break; }
        __builtin_amdgcn_fence(__ATOMIC_ACQUIRE, "agent"); asm volatile("s_waitcnt vmcnt(0)" ::: "memory"); }
    __syncthreads();
}
__device__ __forceinline__ void subgrid_barrier(unsigned* word, unsigned nblocks, const int WAVE_U) {
    asm volatile("s_waitcnt vmcnt(0)" ::: "memory");
    __syncthreads();
    if (TIDX == 0) {
        __builtin_amdgcn_fence(__ATOMIC_RELEASE, "agent");
        asm volatile("s_waitcnt vmcnt(0)" ::: "memory");
        (void)xb_add(word, 1u);
        unsigned sp = 0u;
        while (xb_ld(word) < nblocks) { __builtin_amdgcn_s_sleep(1); if (++sp > (1u << 22)) break; }
        __builtin_amdgcn_fence(__ATOMIC_ACQUIRE, "agent");
        asm volatile("s_waitcnt vmcnt(0)" ::: "memory");
    }
    __syncthreads();
}

#ifndef REP_P1
#define REP_P1 1
#endif
#ifndef REP_RWKV
#define REP_RWKV 1
#endif
#ifndef REP_SSD
#define REP_SSD 1
#endif
#ifndef REP_RET
#define REP_RET 1
#endif
#ifndef REP_LRU
#define REP_LRU 1
#endif
#ifndef PH_MASK
#define PH_MASK 1023
#endif
constexpr int LDS_BYTES = 160768;
constexpr int NUNITS = 176;

__global__ void __launch_bounds__(512, 2) fwd_megakernel(KP p) {
    extern __shared__ __attribute__((aligned(16))) unsigned char lds_raw[];
    LAS unsigned char* lds = (LAS unsigned char*)lds_raw;
    cg::grid_group grid = cg::this_grid();
    const int WAVE_U = __builtin_amdgcn_readfirstlane((int)(threadIdx.x >> 6));
    constexpr int G = 256; int bx = blockIdx.x; constexpr int NGW = G * 8;
#define FRESH_TID() int tid_ = TIDX; asm volatile("" : "+v"(tid_)); const int tid = tid_, wave = tid >> 6, lane = tid & 63, gw = bx * 8 + wave; (void)gw; (void)lane
    float* ssq = (float*)(p.ws + WS_SSQ); float* S = (float*)(p.ws + WS_S); bf16_t* HN = (bf16_t*)(p.ws + WS_HN); bf16_t* P = (bf16_t*)(p.ws + WS_P);
    bf16_t* YS = (bf16_t*)(p.ws + WS_YS); float* Z = (float*)(p.ws + WS_Z); bf16_t* ZB = (bf16_t*)(p.ws + WS_ZB); bf16_t* WIN = (bf16_t*)(p.ws + WS_WIN);
    bf16_t* H = (bf16_t*)(p.ws + WS_P);
    {
        FRESH_TID();
        const float* nw0 = p.in[2];
        for (int m = gw; m < MP; m += NGW) {
            const float* src = m < MMAIN ? p.in[0] + (size_t)m * DM : (m < MMAIN + NMETA ? p.in[1] + (size_t)(m - MMAIN) * DM : nullptr);
            float ss = 0.f;
#pragma unroll
            for (int j = 0; j < 4; ++j) { const int col = 4 * lane + 256 * j; f32x4 v = (f32x4){0.f, 0.f, 0.f, 0.f}; if (src) v = *(const f32x4*)(src + col);
                *(f32x4*)(S + (size_t)m * DM + col) = v; const f32x4 w = *(const f32x4*)(nw0 + col);
                u32x2 o; o.x = pk2(v[0] * w[0], v[1] * w[1]); o.y = pk2(v[2] * w[2], v[3] * w[3]); *(u32x2*)(HN + (size_t)m * DM + col) = o;
                ss += (v[0] * v[0] + v[1] * v[1]) + (v[2] * v[2] + v[3] * v[3]); }
#pragma unroll
            for (int o = 1; o < 64; o <<= 1) ss += __shfl_xor(ss, o);
            if (lane < 16) ssq[(size_t)m * 16 + lane] = lane == 0 ? ss : 0.f;
        }
        for (int i = bx * 512 + tid; i < (NP - INW) * DM / 8; i += G * 512) ((u32x4*)(WIN + (size_t)INW * DM))[i] = (u32x4){0u, 0u, 0u, 0u};
        convert_layer(p, 0, lds, gw, NGW, wave, lane);
        if (bx == 0) for (int i = tid; i < XCD_BAR_WORDS + 512; i += 512) ((unsigned*)(p.ws + WS_XBAR))[i] = 0u;
        if (tid == 0) { ((volatile LAS unsigned*)(lds + LDS_BYTES - 16))[0] = 0u; ((volatile LAS unsigned*)(lds + LDS_BYTES - 16))[1] = 0u; }
    }
    grid.sync();
    XcdBarrier xbar = xcd_barrier_post((unsigned*)(p.ws + WS_XBAR), (volatile LAS unsigned*)(lds + LDS_BYTES - 16), WAVE_U);
    for (int l_ = 0; l_ < NLAYER; ++l_) {
        int l = l_; asm volatile("" : "+s"(l)); asm volatile("" : "+s"(bx));
        unsigned char* sm = p.ws + WS_WSM + (size_t)(l & 1) * WSM_SIZE;
        const bf16_t* br_t = (const bf16_t*)(sm + WSM_BR); const bf16_t* out_t = (const bf16_t*)(sm + WSM_OUT); const bf16_t* fi_t = (const bf16_t*)(sm + WSM_FI); const bf16_t* fo_t = (const bf16_t*)(sm + WSM_FO);
        if (PH_MASK & 1) for (int rp = 0; rp < REP_P1; ++rp) { pg8::Gemm g{HN, WIN, DM}; pg8::RemapOrder So; So.b.init(NTM, PT_A + 1, G, bx); So.from = PT_A; So.to = NP / 256 - 1; pg8::EpiInProj E{P, ssq + (size_t)(2 * l) * MP * 16, 0}; pg8::gemm_phase(lds, g, So, E, WAVE_U); }
        xcd_barrier(xbar, WAVE_U);
        asm volatile("" : "+s"(bx));
        { FRESH_TID(); rwkv_lora_inputs(p, l, gw, NGW, lane); }
        xcd_barrier(xbar, WAVE_U);
        asm volatile("" : "+s"(bx));
        {
            int l = l_; asm volatile("" : "+s"(l));
            if (bx < 64) rwkv_unit(p, l, bx >> 4, bx & 15, lds, WAVE_U);
            else if (bx < 80) ssd_unit(p, l, (bx - 64) >> 2, (bx - 64) & 3, lds, WAVE_U);
            else {
                { pg8::Gemm g{HN, WIN + (size_t)PT_A * 256 * DM, DM}; pg8::StaticOrder So; So.init(NTM, GT0 - PT_A, G - 80, bx - 80);
                  pg8::EpiInProj E{P, ssq + (size_t)(2 * l) * MP * 16, PT_A}; pg8::gemm_phase(lds, g, So, E, WAVE_U); }
                unsigned* sbw = (unsigned*)(p.ws + WS_XBAR) + XCD_BAR_WORDS + 64 + 64 * l;
                subgrid_arrive(sbw, WAVE_U);
                if (bx < 176) subgrid_wait(sbw, (unsigned)(G - 80), WAVE_U);
                if (bx < 112) ret_unit(p, (bx - 80) >> 3, (bx - 80) & 7, lds, WAVE_U);
                else if (bx < 176) { const int v = bx - 112; lru_unit(p, l, v >> 4, (v >> 1) & 7, v & 1, lds, WAVE_U); }
                else { { pg8::Gemm g{HN, (const bf16_t*)(p.ws + WS_WING + (size_t)(l & 1) * WING_SIZE), DM}; pg8::StaticOrder So; So.init(NTM, GTN, G - 176, bx - 176);
                         pg8::EpiInProj E{P, ssq + (size_t)(2 * l) * MP * 16, GT0}; pg8::gemm_phase(lds, g, So, E, WAVE_U); }
                       subgrid_wait(sbw, (unsigned)(G - 80), WAVE_U);
                       if (l_ + 1 < NLAYER) { FRESH_TID(); convert_layer(p, l + 1, lds, (bx - 176) * 8 + wave, (G - 176) * 8, wave, lane); } }
            }
        }
        xcd_barrier(xbar, WAVE_U);
        asm volatile("" : "+s"(bx));
        if (PH_MASK & 32) { pg8::Gemm g{YS, br_t, DM}; pg8::BranchOrder So{G, bx}; pg8::EpiBranch E{P, Z, ZB}; pg8::gemm_phase(lds, g, So, E, WAVE_U);
          if (bx < 16) skinny_branch(YS, br_t, P, Z, ZB, bx, lds, WAVE_U); }
        xcd_barrier(xbar, WAVE_U);
        asm volatile("" : "+s"(bx));
        if (PH_MASK & 64) { pg8::Gemm g{ZB, out_t, DM}; pg8::StaticOrder So; So.init(NTM - 1, 4, G, bx); pg8::EpiResid E{S, HN, p.in[3] + (size_t)l * DM, ssq + (size_t)(2 * l + 1) * MP * 16}; pg8::gemm_phase(lds, g, So, E, WAVE_U);
          if (bx < 16) skinny_resid(ZB, out_t, DM, S, HN, p.in[3] + (size_t)l * DM, ssq + (size_t)(2 * l + 1) * MP * 16, bx, lds, WAVE_U); }
        xcd_barrier(xbar, WAVE_U);
        asm volatile("" : "+s"(bx));
        if (PH_MASK & 128) { pg8::Gemm g{HN, fi_t, DM}; pg8::StaticOrder So; So.init(NTM, 2 * FF / 256, G, bx); pg8::EpiSwiglu E{H, ssq + (size_t)(2 * l + 1) * MP * 16}; pg8::gemm_phase(lds, g, So, E, WAVE_U); }
        xcd_barrier(xbar, WAVE_U);
        asm volatile("" : "+s"(bx));
        if (PH_MASK & 256) { pg8::Gemm g{H, fo_t, FF}; pg8::StaticOrder So; So.init(NTM - 1, 4, G, bx); const float* nwn = (l + 1 < NLAYER) ? p.in[2] + (size_t)(l + 1) * DM : p.in[29];
          pg8::EpiResid E{S, HN, nwn, ssq + (size_t)(2 * l + 2) * MP * 16}; pg8::gemm_phase(lds, g, So, E, WAVE_U);
          if (bx < 16) skinny_resid(H, fo_t, FF, S, HN, nwn, ssq + (size_t)(2 * l + 2) * MP * 16, bx, lds, WAVE_U); }
        xcd_barrier(xbar, WAVE_U);
        asm volatile("" : "+s"(bx));
    }
    { FRESH_TID(); const float* fw = p.in[29]; const float* sq = ssq + (size_t)8 * MP * 16;
      for (int m = gw; m < MMAIN; m += NGW) { const float rs = rsqrtf(ssq_total(sq, m) * (1.f / 1024.f) + 1e-6f);
#pragma unroll
          for (int j = 0; j < 4; ++j) { const int col = 4 * lane + 256 * j; const f32x4 v = *(const f32x4*)(S + (size_t)m * DM + col), w = *(const f32x4*)(fw + col);
              *(f32x4*)(p.out + (size_t)m * DM + col) = v * rs * w; } } }
}

extern "C" void kernel_launch(void* const* d_in, const int* in_sizes, int n_in, void* d_out, int out_size, void* d_ws, size_t ws_size, hipStream_t stream) {
    static int grid = 0;
    if (grid == 0) {
        if (n_in != 30 || ws_size < WS_END) { fprintf(stderr, "kernel_launch: unexpected n_in %d / ws %zu (need %zu)\n", n_in, ws_size, (size_t)WS_END); grid = -1; return; }
        int dev = 0, cus = 0, per_cu = 0;
        hipGetDevice(&dev); hipDeviceGetAttribute(&cus, hipDeviceAttributeMultiprocessorCount, dev);
        hipFuncSetAttribute((const void*)fwd_megakernel, hipFuncAttributeMaxDynamicSharedMemorySize, LDS_BYTES);
        hipOccupancyMaxActiveBlocksPerMultiprocessor(&per_cu, (const void*)fwd_megakernel, 512, LDS_BYTES);
        if (per_cu < 1) { fprintf(stderr, "kernel_launch: occupancy query says %d blocks/CU\n", per_cu); per_cu = 1; }
        (void)hipGetLastError();
        grid = 256;
        if (cus < 256) { fprintf(stderr, "kernel_launch: this kernel needs 256 CUs (got %d)\n", cus); grid = -1; return; }
    }
    if (grid < 0) return;
    KP p{};
    for (int i = 0; i < 30; ++i) p.in[i] = (const float*)d_in[i];
    p.out = (float*)d_out; p.ws = (unsigned char*)d_ws;
    void* args[] = {&p};
    hipError_t e = hipLaunchCooperativeKernel((const void*)fwd_megakernel, dim3(grid), dim3(512), args, LDS_BYTES, stream);
    if (e != hipSuccess) fprintf(stderr, "cooperative launch failed: %s (grid %d)\n", hipGetErrorString(e), grid);
}
```
